# Optimizing an MI355X kernel written in HIP

```python
import jax, jax.numpy as jnp
from jax import lax
import numpy as np

D_MODEL = 1024
BATCH = 8
SEQ = 2048
DEPTH = 2

N_GMLP_GROUPS = 8
GMLP_GROUP_DIM = 64
GMLP_WIDTH = N_GMLP_GROUPS * GMLP_GROUP_DIM
CHUNK = 128
N_SB_HEADS = 8
SB_HEAD_DIM = 64
SB_WIDTH = N_SB_HEADS * SB_HEAD_DIM
SB_BLOCK = 128
EVEN_IN_WIDTH = 2 * GMLP_WIDTH + 3 * SB_WIDTH
EVEN_MIX_WIDTH = GMLP_WIDTH + SB_WIDTH
CONV_WIDTH = D_MODEL
CONV_K = 3
N_GROUPS = 4
EXPERTS_PER_GROUP = 8
N_EXPERTS = N_GROUPS * EXPERTS_PER_GROUP
EXPERT_TOP_K = 2
EXPERT_FF = 512
EPS = 1e-6
N_EVEN = (DEPTH + 1) // 2
N_ODD = DEPTH // 2

kernel_name = "hybrid_gmlp_stickbreak_shortconv_hmoe"


def rms_norm(x, gain):
    xf = x.astype(jnp.float32)
    y = xf * lax.rsqrt(jnp.mean(xf * xf, axis=-1, keepdims=True) + EPS)
    return (y * gain.astype(jnp.float32)).astype(x.dtype)


def chunked_spatial_gating(u, v, w_s, b_s, v_gain):
    b, s, g, d = v.shape
    v = rms_norm(v, v_gain)
    causal = jnp.tril(jnp.ones((CHUNK, CHUNK), dtype=bool))
    w = jnp.where(causal[None], w_s, jnp.zeros_like(w_s)).astype(v.dtype)
    vc = v.reshape(b, s // CHUNK, CHUNK, g, d)
    mixed = jnp.einsum('gts,bnsgd->bntgd', w, vc) + b_s.T.astype(v.dtype)[None, None, :, :, None]
    return u * mixed.reshape(b, s, g, d)


def stick_breaking_attention(q, k, v):
    b, s, h, d = q.shape
    nb = s // SB_BLOCK
    scale = d ** -0.5
    qb = q.reshape(b, nb, SB_BLOCK, h, d).transpose(1, 0, 2, 3, 4)
    kpos = jnp.arange(s)

    def block(args):
        qi, i = args
        z = jnp.einsum('bthd,bshd->bhts', qi, k).astype(jnp.float32) * scale
        qpos = i * SB_BLOCK + jnp.arange(SB_BLOCK)
        causal = kpos[None, :] < qpos[:, None]
        log_beta = jax.nn.log_sigmoid(z)
        log_keep = jnp.where(causal, jax.nn.log_sigmoid(-z), 0.0)
        suffix = lax.cumsum(log_keep, axis=3, reverse=True) - log_keep
        a = jnp.where(causal, jnp.exp(log_beta + suffix), 0.0)
        return jnp.einsum('bhts,bshd->bthd', a.astype(v.dtype), v)

    out = lax.map(block, (qb, jnp.arange(nb)))
    return out.transpose(1, 0, 2, 3, 4).reshape(b, s, h, d)


def short_conv_mixer(p, conv_w):
    gate_b, gate_c, h = jnp.split(p, 3, axis=-1)
    y = gate_c * h
    conv = lax.conv_general_dilated(
        y, conv_w.astype(y.dtype)[:, None, :],
        window_strides=(1,), padding=[(CONV_K - 1, 0)],
        dimension_numbers=('NWC', 'WIO', 'NWC'),
        feature_group_count=CONV_WIDTH)
    return gate_b * conv


def hierarchical_moe(x, w_router_group, w_router_expert, w_gate, w_up, w_down):
    b, s, d = x.shape
    t = x.reshape(-1, d)
    group_prob = jax.nn.softmax((t @ w_router_group).astype(jnp.float32), axis=-1)
    top_gp, top_g = lax.top_k(group_prob, 1)
    top_gp, top_g = top_gp[:, 0], top_g[:, 0]
    expert_logits = jnp.einsum('td,gde->tge', t, w_router_expert).astype(jnp.float32)
    sel_logits = jnp.take_along_axis(expert_logits, top_g[:, None, None], axis=1)[:, 0]
    top_el, top_e = lax.top_k(sel_logits, EXPERT_TOP_K)
    top_ep = jax.nn.softmax(top_el, axis=-1)
    expert_idx = top_g[:, None] * EXPERTS_PER_GROUP + top_e
    weights = top_gp[:, None] * top_ep
    combine = jnp.sum(jax.nn.one_hot(expert_idx, N_EXPERTS, dtype=jnp.float32) * weights[..., None], axis=1)
    combine = combine.astype(t.dtype)
    out = jnp.zeros_like(t)
    for e in range(N_EXPERTS):
        h = jax.nn.silu(t @ w_gate[e]) * (t @ w_up[e])
        out = out + combine[:, e:e + 1] * (h @ w_down[e])
    return out.reshape(b, s, d)


def setup_inputs(seed: int = 0) -> dict:
    key = jax.random.key(seed)
    ks = jax.random.split(key, 18)
    f32 = jnp.float32
    nrm = lambda k, shape, scale: jax.random.normal(k, shape, f32) * scale
    return {
        "x": jax.random.normal(ks[0], (BATCH, SEQ, D_MODEL), f32),
        "even_w_in": nrm(ks[1], (N_EVEN, D_MODEL, EVEN_IN_WIDTH), D_MODEL ** -0.5),
        "even_w_out": nrm(ks[2], (N_EVEN, EVEN_MIX_WIDTH, D_MODEL), EVEN_MIX_WIDTH ** -0.5),
        "gmlp_w_s": nrm(ks[3], (N_EVEN, N_GMLP_GROUPS, CHUNK, CHUNK), CHUNK ** -0.5),
        "gmlp_b_s": 1.0 + nrm(ks[4], (N_EVEN, N_GMLP_GROUPS, CHUNK), 0.1),
        "gmlp_v_gain": 1.0 + nrm(ks[5], (N_EVEN, N_GMLP_GROUPS, GMLP_GROUP_DIM), 0.05),
        "odd_w_in": nrm(ks[6], (N_ODD, D_MODEL, 3 * CONV_WIDTH), D_MODEL ** -0.5),
        "odd_conv_w": nrm(ks[7], (N_ODD, CONV_K, CONV_WIDTH), CONV_K ** -0.5),
        "odd_w_out": nrm(ks[8], (N_ODD, CONV_WIDTH, D_MODEL), CONV_WIDTH ** -0.5),
        "norm_mix": 1.0 + nrm(ks[9], (DEPTH, D_MODEL), 0.05),
        "norm_ffn": 1.0 + nrm(ks[10], (DEPTH, D_MODEL), 0.05),
        "router_group": nrm(ks[11], (DEPTH, D_MODEL, N_GROUPS), D_MODEL ** -0.5),
        "router_expert": nrm(ks[12], (DEPTH, N_GROUPS, D_MODEL, EXPERTS_PER_GROUP), D_MODEL ** -0.5),
        "w_gate": nrm(ks[13], (DEPTH, N_EXPERTS, D_MODEL, EXPERT_FF), D_MODEL ** -0.5),
        "w_up": nrm(ks[14], (DEPTH, N_EXPERTS, D_MODEL, EXPERT_FF), D_MODEL ** -0.5),
        "w_down": nrm(ks[15], (DEPTH, N_EXPERTS, EXPERT_FF, D_MODEL), EXPERT_FF ** -0.5),
        "norm_final": 1.0 + nrm(ks[16], (D_MODEL,), 0.05),
    }


def reference(x, even_w_in, even_w_out, gmlp_w_s, gmlp_b_s, gmlp_v_gain,
              odd_w_in, odd_conv_w, odd_w_out, norm_mix, norm_ffn,
              router_group, router_expert, w_gate, w_up, w_down, norm_final):
    b, s, _ = x.shape
    for l in range(DEPTH):
        h = rms_norm(x, norm_mix[l])
        i = l // 2
        if l % 2 == 0:
            p = h @ even_w_in[i]
            u, v, q, k, vv = jnp.split(
                p, [GMLP_WIDTH, 2 * GMLP_WIDTH, 2 * GMLP_WIDTH + SB_WIDTH,
                    2 * GMLP_WIDTH + 2 * SB_WIDTH], axis=-1)
            u = jax.nn.gelu(u, approximate=False).reshape(b, s, N_GMLP_GROUPS, GMLP_GROUP_DIM)
            v = jax.nn.gelu(v, approximate=False).reshape(b, s, N_GMLP_GROUPS, GMLP_GROUP_DIM)
            a_out = chunked_spatial_gating(u, v, gmlp_w_s[i], gmlp_b_s[i], gmlp_v_gain[i])
            heads = lambda t: t.reshape(b, s, N_SB_HEADS, SB_HEAD_DIM)
            b_out = stick_breaking_attention(heads(q), heads(k), heads(vv))
            mix = jnp.concatenate([a_out.reshape(b, s, GMLP_WIDTH),
                                   b_out.reshape(b, s, SB_WIDTH)], axis=-1) @ even_w_out[i]
        else:
            mix = short_conv_mixer(h @ odd_w_in[i], odd_conv_w[i]) @ odd_w_out[i]
        x = x + mix
        x = x + hierarchical_moe(rms_norm(x, norm_ffn[l]), router_group[l], router_expert[l],
                                 w_gate[l], w_up[l], w_down[l])
    return rms_norm(x, norm_final)
```

```cpp
#include <hip/hip_runtime.h>
#include <cstdio>
#include <cstdint>
#include <cmath>

#ifndef HYBRID
#define HYBRID 0
#endif

#define GAS __attribute__((address_space(1)))
#define LAS __attribute__((address_space(3)))
typedef unsigned short bf16;
typedef unsigned v4u __attribute__((ext_vector_type(4)));
typedef unsigned v2u __attribute__((ext_vector_type(2)));
typedef float f32x4 __attribute__((ext_vector_type(4)));
typedef float f32x2 __attribute__((ext_vector_type(2)));
typedef float f32x16 __attribute__((ext_vector_type(16)));
typedef short bf16x8 __attribute__((ext_vector_type(8)));
typedef GAS unsigned gu32;

constexpr int D = 1024, BATCH = 8, SEQ = 2048, T = BATCH * SEQ;
constexpr int NG = 8, GD = 64, GW = 512, CHUNK = 128;
constexpr int NH = 8, HD = 64, SBW = 512;
constexpr int EVEN_IN = 2560, ODD_IN = 3072;
constexpr int NGRP = 4, EPG = 8, NEXP = 32, FF = 512;
constexpr float EPS = 1e-6f;
constexpr int NWAVES = 8;
constexpr int LIST_CAP = T;
constexpr int MAX_MT = 2 * T / 256 + NEXP;

constexpr size_t MiB = 1u << 20;
constexpr size_t WS_CTL = 0, CTL_ZERO_BYTES = 1 * MiB;
constexpr size_t WS_WTRIL = 1 * MiB;
constexpr size_t WS_LIST = 2 * MiB;
constexpr size_t WS_SELW = 4 * MiB;
constexpr size_t WS_WIN0 = 5 * MiB, WS_WOUT0 = 10 * MiB, WS_WIN1 = 12 * MiB, WS_WOUT1 = 18 * MiB;
constexpr size_t WS_WGU = 20 * MiB;
constexpr size_t WS_WD = 148 * MiB;
constexpr size_t WS_H = 212 * MiB;
constexpr size_t WS_ACT = 244 * MiB;
constexpr size_t WS_MIX = 324 * MiB;
constexpr size_t WS_X = 356 * MiB;
constexpr size_t WS_CONTRIB = 420 * MiB;
constexpr size_t WS_END = 484 * MiB;
constexpr int CW_CNT = 64;
constexpr int CW_BAR = 8192;

constexpr int RING_BYTES = 131072;
constexpr int LDSCTL_OFF = RING_BYTES, MISC_OFF = LDSCTL_OFF + 320;
constexpr int LDS_BYTES = 147456;

#define RLX_AGENT __ATOMIC_RELAXED, __HIP_MEMORY_SCOPE_AGENT
#define LDS_WAIT() asm volatile("s_waitcnt lgkmcnt(0)" ::: "memory")
#define VM_WAIT() asm volatile("s_waitcnt vmcnt(0)" ::: "memory")
__device__ __forceinline__ unsigned f2bf(float f) { unsigned u = __builtin_bit_cast(unsigned, f); return (u + 0x7fffu + ((u >> 16) & 1u)) >> 16; }
__device__ __forceinline__ unsigned pk2(float lo, float hi) { return f2bf(lo) | (f2bf(hi) << 16); }
__device__ __forceinline__ float bf_lo(unsigned w) { return __builtin_bit_cast(float, w << 16); }
__device__ __forceinline__ float bf_hi(unsigned w) { return __builtin_bit_cast(float, w & 0xffff0000u); }
__device__ __forceinline__ unsigned cvt_pk_bf16(float lo, float hi) { unsigned r; asm volatile("v_cvt_pk_bf16_f32 %0, %1, %2" : "=v"(r) : "v"(lo), "v"(hi)); return r; }
__device__ __forceinline__ float wave_sum(float v) {
#pragma unroll
    for (int o = 1; o < 64; o <<= 1) v += __shfl_xor(v, o);
    return v;
}

#define XB_TMO      128
#define XB_XCNT(j)  (256  + 64 * (j))
#define XB_XSUB(j)  (1280 + 64 * (j))
#define XB_XGEN(j)  (2304 + 64 * (j))
#define XB_TOP      3328
#define XB_TOPGEN   3392
#define XCD_BAR_WORDS 3456
#define XB_SPIN_CAP (1u << 18)
__device__ __forceinline__ unsigned xb_ld(unsigned* p)              { return __hip_atomic_load(p, __ATOMIC_RELAXED, __HIP_MEMORY_SCOPE_AGENT); }
__device__ __forceinline__ unsigned xb_add(unsigned* p, unsigned v) { return __hip_atomic_fetch_add(p, v, __ATOMIC_RELAXED, __HIP_MEMORY_SCOPE_AGENT); }
__device__ __forceinline__ unsigned xb_xcc_id() { return (unsigned)__builtin_amdgcn_s_getreg((3 << 11) | 20) & 0xFu; }
#define XB_SPIN(cond, bar) do { unsigned _sp = 0; while (cond) { __builtin_amdgcn_s_sleep(1); \
    if ((++_sp & 255u) == 0u) { if (xb_ld(&(bar)[XB_TMO])) break; if (_sp > XB_SPIN_CAP) { atomicAdd(&(bar)[XB_TMO], 1u); break; } } } } while (0)
struct XcdBarrier { unsigned* bar; unsigned x; volatile LAS unsigned* st; };
__device__ __forceinline__ XcdBarrier xcd_barrier_post(unsigned* bar, volatile LAS unsigned* st) {
    XcdBarrier b; b.bar = bar; b.x = xb_xcc_id(); b.st = st;
    if (threadIdx.x == 0) (void)xb_add(&bar[XB_XCNT(b.x)], 1u);
    return b;
}
__device__ __forceinline__ void xcd_barrier_complete(unsigned* bar, unsigned x, unsigned& nloc, unsigned& nx) {
    const unsigned G = gridDim.x * gridDim.y * gridDim.z;
    unsigned sum, cnt, mine, sp = 0u;
    for (;;) {
        sum = 0u; cnt = 0u; mine = 0u;
#pragma unroll
        for (unsigned j = 0; j < 16; ++j) { const unsigned c = xb_ld(&bar[XB_XCNT(j)]); sum += c; cnt += (c > 0u) ? 1u : 0u; mine = (j == x) ? c : mine; }
        if (sum == G) break;
        __builtin_amdgcn_s_sleep(1);
        if ((++sp & 255u) == 0u) { if (xb_ld(&bar[XB_TMO])) break; if (sp > XB_SPIN_CAP) { atomicAdd(&bar[XB_TMO], 1u); break; } }
    }
    nloc = mine > 0u ? mine : 1u; nx = cnt > 0u ? cnt : 1u;
}
__device__ __forceinline__ void xcd_barrier(const XcdBarrier& b) {
    asm volatile("s_waitcnt vmcnt(0)" ::: "memory");
    __syncthreads();
    if (threadIdx.x == 0) {
        unsigned* bar = b.bar;
        __builtin_amdgcn_s_waitcnt(0);
        unsigned nloc = b.st[0], nx = b.st[1];
        if (nloc == 0u) { xcd_barrier_complete(bar, b.x, nloc, nx); b.st[0] = nloc; b.st[1] = nx; }
        const unsigned old = xb_add(&bar[XB_XSUB(b.x)], 1u);
        const unsigned gen = old / nloc;
        if (old + 1u == (gen + 1u) * nloc) {
            __builtin_amdgcn_fence(__ATOMIC_RELEASE, "agent");
            asm volatile("s_waitcnt vmcnt(0)" ::: "memory");
            const unsigned og = xb_add(&bar[XB_TOP], 1u);
            const unsigned tg = og / nx;
            if (og + 1u == (tg + 1u) * nx) xb_add(&bar[XB_TOPGEN], 1u);
            else XB_SPIN(xb_ld(&bar[XB_TOPGEN]) == tg, bar);
            __builtin_amdgcn_fence(__ATOMIC_ACQUIRE, "agent");
            xb_add(&bar[XB_XGEN(b.x)], 1u);
            asm volatile("s_waitcnt vmcnt(0)" ::: "memory");
        } else {
            XB_SPIN(xb_ld(&bar[XB_XGEN(b.x)]) == gen, bar);
            __builtin_amdgcn_fence(__ATOMIC_ACQUIRE, "agent");
            asm volatile("s_waitcnt vmcnt(0)" ::: "memory");
        }
    }
    __syncthreads();
}

namespace pg8 {
constexpr int BM = 256, BK = 64, HALF = 128, HTB = HALF * BK * 2, STAGE_BYTES = 8 * HTB, NXCD = 8, WGM = 8;
__host__ __device__ __forceinline__ int lds_byte(int r, int c) { const int st = (r >> 4) * 2 + (c >> 5), rr = r & 15, cc = c & 31, ob = rr * 64 + cc * 2; return st * 1024 + (ob ^ (((ob >> 9) & 1) << 5)); }
__host__ __device__ __forceinline__ void stage_rc(int b, int& R, int& C) { const int st = b / 1024, sb = b % 1024, swz = sb ^ (((sb >> 9) & 1) << 5); R = (st >> 1) * 16 + swz / 64; C = (st & 1) * 32 + (swz % 64) / 2; }
__host__ __device__ __forceinline__ int perm32(int rho) { const int n = rho >> 4, i = rho & 15; return 8 * (i >> 2) + 4 * n + (i & 3); }

struct Unit { int pm, pn, e, mt; };

struct DenseOrder {
    int nM, nN, nwg, G, c; const bf16* Bt; int K;
    __device__ void init(int M, int N, int K_, const bf16* Bt_, int G_, int c_) { nM = M / BM; nN = N / BM; nwg = nM * nN; G = G_; c = c_; Bt = Bt_; K = K_; }
    __device__ bool next(int i, Unit& u) const {
        const long L = (long)i * G + c; if (L >= nwg) return false;
        int wgid = (int)L; { const int q = nwg / NXCD, r = nwg % NXCD, xcd = wgid % NXCD, off = wgid / NXCD; wgid = (xcd < r ? xcd * (q + 1) : r * (q + 1) + (xcd - r) * q) + off; }
        const int nig = WGM * nN, gid = wgid / nig, fm = gid * WGM, gsz = (nM - fm) < WGM ? (nM - fm) : WGM;
        u.pm = fm + ((wgid % nig) % gsz); u.pn = (wgid % nig) / gsz; u.e = 0; u.mt = 0; return true;
    }
    __device__ __forceinline__ int a_row(const Unit& u, int r) const { return u.pm * BM + r; }
    __device__ __forceinline__ const char* b_base(const Unit& u) const { return (const char*)Bt + (size_t)u.pn * BM * K * 2; }
};

struct MoeOrder {
    const LAS int* cnt; const LAS int* tstart; int c, G; const bf16* W; size_t wstride; int K; const unsigned* list; bool gather;
    __device__ bool next(int i, Unit& u) const {
        const int x = c & 7, j = c >> 3, per = (G - x + 7) >> 3;
        int L = i * per + j;
        int tl = L >> 2; const int pn = L & 3;
#pragma unroll
        for (int k = 0; k < 4; ++k) {
            const int e = x + 8 * k; const int nt = tstart[e + 1] - tstart[e];
            if (tl < nt) { u.e = e; u.mt = tl; u.pm = tstart[e] + tl; u.pn = pn; return true; }
            tl -= nt;
        }
        return false;
    }
    __device__ __forceinline__ int a_row(const Unit& u, int r) const {
        if (!gather) return u.pm * BM + r;
        const int idx = u.mt * BM + r;
        return idx < cnt[u.e] ? (int)(list[(size_t)u.e * LIST_CAP + idx] >> 1) : 0;
    }
    __device__ __forceinline__ const char* b_base(const Unit& u) const { return (const char*)W + ((size_t)u.e * wstride + (size_t)u.pn * BM * K) * 2; }
};

__device__ __forceinline__ f32x2 gelu_pk(f32x2 v) {
    const f32x2 av = __builtin_elementwise_abs(v), d = av * 0.2316418882f + 1.0f;
    f32x2 t; t.x = __builtin_amdgcn_rcpf(d.x); t.y = __builtin_amdgcn_rcpf(d.y);
    f32x2 q = t * 0.5307027145f + (-0.7265760135f); q = q * t + 0.7107068705f; q = q * t + (-0.142248368f); q = q * t + 0.127414796f; q = q * t;
    const f32x2 s = (v * v) * (-0.72134752044f);
    f32x2 e; e.x = __builtin_amdgcn_exp2f(s.x); e.y = __builtin_amdgcn_exp2f(s.y);
    const f32x2 m = v * (q * e), r = v - m;
    f32x2 o; o.x = v.x < 0.f ? m.x : r.x; o.y = v.y < 0.f ? m.y : r.y; return o;
}

typedef f32x4 Acc[2][2][4][2];

template <class Epi, class Sched, bool ALIGN_EPI>
__device__ __forceinline__ void gemm_phase(LAS unsigned char* lds, const bf16* A, const int K, const Sched& S, const Epi& E) {
    const int tid = threadIdx.x, wid = __builtin_amdgcn_readfirstlane(tid >> 6), lane = tid & 63, wr = wid >> 2, wc = wid & 3, fr = lane & 15, fq = lane >> 4;
    const int nt = K / BK;
    int Rr[2], Cc[2]; unsigned voffB[2];
#pragma unroll
    for (int i = 0; i < 2; ++i) { int R, C; stage_rc(tid * 16 + i * 8192, R, C); const int Rb = Epi::PERM ? ((R & ~31) + perm32(R & 31)) : R;
        Rr[i] = R; Cc[i] = C; voffB[i] = (unsigned)(Rb * K + C) * 2u; }
    const size_t kstep = (size_t)(BK * 2);
    const size_t hstep = (size_t)HALF * K * 2;
    const unsigned ldsw = (unsigned)wid * 1024u;
    const int aoff = lds_byte(wr * 64 + fr, fq * 8), boff = lds_byte(wc * 32 + fr, fq * 8);
#define PG8_SA(b, h) (((b) * 2 + (h)) * HTB)
#define PG8_SB(b, h) ((4 + (b) * 2 + (h)) * HTB)
#define PG8_STAGE(bufoff, gbase, voff) do { _Pragma("unroll") for (int _i = 0; _i < 2; ++_i) \
        __builtin_amdgcn_global_load_lds((const unsigned*)((const char*)(gbase) + (voff)[_i]), (LAS unsigned*)(lds + (bufoff) + ldsw + _i * 8192), 16, 0, 0); } while (0)
#define PG8_LDA(dst, b, h) do { _Pragma("unroll") for (int m = 0; m < 4; ++m) _Pragma("unroll") for (int k = 0; k < 2; ++k) dst[m][k] = *(const LAS bf16x8*)(lds + PG8_SA(b, h) + aoff + m * 2048 + k * 1024); } while (0)
#define PG8_LDB(dst, b, h) do { _Pragma("unroll") for (int n = 0; n < 2; ++n) _Pragma("unroll") for (int k = 0; k < 2; ++k) dst[n][k] = *(const LAS bf16x8*)(lds + PG8_SB(b, h) + boff + n * 2048 + k * 1024); } while (0)
#define PG8_MMA(ai, bj, At, Bt) do { __builtin_amdgcn_s_setprio(1); _Pragma("unroll") for (int m = 0; m < 4; ++m) _Pragma("unroll") for (int n = 0; n < 2; ++n) _Pragma("unroll") for (int k = 0; k < 2; ++k) \
        acc[ai][bj][m][n] = __builtin_amdgcn_mfma_f32_16x16x32_bf16(Bt[n][k], At[m][k], acc[ai][bj][m][n], 0, 0, 0); __builtin_amdgcn_s_setprio(0); } while (0)
#define PG8_WAIT_V(n) asm volatile("s_waitcnt vmcnt(" #n ")" ::: "memory")
#define PG8_WAIT_L(n) asm volatile("s_waitcnt lgkmcnt(" #n ")" ::: "memory")
#define PG8_BAR __builtin_amdgcn_s_barrier()
#define PG8_SCHED __builtin_amdgcn_sched_barrier(0)
#define PG8_VOFF(dst, u) do { _Pragma("unroll") for (int _h = 0; _h < 2; ++_h) _Pragma("unroll") for (int _i = 0; _i < 2; ++_i) \
        dst[_h][_i] = (unsigned)(S.a_row(u, _h * HALF + Rr[_i]) * K + Cc[_i]) * 2u; \
        asm volatile("" : "+v"(dst[0][0]), "+v"(dst[0][1]), "+v"(dst[1][0]), "+v"(dst[1][1])); } while (0)
    Unit cur, nxt; int ui = 0;
    if (!S.next(0, cur)) return;
    Acc acc;
#pragma unroll
    for (int a = 0; a < 2; ++a)
#pragma unroll
        for (int b = 0; b < 2; ++b)
#pragma unroll
            for (int m = 0; m < 4; ++m)
#pragma unroll
                for (int n = 0; n < 2; ++n) acc[a][b][m][n] = (f32x4){0.f, 0.f, 0.f, 0.f};
    bf16x8 At[4][2], B0[2][2], B1[2][2];
    unsigned vc[2][2], vn[2][2];
    PG8_VOFF(vc, cur);
    const char* const cA = (const char*)A;
    const char* cB = S.b_base(cur);
    PG8_STAGE(PG8_SB(0, 0), cB, voffB); PG8_STAGE(PG8_SB(0, 1), cB + hstep, voffB); PG8_STAGE(PG8_SA(0, 0), cA, vc[0]); PG8_STAGE(PG8_SA(0, 1), cA, vc[1]);
    if (wr == 1) PG8_BAR;
    PG8_WAIT_V(2); PG8_BAR;
    PG8_STAGE(PG8_SB(1, 0), cB + kstep, voffB); PG8_STAGE(PG8_SA(1, 0), cA + kstep, vc[0]); PG8_STAGE(PG8_SB(1, 1), cB + hstep + kstep, voffB);
    PG8_WAIT_V(6); PG8_BAR;
    for (;;) {
        const bool has_next = S.next(ui + 1, nxt);
        if (has_next) { PG8_VOFF(vn, nxt); } else {
#pragma unroll
            for (int h = 0; h < 2; ++h)
#pragma unroll
                for (int i = 0; i < 2; ++i) vn[h][i] = vc[h][i]; }
        const char* nB = has_next ? S.b_base(nxt) : cB;
        for (int t = 0; t < nt; t += 2) {
            const bool last = (t == nt - 2);
            const char* a1 = cA + (size_t)(t + 1) * kstep;
            const char* a2 = last ? cA : cA + (size_t)(t + 2) * kstep; const char* b2 = last ? nB : cB + (size_t)(t + 2) * kstep;
            const char* a3 = a2 + kstep; const char* b3 = b2 + kstep;
            unsigned v2[2][2];
#pragma unroll
            for (int h = 0; h < 2; ++h)
#pragma unroll
                for (int i = 0; i < 2; ++i) v2[h][i] = last ? vn[h][i] : vc[h][i];
            PG8_LDB(B0, 0, 0); PG8_LDB(B1, 0, 1); PG8_SCHED; PG8_LDA(At, 0, 0); PG8_STAGE(PG8_SA(1, 1), a1, vc[1]);
            PG8_WAIT_V(8); PG8_WAIT_L(0); PG8_BAR; PG8_MMA(0, 0, At, B0); PG8_MMA(0, 1, At, B1); PG8_BAR; PG8_SCHED;
            PG8_LDA(At, 0, 1); PG8_STAGE(PG8_SB(0, 0), b2, voffB); PG8_STAGE(PG8_SB(0, 1), b2 + hstep, voffB); PG8_STAGE(PG8_SA(0, 0), a2, v2[0]);
            PG8_WAIT_V(8); PG8_WAIT_L(0); PG8_BAR; PG8_MMA(1, 0, At, B0); PG8_MMA(1, 1, At, B1); PG8_BAR; PG8_SCHED;
            PG8_LDB(B0, 1, 0); PG8_LDB(B1, 1, 1); PG8_SCHED; PG8_LDA(At, 1, 0); PG8_STAGE(PG8_SA(0, 1), a2, v2[1]);
            PG8_WAIT_V(8); PG8_WAIT_L(0); PG8_BAR; PG8_MMA(0, 0, At, B0); PG8_MMA(0, 1, At, B1); PG8_BAR; PG8_SCHED;
            PG8_LDA(At, 1, 1); PG8_STAGE(PG8_SB(1, 0), b3, voffB); PG8_STAGE(PG8_SB(1, 1), b3 + hstep, voffB); PG8_STAGE(PG8_SA(1, 0), a3, v2[0]);
            PG8_WAIT_V(8); PG8_WAIT_L(0); PG8_BAR; PG8_MMA(1, 0, At, B0); PG8_MMA(1, 1, At, B1); PG8_BAR; PG8_SCHED;
        }
        if constexpr (ALIGN_EPI) { if (wr == 0) PG8_BAR; }
        E(acc, cur, wr, wc, fr, fq);
        if (!has_next) break;
#pragma unroll
        for (int a = 0; a < 2; ++a)
#pragma unroll
            for (int b = 0; b < 2; ++b)
#pragma unroll
                for (int m = 0; m < 4; ++m)
#pragma unroll
                    for (int n = 0; n < 2; ++n) acc[a][b][m][n] = (f32x4){0.f, 0.f, 0.f, 0.f};
        cur = nxt; cB = nB; ++ui;
#pragma unroll
        for (int h = 0; h < 2; ++h)
#pragma unroll
            for (int i = 0; i < 2; ++i) vc[h][i] = vn[h][i];
        if constexpr (ALIGN_EPI) { if (wr == 1) PG8_BAR; }
    }
    PG8_WAIT_V(0);
    if constexpr (!ALIGN_EPI) { if (wr == 0) PG8_BAR; }
    PG8_BAR;
#undef PG8_SA
#undef PG8_SB
#undef PG8_STAGE
#undef PG8_LDA
#undef PG8_LDB
#undef PG8_MMA
#undef PG8_WAIT_V
#undef PG8_WAIT_L
#undef PG8_BAR
#undef PG8_SCHED
#undef PG8_VOFF
}

struct EpiEvenIn {
    static constexpr bool PERM = true;
    bf16 *U, *GV, *Q, *Kb, *VT;
    __device__ __forceinline__ void operator()(const Acc& acc, const Unit& u, int wr, int wc, int fr, int fq) const {
        const int sel = u.pn >> 1;
        const int row0 = u.pm * BM + wr * 64 + fr;
        const int colt = (u.pn & 1) * BM + wc * 32 + 8 * fq;
        if (sel < 4) {
            bf16* base = sel == 0 ? U : sel == 1 ? GV : sel == 2 ? Q : Kb;
#pragma unroll
            for (int ai = 0; ai < 2; ++ai)
#pragma unroll
                for (int m = 0; m < 4; ++m) { bf16* rowp = base + (size_t)(row0 + ai * HALF + m * 16) * GW + colt;
#pragma unroll
                    for (int bj = 0; bj < 2; ++bj) { f32x4 v0 = acc[ai][bj][m][0], v1 = acc[ai][bj][m][1];
                        if (sel < 2) { f32x2 a = gelu_pk((f32x2){v0[0], v0[1]}), b = gelu_pk((f32x2){v0[2], v0[3]}), c = gelu_pk((f32x2){v1[0], v1[1]}), d = gelu_pk((f32x2){v1[2], v1[3]});
                            v0 = (f32x4){a.x, a.y, b.x, b.y}; v1 = (f32x4){c.x, c.y, d.x, d.y}; }
                        v4u w; w.x = cvt_pk_bf16(v0[0], v0[1]); w.y = cvt_pk_bf16(v0[2], v0[3]); w.z = cvt_pk_bf16(v1[0], v1[1]); w.w = cvt_pk_bf16(v1[2], v1[3]);
                        *(v4u*)(rowp + bj * HALF) = w; } }
        } else {
#pragma unroll
            for (int ai = 0; ai < 2; ++ai)
#pragma unroll
                for (int m = 0; m < 4; ++m) { const int tok = row0 + ai * HALF + m * 16; const int b = tok / SEQ, t = tok % SEQ;
#pragma unroll
                    for (int bj = 0; bj < 2; ++bj) { const int c0 = colt + bj * HALF;
#pragma unroll
                        for (int n = 0; n < 2; ++n)
#pragma unroll
                            for (int j = 0; j < 4; ++j) { const int c = c0 + 4 * n + j;
                                VT[((size_t)(b * NH) * HD + c) * SEQ + t] = (bf16)f2bf(acc[ai][bj][m][n][j]); } } }
        }
    }
};
struct EpiResF32 {
    static constexpr bool PERM = false;
    const float* R; float* X;
    __device__ __forceinline__ void operator()(const Acc& acc, const Unit& u, int wr, int wc, int fr, int fq) const {
        const int row0 = u.pm * BM + wr * 64 + fr, col0 = u.pn * BM + wc * 32 + 4 * fq;
#pragma unroll
        for (int ai = 0; ai < 2; ++ai)
#pragma unroll
            for (int m = 0; m < 4; ++m) { const size_t off = (size_t)(row0 + ai * HALF + m * 16) * D + col0;
#pragma unroll
                for (int bj = 0; bj < 2; ++bj)
#pragma unroll
                    for (int n = 0; n < 2; ++n) { const f32x4 r = *(const f32x4*)(R + off + bj * HALF + n * 16); *(f32x4*)(X + off + bj * HALF + n * 16) = r + acc[ai][bj][m][n]; } }
    }
};
struct EpiOddIn {
    static constexpr bool PERM = true;
    bf16 *Y, *GB;
    __device__ __forceinline__ void operator()(const Acc& acc, const Unit& u, int wr, int wc, int fr, int fq) const {
        const int row0 = u.pm * BM + wr * 64 + fr;
        if (u.pn < 8) {
            const int col = u.pn * HALF + wc * 32 + 8 * fq;
#pragma unroll
            for (int ai = 0; ai < 2; ++ai)
#pragma unroll
                for (int m = 0; m < 4; ++m) { const f32x4 v0 = acc[ai][0][m][0] * acc[ai][1][m][0], v1 = acc[ai][0][m][1] * acc[ai][1][m][1];
                    v4u w; w.x = cvt_pk_bf16(v0[0], v0[1]); w.y = cvt_pk_bf16(v0[2], v0[3]); w.z = cvt_pk_bf16(v1[0], v1[1]); w.w = cvt_pk_bf16(v1[2], v1[3]);
                    *(v4u*)(Y + (size_t)(row0 + ai * HALF + m * 16) * D + col) = w; }
        } else {
            const int col = (u.pn - 8) * BM + wc * 32 + 8 * fq;
#pragma unroll
            for (int ai = 0; ai < 2; ++ai)
#pragma unroll
                for (int m = 0; m < 4; ++m)
#pragma unroll
                    for (int bj = 0; bj < 2; ++bj) { const f32x4 v0 = acc[ai][bj][m][0], v1 = acc[ai][bj][m][1];
                        v4u w; w.x = cvt_pk_bf16(v0[0], v0[1]); w.y = cvt_pk_bf16(v0[2], v0[3]); w.z = cvt_pk_bf16(v1[0], v1[1]); w.w = cvt_pk_bf16(v1[2], v1[3]);
                        *(v4u*)(GB + (size_t)(row0 + ai * HALF + m * 16) * D + col + bj * HALF) = w; }
        }
    }
};
struct EpiMoeUp {
    static constexpr bool PERM = true;
    bf16* HM;
    __device__ __forceinline__ void operator()(const Acc& acc, const Unit& u, int wr, int wc, int fr, int fq) const {
        const int row0 = u.pm * BM + wr * 64 + fr, col = u.pn * HALF + wc * 32 + 8 * fq;
#pragma unroll
        for (int ai = 0; ai < 2; ++ai)
#pragma unroll
            for (int m = 0; m < 4; ++m) { float o[8];
#pragma unroll
                for (int n = 0; n < 2; ++n)
#pragma unroll
                    for (int j = 0; j < 4; ++j) { const float g = acc[ai][0][m][n][j], up = acc[ai][1][m][n][j];
                        o[4 * n + j] = g * __builtin_amdgcn_rcpf(1.0f + __builtin_amdgcn_exp2f(-1.44269504089f * g)) * up; }
                v4u w; w.x = cvt_pk_bf16(o[0], o[1]); w.y = cvt_pk_bf16(o[2], o[3]); w.z = cvt_pk_bf16(o[4], o[5]); w.w = cvt_pk_bf16(o[6], o[7]);
                *(v4u*)(HM + (size_t)(row0 + ai * HALF + m * 16) * FF + col) = w; }
    }
};
struct EpiMoeDown {
    static constexpr bool PERM = true;
    bf16* CONTRIB; const unsigned* list; const float* selw; const LAS int* cnt;
    __device__ __forceinline__ void operator()(const Acc& acc, const Unit& u, int wr, int wc, int fr, int fq) const {
        const int n_e = cnt[u.e]; const unsigned* le = list + (size_t)u.e * LIST_CAP + u.mt * BM;
        const int col = u.pn * BM + wc * 32 + 8 * fq;
#pragma unroll
        for (int ai = 0; ai < 2; ++ai)
#pragma unroll
            for (int m = 0; m < 4; ++m) { const int r = ai * HALF + wr * 64 + m * 16 + fr;
                if (u.mt * BM + r < n_e) { const unsigned ent = le[r]; const float w = selw[ent];
                    bf16* rowp = CONTRIB + ((size_t)(ent & 1u) * T + (ent >> 1)) * D + col;
#pragma unroll
                    for (int bj = 0; bj < 2; ++bj) { const f32x4 v0 = acc[ai][bj][m][0] * w, v1 = acc[ai][bj][m][1] * w;
                        v4u o; o.x = cvt_pk_bf16(v0[0], v0[1]); o.y = cvt_pk_bf16(v0[2], v0[3]); o.z = cvt_pk_bf16(v1[0], v1[1]); o.w = cvt_pk_bf16(v1[2], v1[3]);
                        *(v4u*)(rowp + bj * HALF) = o; } } }
    }
};
}

struct Frame {
    LAS unsigned char* lds;
    volatile LAS unsigned* MISC;
    gu32* ctl;
    int tid, lane, wave, vcu, G;
};

__device__ __forceinline__ void p0_transpose_item(const float* W, int K, int N, bf16* WT, int k0, int n0, int orow0, LAS float* scr, int lane) {
#pragma unroll 8
    for (int i = 0; i < 32; ++i) { const int kk = 2 * i + (lane >> 5); scr[kk * 33 + (lane & 31)] = W[(size_t)(k0 + kk) * N + n0 + (lane & 31)]; }
    LDS_WAIT(); asm volatile("" ::: "memory");
    const int c = lane & 7;
#pragma unroll
    for (int j = 0; j < 4; ++j) { const int n = (lane >> 3) + 8 * j; const LAS float* s = scr + (8 * c) * 33 + n;
        v4u o; o.x = pk2(s[0 * 33], s[1 * 33]); o.y = pk2(s[2 * 33], s[3 * 33]); o.z = pk2(s[4 * 33], s[5 * 33]); o.w = pk2(s[6 * 33], s[7 * 33]);
        *(GAS v4u*)(WT + (size_t)(orow0 + n) * K + k0 + 8 * c) = o; }
    LDS_WAIT(); asm volatile("" ::: "memory");
}
__device__ __forceinline__ void norm_row(int lane, const float* xrow, const bf16* c0, const bf16* c1, const float* gain, float* xs, bf16* ob, float* of32) {
    const GAS f32x4* xr = (const GAS f32x4*)xrow + lane;
    f32x4 v[4]; float s = 0.f;
#pragma unroll
    for (int j = 0; j < 4; ++j) v[j] = xr[64 * j];
    if (c0) {
#pragma unroll
        for (int j = 0; j < 4; ++j) { const v2u a = *((const GAS v2u*)c0 + lane + 64 * j), b = *((const GAS v2u*)c1 + lane + 64 * j);
            v[j].x += bf_lo(a.x) + bf_lo(b.x); v[j].y += bf_hi(a.x) + bf_hi(b.x); v[j].z += bf_lo(a.y) + bf_lo(b.y); v[j].w += bf_hi(a.y) + bf_hi(b.y); }
    }
#pragma unroll
    for (int j = 0; j < 4; ++j) s += (v[j].x * v[j].x + v[j].y * v[j].y) + (v[j].z * v[j].z + v[j].w * v[j].w);
    if (xs) {
#pragma unroll
        for (int j = 0; j < 4; ++j) *((GAS f32x4*)xs + lane + 64 * j) = v[j]; }
    const float rstd = rsqrtf(wave_sum(s) * (1.f / D) + EPS);
#pragma unroll
    for (int j = 0; j < 4; ++j) { const f32x4 g = *((const GAS f32x4*)gain + lane + 64 * j); v[j] = v[j] * rstd * g; }
    if (ob) {
#pragma unroll
        for (int j = 0; j < 4; ++j) { v2u o; o.x = pk2(v[j].x, v[j].y); o.y = pk2(v[j].z, v[j].w); *((GAS v2u*)ob + lane + 64 * j) = o; } }
    if (of32) {
#pragma unroll
        for (int j = 0; j < 4; ++j) *((GAS f32x4*)of32 + lane + 64 * j) = v[j]; }
}

struct Args { const float* in[17]; float* out; unsigned char* ws; unsigned mask; int single; };

__device__ __forceinline__ void phase_prologue(Frame& F, const Args& a) {
    LAS float* scr = (LAS float*)(F.lds + F.wave * 16384);
    const int gw = F.vcu * NWAVES + F.wave, NGW = F.G * NWAVES;
    unsigned char* ws = a.ws;
    constexpr int I_IN0 = 16 * (EVEN_IN / 32), I_OUT = 16 * (D / 32), I_IN1 = 16 * (ODD_IN / 32);
    constexpr int I_G = 16 * (FF / 32), I_D = 8 * (D / 32), I_E = 2 * I_G + I_D;
    constexpr int I_DENSE = I_IN0 + 2 * I_OUT + I_IN1, NITEMS = I_DENSE + 2 * NEXP * I_E;
    for (int it = gw; it < NITEMS; it += NGW) {
        int r = it;
        if (r < I_IN0) { const int nb = EVEN_IN / 32; p0_transpose_item(a.in[1], D, EVEN_IN, (bf16*)(ws + WS_WIN0), 64 * (r / nb), 32 * (r % nb), 32 * (r % nb), scr, F.lane); continue; } r -= I_IN0;
        if (r < I_OUT) { const int nb = D / 32; p0_transpose_item(a.in[2], D, D, (bf16*)(ws + WS_WOUT0), 64 * (r / nb), 32 * (r % nb), 32 * (r % nb), scr, F.lane); continue; } r -= I_OUT;
        if (r < I_IN1) { const int nb = ODD_IN / 32; const int n0 = 32 * (r % nb);
            const int sec = n0 / D, c = n0 % D; const int orow = sec == 0 ? 2048 + c : 256 * (c / 128) + (sec == 2 ? 128 : 0) + (c % 128);
            p0_transpose_item(a.in[6], D, ODD_IN, (bf16*)(ws + WS_WIN1), 64 * (r / nb), n0, orow, scr, F.lane); continue; } r -= I_IN1;
        if (r < I_OUT) { const int nb = D / 32; p0_transpose_item(a.in[8], D, D, (bf16*)(ws + WS_WOUT1), 64 * (r / nb), 32 * (r % nb), 32 * (r % nb), scr, F.lane); continue; } r -= I_OUT;
        const int le = r / I_E; r -= le * I_E;
        if (r < 2 * I_G) { const int up = r >= I_G; if (up) r -= I_G; const int nb = FF / 32; const int n0 = 32 * (r % nb);
            const float* W = (up ? a.in[14] : a.in[13]) + (size_t)le * D * FF;
            p0_transpose_item(W, D, FF, (bf16*)(ws + WS_WGU) + (size_t)le * 1024 * D, 64 * (r / nb), n0, 256 * (n0 / 128) + (up ? 128 : 0) + (n0 % 128), scr, F.lane); continue; }
        r -= 2 * I_G;
        { const int nb = D / 32; p0_transpose_item(a.in[15] + (size_t)le * FF * D, FF, D, (bf16*)(ws + WS_WD) + (size_t)le * D * FF, 64 * (r / nb), 32 * (r % nb), 32 * (r % nb), scr, F.lane); }
    }
    { const float* wsrc = a.in[3]; bf16* wt = (bf16*)(ws + WS_WTRIL);
      for (int i = (F.vcu * 512 + F.tid) * 4; i < NG * CHUNK * CHUNK; i += F.G * 512 * 4) { const int t = (i / CHUNK) % CHUNK, s = i % CHUNK; const f32x4 v = *(const f32x4*)(wsrc + i);
          v2u o; o.x = pk2(s <= t ? v.x : 0.f, s + 1 <= t ? v.y : 0.f); o.y = pk2(s + 2 <= t ? v.z : 0.f, s + 3 <= t ? v.w : 0.f); *(v2u*)(wt + i) = o; } }
    for (int m = gw; m < T; m += NGW) norm_row(F.lane, a.in[0] + (size_t)m * D, nullptr, nullptr, a.in[9], nullptr, (bf16*)(ws + WS_H) + (size_t)m * D, nullptr);
}

__device__ __forceinline__ void gmlp_unit(Frame& F, const Args& a, int unit) {
    unsigned char* ws = a.ws;
    const bf16* U = (const bf16*)(ws + WS_ACT); const bf16* GV = U + (size_t)T * GW; const bf16* WT = (const bf16*)(ws + WS_WTRIL); bf16* MIX = (bf16*)(ws + WS_MIX);
    const int g = unit % NG, n = (unit / NG) % (SEQ / CHUNK), b = unit / (NG * (SEQ / CHUNK));
    const int tok0 = b * SEQ + n * CHUNK;
    constexpr int VSTR = 136;
    LAS bf16* vnT = (LAS bf16*)F.lds;
    { const int s = F.tid >> 2, cg = F.tid & 3;
      const v4u r0 = *(const v4u*)(GV + (size_t)(tok0 + s) * GW + g * GD + 16 * cg), r1 = *(const v4u*)(GV + (size_t)(tok0 + s) * GW + g * GD + 16 * cg + 8);
      float v[16]; const unsigned w[8] = {r0.x, r0.y, r0.z, r0.w, r1.x, r1.y, r1.z, r1.w};
#pragma unroll
      for (int i = 0; i < 8; ++i) { v[2 * i] = bf_lo(w[i]); v[2 * i + 1] = bf_hi(w[i]); }
      float ss = 0.f;
#pragma unroll
      for (int i = 0; i < 16; ++i) ss += v[i] * v[i];
      ss += __shfl_xor(ss, 1); ss += __shfl_xor(ss, 2);
      const float rstd = rsqrtf(ss * (1.0f / GD) + EPS);
      const float* gn = a.in[5] + g * GD + 16 * cg;
#pragma unroll
      for (int i = 0; i < 16; ++i) vnT[(16 * cg + i) * VSTR + s] = (bf16)f2bf(v[i] * rstd * gn[i]); }
    __syncthreads();
    { const int db = F.wave & 1, tb = F.wave >> 1, r = F.lane & 31, h = F.lane >> 5;
      f32x16 x;
_Pragma("unroll") for (int i = 0; i < 16; ++i) x[i] = 0.f;
      const bf16* wrow = WT + ((size_t)g * CHUNK + 32 * tb + r) * CHUNK + 8 * h;
      const LAS bf16* vrow = vnT + (32 * db + r) * VSTR + 8 * h;
      for (int kk = 0; kk < 2 * (tb + 1); ++kk) {
          const bf16x8 av = *(const LAS bf16x8*)(vrow + 16 * kk);
          const bf16x8 bw = *(const bf16x8*)(wrow + 16 * kk);
          x = __builtin_amdgcn_mfma_f32_32x32x16_bf16(av, bw, x, 0, 0, 0);
      }
      const int t = 32 * tb + r; const float bias = a.in[4][g * CHUNK + t];
      const bf16* urow = U + (size_t)(tok0 + t) * GW + g * GD + 32 * db + 4 * h; bf16* orow = MIX + (size_t)(tok0 + t) * D + g * GD + 32 * db + 4 * h;
#pragma unroll
      for (int q = 0; q < 4; ++q) { const v2u uu = *(const v2u*)(urow + 8 * q);
          v2u o; o.x = pk2(bf_lo(uu.x) * (x[4 * q] + bias), bf_hi(uu.x) * (x[4 * q + 1] + bias)); o.y = pk2(bf_lo(uu.y) * (x[4 * q + 2] + bias), bf_hi(uu.y) * (x[4 * q + 3] + bias));
          *(v2u*)(orow + 8 * q) = o; } }
    __syncthreads();
}

template <bool DIAG>
__device__ __forceinline__ void sb_tile(const f32x16& s, float& carry, bf16x8& p0, bf16x8& p1, int r, int hh) {
    float l[16], lk[16];
#pragma unroll
    for (int i = 0; i < 16; ++i) {
        const float n = fminf(s[i] * (-0.125f * 1.44269504089f), 126.0f);
        const float e = __builtin_amdgcn_exp2f(n);
        l[i] = __builtin_amdgcn_logf(1.0f + e);
        lk[i] = n - l[i];
        if (DIAG) { const int key = 16 * (i >> 3) + 8 * hh + (i & 7); if (key >= r) lk[i] = 0.f; }
    }
    float suf[16]; float run0 = 0.f, run1 = 0.f;
#pragma unroll
    for (int j = 7; j >= 0; --j) { suf[j] = run0; run0 += lk[j]; suf[8 + j] = run1; run1 += lk[8 + j]; }
    const float o0 = __shfl_xor(run0, 32), o1 = __shfl_xor(run1, 32);
    const float afterA = hh == 0 ? (o0 + run1 + o1) : (o1 + run1);
    const float afterB = hh == 0 ? o1 : 0.f;
    float pa[16];
#pragma unroll
    for (int i = 0; i < 16; ++i) {
        const float arg = carry + (i < 8 ? afterA : afterB) + suf[i] - l[i];
        pa[i] = __builtin_amdgcn_exp2f(arg);
        if (DIAG) { const int key = 16 * (i >> 3) + 8 * hh + (i & 7); if (key >= r) pa[i] = 0.f; }
    }
    carry += (run0 + run1) + (o0 + o1);
    v4u w0, w1;
    w0.x = cvt_pk_bf16(pa[0], pa[1]); w0.y = cvt_pk_bf16(pa[2], pa[3]); w0.z = cvt_pk_bf16(pa[4], pa[5]); w0.w = cvt_pk_bf16(pa[6], pa[7]);
    w1.x = cvt_pk_bf16(pa[8], pa[9]); w1.y = cvt_pk_bf16(pa[10], pa[11]); w1.z = cvt_pk_bf16(pa[12], pa[13]); w1.w = cvt_pk_bf16(pa[14], pa[15]);
    p0 = __builtin_bit_cast(bf16x8, w0); p1 = __builtin_bit_cast(bf16x8, w1);
}
__device__ __forceinline__ void sb_task(const Args& a, int lane, int bh, int qblk) {
    unsigned char* ws = a.ws;
    const bf16* Q = (const bf16*)(ws + WS_ACT) + (size_t)2 * T * GW; const bf16* Kb = Q + (size_t)T * SBW; const bf16* VT = Kb + (size_t)T * SBW; bf16* MIX = (bf16*)(ws + WS_MIX);
    const int b = bh / NH, h = bh % NH, r = lane & 31, hh = lane >> 5;
    const int q0 = qblk * 32;
    const int kap = (r & ~12) | ((r & 4) << 1) | ((r & 8) >> 1);
    bf16x8 qf[4];
    { const bf16* qp = Q + (size_t)(b * SEQ + q0 + r) * SBW + h * HD + 8 * hh;
#pragma unroll
      for (int kk = 0; kk < 4; ++kk) qf[kk] = *(const bf16x8*)(qp + 16 * kk); }
    const bf16* kbase = Kb + (size_t)(b * SEQ + kap) * SBW + h * HD + 8 * hh;
    const bf16* vbase = VT + ((size_t)bh * HD + r) * SEQ + 8 * hh;
    f32x16 o0, o1;
_Pragma("unroll") for (int i = 0; i < 16; ++i) { o0[i] = 0.f; o1[i] = 0.f; }
    float carry = 0.f;
    bf16x8 kf[4], vf[2][2];
    int k0 = q0;
#pragma unroll
    for (int kk = 0; kk < 4; ++kk) kf[kk] = *(const bf16x8*)(kbase + (size_t)k0 * SBW + 16 * kk);
#pragma unroll
    for (int db = 0; db < 2; ++db)
#pragma unroll
        for (int s = 0; s < 2; ++s) vf[db][s] = *(const bf16x8*)(vbase + (size_t)(32 * db) * SEQ + k0 + 16 * s);
    bool diag = true;
    for (;;) {
        f32x16 sc;
_Pragma("unroll") for (int i = 0; i < 16; ++i) sc[i] = 0.f;
#pragma unroll
        for (int kk = 0; kk < 4; ++kk) sc = __builtin_amdgcn_mfma_f32_32x32x16_bf16(kf[kk], qf[kk], sc, 0, 0, 0);
        bf16x8 vcur[2][2];
#pragma unroll
        for (int db = 0; db < 2; ++db)
#pragma unroll
            for (int s = 0; s < 2; ++s) vcur[db][s] = vf[db][s];
        const int kn = k0 - 32;
        if (kn >= 0) {
#pragma unroll
            for (int kk = 0; kk < 4; ++kk) kf[kk] = *(const bf16x8*)(kbase + (size_t)kn * SBW + 16 * kk);
#pragma unroll
            for (int db = 0; db < 2; ++db)
#pragma unroll
                for (int s = 0; s < 2; ++s) vf[db][s] = *(const bf16x8*)(vbase + (size_t)(32 * db) * SEQ + kn + 16 * s);
        }
        bf16x8 p0, p1;
        if (diag) sb_tile<true>(sc, carry, p0, p1, r, hh); else sb_tile<false>(sc, carry, p0, p1, r, hh);
        diag = false;
        o0 = __builtin_amdgcn_mfma_f32_32x32x16_bf16(vcur[0][0], p0, o0, 0, 0, 0);
        o0 = __builtin_amdgcn_mfma_f32_32x32x16_bf16(vcur[0][1], p1, o0, 0, 0, 0);
        o1 = __builtin_amdgcn_mfma_f32_32x32x16_bf16(vcur[1][0], p0, o1, 0, 0, 0);
        o1 = __builtin_amdgcn_mfma_f32_32x32x16_bf16(vcur[1][1], p1, o1, 0, 0, 0);
        if (kn < 0) break;
        if (__all(carry < -150.0f)) break;
        k0 = kn;
    }
    bf16* orow = MIX + (size_t)(b * SEQ + q0 + r) * D + GW + h * HD + 4 * hh;
#pragma unroll
    for (int q = 0; q < 4; ++q) {
        v2u w; w.x = cvt_pk_bf16(o0[4 * q], o0[4 * q + 1]); w.y = cvt_pk_bf16(o0[4 * q + 2], o0[4 * q + 3]); *(v2u*)(orow + 8 * q) = w;
        v2u w2; w2.x = cvt_pk_bf16(o1[4 * q], o1[4 * q + 1]); w2.y = cvt_pk_bf16(o1[4 * q + 2], o1[4 * q + 3]); *(v2u*)(orow + 32 + 8 * q) = w2;
    }
}

__device__ __forceinline__ void route_row(const Args& a, int lane, int layer, int tok, const float* X, bf16* H, unsigned* cntw, unsigned* list, float* selw) {
    const GAS f32x4* xr = (const GAS f32x4*)(X + (size_t)tok * D) + lane;
    f32x4 v[4]; float s = 0.f;
#pragma unroll
    for (int j = 0; j < 4; ++j) { v[j] = xr[64 * j]; s += (v[j].x * v[j].x + v[j].y * v[j].y) + (v[j].z * v[j].z + v[j].w * v[j].w); }
    const float rstd = rsqrtf(wave_sum(s) * (1.f / D) + EPS);
    const float* gain = a.in[10] + layer * D;
#pragma unroll
    for (int j = 0; j < 4; ++j) { const f32x4 g = *((const GAS f32x4*)gain + lane + 64 * j); v[j] = v[j] * rstd * g;
        v2u o; o.x = pk2(v[j].x, v[j].y); o.y = pk2(v[j].z, v[j].w); *((GAS v2u*)(H + (size_t)tok * D) + lane + 64 * j) = o; }
    const float* wrg = a.in[11] + (size_t)layer * D * NGRP;
    f32x4 ga = {0.f, 0.f, 0.f, 0.f};
#pragma unroll
    for (int j = 0; j < 4; ++j) { const int k = 4 * (lane + 64 * j);
        ga += v[j].x * *(const f32x4*)(wrg + (size_t)k * 4) + v[j].y * *(const f32x4*)(wrg + (size_t)(k + 1) * 4) + v[j].z * *(const f32x4*)(wrg + (size_t)(k + 2) * 4) + v[j].w * *(const f32x4*)(wrg + (size_t)(k + 3) * 4); }
    float gl[4] = {wave_sum(ga.x), wave_sum(ga.y), wave_sum(ga.z), wave_sum(ga.w)};
    int tg = 0; float mx = gl[0];
#pragma unroll
    for (int g = 1; g < NGRP; ++g) if (gl[g] > mx) { mx = gl[g]; tg = g; }
    float den = 0.f;
#pragma unroll
    for (int g = 0; g < NGRP; ++g) den += __expf(gl[g] - mx);
    const float top_gp = 1.0f / den;
    const float* wre = a.in[12] + ((size_t)layer * NGRP + tg) * D * EPG;
    f32x4 ea = {0.f, 0.f, 0.f, 0.f}, eb = {0.f, 0.f, 0.f, 0.f};
#pragma unroll
    for (int j = 0; j < 4; ++j) { const int k = 4 * (lane + 64 * j);
#pragma unroll
        for (int c = 0; c < 4; ++c) { const float hv = v[j][c]; ea += hv * *(const f32x4*)(wre + (size_t)(k + c) * 8); eb += hv * *(const f32x4*)(wre + (size_t)(k + c) * 8 + 4); } }
    float el[8] = {wave_sum(ea.x), wave_sum(ea.y), wave_sum(ea.z), wave_sum(ea.w), wave_sum(eb.x), wave_sum(eb.y), wave_sum(eb.z), wave_sum(eb.w)};
    int e0 = 0; float l0 = el[0];
#pragma unroll
    for (int e = 1; e < EPG; ++e) if (el[e] > l0) { l0 = el[e]; e0 = e; }
    int e1 = -1; float l1 = -INFINITY;
#pragma unroll
    for (int e = 0; e < EPG; ++e) if (e != e0 && el[e] > l1) { l1 = el[e]; e1 = e; }
    const float p1 = __expf(l1 - l0), inv = 1.0f / (1.0f + p1);
    if (lane < 2) {
        const int e = tg * EPG + (lane == 0 ? e0 : e1);
        const unsigned pos = __hip_atomic_fetch_add(cntw + (layer * NEXP + e) * 64, 1u, RLX_AGENT);
        list[(size_t)e * LIST_CAP + pos] = (unsigned)(tok * 2 + lane);
        selw[tok * 2 + lane] = lane == 0 ? top_gp * inv : top_gp * p1 * inv;
    }
}

__device__ __forceinline__ void moe_tables(Frame& F, int layer) {
    volatile LAS int* cnt = (volatile LAS int*)(F.lds + LDSCTL_OFF);
    volatile LAS int* tst = cnt + 32;
    if (F.tid < NEXP) cnt[F.tid] = (int)__hip_atomic_load(F.ctl + CW_CNT + (layer * NEXP + F.tid) * 64, RLX_AGENT);
    __syncthreads();
    if (F.tid == 0) { int acc = 0; for (int e = 0; e < NEXP; ++e) { tst[e] = acc; acc += (cnt[e] + 255) >> 8; } tst[NEXP] = acc; }
    __syncthreads();
}

__device__ __forceinline__ void conv_phase(Frame& F, const Args& a) {
    unsigned char* ws = a.ws;
    const bf16* Y = (const bf16*)(ws + WS_ACT); const bf16* GB = Y + (size_t)T * D; bf16* MIX = (bf16*)(ws + WS_MIX);
    const float* cw = a.in[7];
    for (int it = F.vcu * 512 + F.tid; it < (T / 16) * (D / 8); it += F.G * 512) {
        const int cg = it % (D / 8), tb = it / (D / 8), c0 = cg * 8, tok0 = tb * 16;
        float w0[8], w1[8], w2[8];
#pragma unroll
        for (int j = 0; j < 8; ++j) { w0[j] = cw[c0 + j]; w1[j] = cw[D + c0 + j]; w2[j] = cw[2 * D + c0 + j]; }
        float ym2[8], ym1[8];
        const bool first = (tok0 % SEQ) == 0;
        { v4u r1 = {0, 0, 0, 0}, r2 = {0, 0, 0, 0};
          if (!first) { r2 = *(const v4u*)(Y + (size_t)(tok0 - 2) * D + c0); r1 = *(const v4u*)(Y + (size_t)(tok0 - 1) * D + c0); }
          const unsigned a2[4] = {r2.x, r2.y, r2.z, r2.w}, a1[4] = {r1.x, r1.y, r1.z, r1.w};
#pragma unroll
          for (int j = 0; j < 4; ++j) { ym2[2 * j] = bf_lo(a2[j]); ym2[2 * j + 1] = bf_hi(a2[j]); ym1[2 * j] = bf_lo(a1[j]); ym1[2 * j + 1] = bf_hi(a1[j]); } }
#pragma unroll 4
        for (int t = 0; t < 16; ++t) {
            const v4u ry = *(const v4u*)(Y + (size_t)(tok0 + t) * D + c0), rg = *(const v4u*)(GB + (size_t)(tok0 + t) * D + c0);
            const unsigned ay[4] = {ry.x, ry.y, ry.z, ry.w}, ag[4] = {rg.x, rg.y, rg.z, rg.w};
            float y[8], o[8];
#pragma unroll
            for (int j = 0; j < 4; ++j) { y[2 * j] = bf_lo(ay[j]); y[2 * j + 1] = bf_hi(ay[j]); }
#pragma unroll
            for (int j = 0; j < 8; ++j) { const float gbv = (j & 1) ? bf_hi(ag[j >> 1]) : bf_lo(ag[j >> 1]); o[j] = gbv * (w0[j] * ym2[j] + w1[j] * ym1[j] + w2[j] * y[j]); ym2[j] = ym1[j]; ym1[j] = y[j]; }
            v4u w; w.x = pk2(o[0], o[1]); w.y = pk2(o[2], o[3]); w.z = pk2(o[4], o[5]); w.w = pk2(o[6], o[7]);
            *(v4u*)(MIX + (size_t)(tok0 + t) * D + c0) = w;
        }
    }
}

constexpr int NPHASE = 15;
__global__ void __launch_bounds__(NWAVES * 64, 2) mk_fwd(Args args) {
    extern __shared__ __attribute__((aligned(16))) unsigned char lds[];
    Frame F;
    F.lds = (LAS unsigned char*)lds;
    F.MISC = (volatile LAS unsigned*)(F.lds + MISC_OFF);
    F.tid = threadIdx.x; F.lane = F.tid & 63; F.wave = __builtin_amdgcn_readfirstlane(F.tid >> 6);
    F.G = gridDim.x; { const int bx = blockIdx.x; F.vcu = (F.G % 8 == 0) ? (bx % 8) * (F.G / 8) + bx / 8 : bx; }
    unsigned char* ws = args.ws;
    F.ctl = (gu32*)(ws + WS_CTL);
    for (int u = F.tid; u < (LDS_BYTES - LDSCTL_OFF) / 4; u += NWAVES * 64) ((LAS unsigned*)(F.lds + LDSCTL_OFF))[u] = 0u;
    __syncthreads();
    XcdBarrier bar; bar.bar = (unsigned*)(F.ctl + CW_BAR); bar.x = 0; bar.st = nullptr;
    if (args.single) bar = xcd_barrier_post((unsigned*)(F.ctl + CW_BAR), F.MISC + 8);
    const unsigned mask = args.mask;
#ifndef PHCT
#define PHCT 0x7fffu
#endif
#define RUN(k) (((PHCT >> (k)) & 1u) && ((mask >> (k)) & 1u))
#define SEAM(k) do { if (args.single && (k) + 1 < NPHASE) xcd_barrier(bar); } while (0)
    const LAS int* cntL = (const LAS int*)(F.lds + LDSCTL_OFF); const LAS int* tstL = cntL + 32;
    bf16* const Hb = (bf16*)(ws + WS_H); bf16* const ACT = (bf16*)(ws + WS_ACT); bf16* const MIXb = (bf16*)(ws + WS_MIX); float* const Xf = (float*)(ws + WS_X);
    bf16* const CONTRIB = (bf16*)(ws + WS_CONTRIB); unsigned* const LIST = (unsigned*)(ws + WS_LIST); float* const SELW = (float*)(ws + WS_SELW);
    const int gw = F.vcu * NWAVES + F.wave, NGW = F.G * NWAVES;

    if (RUN(0)) { phase_prologue(F, args); SEAM(0); }
    if (RUN(1)) {
        pg8::DenseOrder S; S.init(T, EVEN_IN, D, (const bf16*)(ws + WS_WIN0), F.G, (int)blockIdx.x);
        pg8::EpiEvenIn E{ACT, ACT + (size_t)T * GW, ACT + (size_t)2 * T * GW, ACT + (size_t)3 * T * GW, ACT + (size_t)4 * T * GW};
        pg8::gemm_phase<pg8::EpiEvenIn, pg8::DenseOrder, true>(F.lds, Hb, D, S, E);
        SEAM(1);
    }
    if (RUN(2)) {
        for (int u = F.vcu; u < BATCH * (SEQ / CHUNK) * NG; u += F.G) gmlp_unit(F, args, u);
        for (int t = gw; t < 2 * 2048; t += NGW) {
            const int rnd = t >> 11, tt = t & 2047; const int bh = (tt >> 6) + 32 * rnd, qb = tt & 63;
            sb_task(args, F.lane, bh, rnd ? 63 - qb : qb);
        }
        SEAM(2);
    }
    if (RUN(3)) {
        pg8::DenseOrder S; S.init(T, D, D, (const bf16*)(ws + WS_WOUT0), F.G, (int)blockIdx.x);
        pg8::EpiResF32 E{args.in[0], Xf};
        pg8::gemm_phase<pg8::EpiResF32, pg8::DenseOrder, false>(F.lds, MIXb, D, S, E);
        SEAM(3);
    }
#define MOE_PHASES(layer, pb) do { \
        if (RUN(pb)) { \
            for (int m = gw; m < T; m += NGW) route_row(args, F.lane, layer, m, Xf, Hb, (unsigned*)(F.ctl + CW_CNT), LIST, SELW); \
            SEAM(pb); \
        } \
        if (RUN((pb) + 1)) { \
            moe_tables(F, layer); \
            pg8::MoeOrder S{cntL, tstL, (int)blockIdx.x, F.G, (const bf16*)(ws + WS_WGU) + (size_t)(layer) * NEXP * 1024 * D, (size_t)1024 * D, D, LIST, true}; \
            pg8::EpiMoeUp E{ACT}; \
            pg8::gemm_phase<pg8::EpiMoeUp, pg8::MoeOrder, true>(F.lds, Hb, D, S, E); \
            SEAM((pb) + 1); \
        } \
        if (RUN((pb) + 2)) { \
            moe_tables(F, layer); \
            pg8::MoeOrder S{cntL, tstL, (int)blockIdx.x, F.G, (const bf16*)(ws + WS_WD) + (size_t)(layer) * NEXP * D * FF, (size_t)D * FF, FF, LIST, false}; \
            pg8::EpiMoeDown E{CONTRIB, LIST, SELW, cntL}; \
            pg8::gemm_phase<pg8::EpiMoeDown, pg8::MoeOrder, true>(F.lds, ACT, FF, S, E); \
            SEAM((pb) + 2); \
        } } while (0)
    MOE_PHASES(0, 4);
    if (RUN(7)) {
        for (int m = gw; m < T; m += NGW) norm_row(F.lane, Xf + (size_t)m * D, CONTRIB + (size_t)m * D, CONTRIB + (size_t)(T + m) * D, args.in[9] + D, Xf + (size_t)m * D, Hb + (size_t)m * D, nullptr);
        SEAM(7);
    }
    if (RUN(8)) {
        pg8::DenseOrder S; S.init(T, ODD_IN, D, (const bf16*)(ws + WS_WIN1), F.G, (int)blockIdx.x);
        pg8::EpiOddIn E{ACT, ACT + (size_t)T * D};
        pg8::gemm_phase<pg8::EpiOddIn, pg8::DenseOrder, true>(F.lds, Hb, D, S, E);
        SEAM(8);
    }
    if (RUN(9)) { conv_phase(F, args); SEAM(9); }
    if (RUN(10)) {
        pg8::DenseOrder S; S.init(T, D, D, (const bf16*)(ws + WS_WOUT1), F.G, (int)blockIdx.x);
        pg8::EpiResF32 E{Xf, Xf};
        pg8::gemm_phase<pg8::EpiResF32, pg8::DenseOrder, false>(F.lds, MIXb, D, S, E);
        SEAM(10);
    }
    MOE_PHASES(1, 11);
#undef MOE_PHASES
    if (RUN(14)) {
        for (int m = gw; m < T; m += NGW) norm_row(F.lane, Xf + (size_t)m * D, CONTRIB + (size_t)m * D, CONTRIB + (size_t)(T + m) * D, args.in[16], nullptr, nullptr, args.out + (size_t)m * D);
    }
#undef RUN
#undef SEAM
}

#if HYBRID
__global__ void __launch_bounds__(256) k_rmsnorm(const float* __restrict__ x, const float* __restrict__ gain, float* __restrict__ out, int rows) {
    const int wave = (blockIdx.x * blockDim.x + threadIdx.x) >> 6, lane = threadIdx.x & 63;
    if (wave >= rows) return;
    const float* xr = x + (size_t)wave * D;
    float v[16]; float s = 0.f;
#pragma unroll
    for (int j = 0; j < 16; ++j) { v[j] = xr[lane + 64 * j]; s += v[j] * v[j]; }
    s = wave_sum(s);
    const float r = rsqrtf(s * (1.0f / D) + EPS);
#pragma unroll
    for (int j = 0; j < 16; ++j) out[(size_t)wave * D + lane + 64 * j] = v[j] * r * gain[lane + 64 * j];
}
__global__ void __launch_bounds__(256) k_sgemm(const float* __restrict__ A, const float* __restrict__ B, float* C, const float* R, int M, int N, int K) {
    __shared__ float As[16][65];
    __shared__ float Bs[16][65];
    const int tx = threadIdx.x & 15, ty = threadIdx.x >> 4;
    const int bm = blockIdx.y * 64, bn = blockIdx.x * 64;
    float acc[4][4] = {};
    for (int k0 = 0; k0 < K; k0 += 16) {
        for (int i = threadIdx.x; i < 64 * 16; i += 256) { const int r = i >> 4, c = i & 15; As[c][r] = A[(size_t)(bm + r) * K + k0 + c]; }
        for (int i = threadIdx.x; i < 16 * 64; i += 256) { const int r = i >> 6, c = i & 63; Bs[r][c] = B[(size_t)(k0 + r) * N + bn + c]; }
        __syncthreads();
#pragma unroll
        for (int k = 0; k < 16; ++k) {
            float a[4], b[4];
#pragma unroll
            for (int i = 0; i < 4; ++i) { a[i] = As[k][ty * 4 + i]; b[i] = Bs[k][tx * 4 + i]; }
#pragma unroll
            for (int i = 0; i < 4; ++i)
#pragma unroll
                for (int j = 0; j < 4; ++j) acc[i][j] += a[i] * b[j];
        }
        __syncthreads();
    }
#pragma unroll
    for (int i = 0; i < 4; ++i)
#pragma unroll
        for (int j = 0; j < 4; ++j) { const size_t o = (size_t)(bm + ty * 4 + i) * N + bn + tx * 4 + j; C[o] = (R ? R[o] : 0.f) + acc[i][j]; }
}
__device__ __forceinline__ float gelu_exact(float v) { return 0.5f * v * (1.0f + erff(v * 0.70710678118654752f)); }
__global__ void __launch_bounds__(256) k_even_post(float* P, const float* __restrict__ vgain) {
    const int w = (blockIdx.x * blockDim.x + threadIdx.x) >> 6, lane = threadIdx.x & 63;
    if (w >= T * NG) return;
    const int tok = w / NG, g = w % NG;
    float* pu = P + (size_t)tok * EVEN_IN + g * GD + lane;
    float* pv = P + (size_t)tok * EVEN_IN + GW + g * GD + lane;
    *pu = gelu_exact(*pu);
    const float v = gelu_exact(*pv);
    const float s = wave_sum(v * v);
    *pv = v * rsqrtf(s * (1.0f / GD) + EPS) * vgain[g * GD + lane];
}
__global__ void __launch_bounds__(256) k_gmlp(const float* __restrict__ P, const float* __restrict__ ws_, const float* __restrict__ bs_, float* __restrict__ mixcat) {
    __shared__ float vs[CHUNK][GD];
    const int g = blockIdx.x % NG, n = (blockIdx.x / NG) % (SEQ / CHUNK), b = blockIdx.x / (NG * (SEQ / CHUNK));
    const int tok0 = b * SEQ + n * CHUNK;
    for (int i = threadIdx.x; i < CHUNK * GD; i += 256) { const int s = i >> 6, d = i & 63; vs[s][d] = P[(size_t)(tok0 + s) * EVEN_IN + GW + g * GD + d]; }
    __syncthreads();
    const int d = threadIdx.x & 63;
    for (int t = threadIdx.x >> 6; t < CHUNK; t += 4) {
        float acc = 0.f;
        const float* wr = ws_ + ((size_t)g * CHUNK + t) * CHUNK;
        for (int s = 0; s <= t; ++s) acc += wr[s] * vs[s][d];
        acc += bs_[g * CHUNK + t];
        const float u = P[(size_t)(tok0 + t) * EVEN_IN + g * GD + d];
        mixcat[(size_t)(tok0 + t) * D + g * GD + d] = u * acc;
    }
}
__device__ __forceinline__ float log_sigmoid(float z) { return fminf(z, 0.f) - log1pf(expf(-fabsf(z))); }
__global__ void __launch_bounds__(256) k_sbattn(const float* __restrict__ P, float* __restrict__ mixcat) {
    const int w = (blockIdx.x * blockDim.x + threadIdx.x) >> 6, lane = threadIdx.x & 63;
    if (w >= T * NH) return;
    const int h = w % NH, tok = w / NH, b = tok / SEQ, t = tok % SEQ;
    const float q = P[(size_t)tok * EVEN_IN + 2 * GW + h * HD + lane];
    float acc = 0.f, suffix = 0.f;
    for (int s = t - 1; s >= 0; --s) {
        const size_t row = (size_t)(b * SEQ + s) * EVEN_IN;
        const float kk = P[row + 2 * GW + SBW + h * HD + lane];
        const float vv = P[row + 2 * GW + 2 * SBW + h * HD + lane];
        const float z = wave_sum(q * kk) * 0.125f;
        const float a = expf(log_sigmoid(z) + suffix);
        acc += a * vv;
        suffix += log_sigmoid(-z);
    }
    mixcat[(size_t)tok * D + GW + h * HD + lane] = acc;
}
__global__ void __launch_bounds__(256) k_conv(const float* __restrict__ P, const float* __restrict__ cw, float* __restrict__ mixin) {
    const size_t i = (size_t)blockIdx.x * blockDim.x + threadIdx.x;
    if (i >= (size_t)T * D) return;
    const int c = (int)(i % D), tok = (int)(i / D), t = tok % SEQ;
    float acc = 0.f;
#pragma unroll
    for (int k = 0; k < 3; ++k) { const int tt = t + k - 2;
        if (tt >= 0) { const size_t row = (size_t)(tok + k - 2) * ODD_IN; acc += cw[k * D + c] * (P[row + D + c] * P[row + 2 * D + c]); } }
    mixin[i] = P[(size_t)tok * ODD_IN + c] * acc;
}
__global__ void __launch_bounds__(256) k_route(const float* __restrict__ x, const float* __restrict__ gain, const float* __restrict__ wrg, const float* __restrict__ wre,
                                               float* __restrict__ h2, int* __restrict__ sel_e, float* __restrict__ sel_w) {
    const int w = (blockIdx.x * blockDim.x + threadIdx.x) >> 6, lane = threadIdx.x & 63;
    if (w >= T) return;
    const float* xr = x + (size_t)w * D;
    float v[16]; float s = 0.f;
#pragma unroll
    for (int j = 0; j < 16; ++j) { v[j] = xr[lane + 64 * j]; s += v[j] * v[j]; }
    s = wave_sum(s);
    const float r = rsqrtf(s * (1.0f / D) + EPS);
#pragma unroll
    for (int j = 0; j < 16; ++j) { v[j] = v[j] * r * gain[lane + 64 * j]; h2[(size_t)w * D + lane + 64 * j] = v[j]; }
    float gl[NGRP];
#pragma unroll
    for (int g = 0; g < NGRP; ++g) { float a = 0.f;
#pragma unroll
        for (int j = 0; j < 16; ++j) a += v[j] * wrg[(size_t)(lane + 64 * j) * NGRP + g];
        gl[g] = wave_sum(a); }
    int tg = 0; float mx = gl[0];
#pragma unroll
    for (int g = 1; g < NGRP; ++g) if (gl[g] > mx) { mx = gl[g]; tg = g; }
    float den = 0.f;
#pragma unroll
    for (int g = 0; g < NGRP; ++g) den += expf(gl[g] - mx);
    const float top_gp = 1.0f / den;
    float el[EPG];
#pragma unroll
    for (int e = 0; e < EPG; ++e) { float a = 0.f;
#pragma unroll
        for (int j = 0; j < 16; ++j) a += v[j] * wre[((size_t)tg * D + lane + 64 * j) * EPG + e];
        el[e] = wave_sum(a); }
    int e0 = 0; float l0 = el[0];
#pragma unroll
    for (int e = 1; e < EPG; ++e) if (el[e] > l0) { l0 = el[e]; e0 = e; }
    int e1 = -1; float l1 = -INFINITY;
#pragma unroll
    for (int e = 0; e < EPG; ++e) if (e != e0 && el[e] > l1) { l1 = el[e]; e1 = e; }
    const float p1 = expf(l1 - l0), inv = 1.0f / (1.0f + p1);
    if (lane == 0) { sel_e[w * 2 + 0] = tg * EPG + e0; sel_e[w * 2 + 1] = tg * EPG + e1; sel_w[w * 2 + 0] = top_gp * inv; sel_w[w * 2 + 1] = top_gp * p1 * inv; }
}
__global__ void __launch_bounds__(256) k_moe_up(const float* __restrict__ h2, const int* __restrict__ sel_e, const float* __restrict__ wg, const float* __restrict__ wu, float* __restrict__ hmid) {
    __shared__ float hs[D];
    const int row = blockIdx.x, tok = row >> 1;
    const int e = sel_e[row];
    for (int i = threadIdx.x; i < D; i += 256) hs[i] = h2[(size_t)tok * D + i];
    __syncthreads();
    const float* g = wg + (size_t)e * D * FF; const float* u = wu + (size_t)e * D * FF;
    float ag0 = 0.f, ag1 = 0.f, au0 = 0.f, au1 = 0.f;
    const int f = threadIdx.x;
    for (int k = 0; k < D; ++k) { const float hv = hs[k];
        ag0 += hv * g[(size_t)k * FF + f]; ag1 += hv * g[(size_t)k * FF + f + 256];
        au0 += hv * u[(size_t)k * FF + f]; au1 += hv * u[(size_t)k * FF + f + 256]; }
    hmid[(size_t)row * FF + f] = ag0 / (1.0f + expf(-ag0)) * au0;
    hmid[(size_t)row * FF + f + 256] = ag1 / (1.0f + expf(-ag1)) * au1;
}
__global__ void __launch_bounds__(256) k_moe_down(const float* __restrict__ hmid, const int* __restrict__ sel_e, const float* __restrict__ sel_w, const float* __restrict__ wd, float* x) {
    __shared__ float hs[2][FF];
    const int tok = blockIdx.x;
    for (int i = threadIdx.x; i < 2 * FF; i += 256) hs[i / FF][i % FF] = hmid[(size_t)tok * 2 * FF + i];
    __syncthreads();
    float acc[4] = {0.f, 0.f, 0.f, 0.f};
    for (int sl = 0; sl < 2; ++sl) {
        const int e = sel_e[tok * 2 + sl]; const float w = sel_w[tok * 2 + sl];
        const float* dmat = wd + (size_t)e * FF * D;
        float a[4] = {0.f, 0.f, 0.f, 0.f};
        for (int f = 0; f < FF; ++f) { const float hv = hs[sl][f];
#pragma unroll
            for (int j = 0; j < 4; ++j) a[j] += hv * dmat[(size_t)f * D + threadIdx.x + 256 * j]; }
#pragma unroll
        for (int j = 0; j < 4; ++j) acc[j] += w * a[j];
    }
#pragma unroll
    for (int j = 0; j < 4; ++j) x[(size_t)tok * D + threadIdx.x + 256 * j] += acc[j];
}
#endif

extern "C" void kernel_launch(void* const* d_in, const int* in_sizes, int n_in, void* d_out, int out_size, void* d_ws, size_t ws_size, hipStream_t stream) {
    static int grid = 0;
    if (grid == 0) {
        if (n_in != 17 || in_sizes[0] != T * D || out_size != T * D || ws_size < WS_END) { fprintf(stderr, "kernel_launch: unexpected shapes / workspace (%d inputs, ws %zu)\n", n_in, ws_size); grid = -1; return; }
        int dev = 0, cus = 0, per_cu = 0;
        if (hipGetDevice(&dev) != hipSuccess || hipDeviceGetAttribute(&cus, hipDeviceAttributeMultiprocessorCount, dev) != hipSuccess) { grid = -1; return; }
        if (hipFuncSetAttribute((const void*)mk_fwd, hipFuncAttributeMaxDynamicSharedMemorySize, LDS_BYTES) != hipSuccess) { fprintf(stderr, "kernel_launch: hipFuncSetAttribute failed\n"); grid = -1; return; }
        if (hipOccupancyMaxActiveBlocksPerMultiprocessor(&per_cu, (const void*)mk_fwd, NWAVES * 64, LDS_BYTES) != hipSuccess || per_cu < 1) { fprintf(stderr, "kernel_launch: occupancy query reports %d workgroups per CU\n", per_cu); }
        (void)hipGetLastError();
        grid = cus;
    }
    if (grid < 0) return;
    Args a{};
    for (int i = 0; i < 17; ++i) a.in[i] = (const float*)d_in[i];
    a.out = (float*)d_out; a.ws = (unsigned char*)d_ws;
#if !HYBRID
    hipMemsetAsync((char*)d_ws + WS_CTL, 0, CTL_ZERO_BYTES, stream);
    a.mask = (1u << NPHASE) - 1u; a.single = 1;
    hipLaunchKernelGGL(mk_fwd, dim3(grid), dim3(NWAVES * 64), LDS_BYTES, stream, a);
#else
    char* ws = (char*)d_ws;
    float* X = (float*)(ws + WS_X);
    float* sH = (float*)(ws + 0 * MiB); float* sP = (float*)(ws + 64 * MiB); float* sMC = (float*)(ws + 256 * MiB);
    int* sSE = (int*)(ws + 320 * MiB); float* sSW = (float*)(ws + 321 * MiB); float* sHM = (float*)(ws + 420 * MiB);
    const float** in = (const float**)a.in;
    auto fast = [&](unsigned mask) {
        for (int k = 0; k < NPHASE; ++k) if ((mask >> k) & 1u) { a.mask = 1u << k; a.single = 0; hipLaunchKernelGGL(mk_fwd, dim3(grid), dim3(NWAVES * 64), LDS_BYTES, stream, a); } };
    auto fast_prep = [&]() { hipMemsetAsync(ws + WS_CTL, 0, CTL_ZERO_BYTES, stream); fast(1u << 0); };
    auto slow_mixer = [&](int l) {
        const float* xin = (l == 0) ? in[0] : X;
        k_rmsnorm<<<T / 4, 256, 0, stream>>>(xin, in[9] + l * D, sH, T);
        if (l == 0) {
            k_sgemm<<<dim3(EVEN_IN / 64, T / 64), 256, 0, stream>>>(sH, in[1], sP, nullptr, T, EVEN_IN, D);
            k_even_post<<<T * NG / 4, 256, 0, stream>>>(sP, in[5]);
            k_gmlp<<<BATCH * (SEQ / CHUNK) * NG, 256, 0, stream>>>(sP, in[3], in[4], sMC);
            k_sbattn<<<T * NH / 4, 256, 0, stream>>>(sP, sMC);
            k_sgemm<<<dim3(D / 64, T / 64), 256, 0, stream>>>(sMC, in[2], X, xin, T, D, D);
        } else {
            k_sgemm<<<dim3(ODD_IN / 64, T / 64), 256, 0, stream>>>(sH, in[6], sP, nullptr, T, ODD_IN, D);
            k_conv<<<T * D / 256, 256, 0, stream>>>(sP, in[7], sMC);
            k_sgemm<<<dim3(D / 64, T / 64), 256, 0, stream>>>(sMC, in[8], X, xin, T, D, D);
        } };
    auto slow_moe = [&](int l) {
        k_route<<<T / 4, 256, 0, stream>>>(X, in[10] + l * D, in[11] + (size_t)l * D * NGRP, in[12] + (size_t)l * NGRP * D * EPG, sH, sSE, sSW);
        k_moe_up<<<T * 2, 256, 0, stream>>>(sH, sSE, in[13] + (size_t)l * NEXP * D * FF, in[14] + (size_t)l * NEXP * D * FF, sHM);
        k_moe_down<<<T, 256, 0, stream>>>(sHM, sSE, sSW, in[15] + (size_t)l * NEXP * FF * D, X);
        hipMemsetAsync(ws + WS_CONTRIB, 0, (size_t)2 * T * D * 2, stream); };
    const unsigned hy = HYBRID;
    if (hy & 1u) slow_mixer(0); else { fast_prep(); fast(0xEu); }
    if (hy & 2u) slow_moe(0); else { if (hy & 1u) fast_prep(); fast(0x70u); }
    if (hy & 4u) { if (!(hy & 2u)) fast(1u << 7); slow_mixer(1); }
    else { if (hy & 2u) fast_prep(); fast(0x780u); }
    if (hy & 8u) slow_moe(1); else { if (hy & 4u) fast_prep(); fast(0x3800u); }
    fast(1u << 14);
#endif
}
```

```cpp
#include <hip/hip_runtime.h>
#include <cstdio>
#include <cstdint>
#include <cmath>

#ifndef HYBRID
#define HYBRID 0
#endif

#define GAS __attribute__((address_space(1)))
#define LAS __attribute__((address_space(3)))
typedef unsigned short bf16;
typedef unsigned v4u __attribute__((ext_vector_type(4)));
typedef unsigned v2u __attribute__((ext_vector_type(2)));
typedef float f32x4 __attribute__((ext_vector_type(4)));
typedef float f32x2 __attribute__((ext_vector_type(2)));
typedef float f32x16 __attribute__((ext_vector_type(16)));
typedef short bf16x8 __attribute__((ext_vector_type(8)));
typedef GAS unsigned gu32;

constexpr int D = 1024, BATCH = 8, SEQ = 2048, T = BATCH * SEQ;
constexpr int NG = 8, GD = 64, GW = 512, CHUNK = 128;
constexpr int NH = 8, HD = 64, SBW = 512;
constexpr int EVEN_IN = 2560, ODD_IN = 3072;
constexpr int NGRP = 4, EPG = 8, NEXP = 32, FF = 512;
constexpr float EPS = 1e-6f;
constexpr int NWAVES = 8;
constexpr int LIST_CAP = T;
constexpr int MAX_MT = 2 * T / 256 + NEXP;

constexpr size_t MiB = 1u << 20;
constexpr size_t WS_CTL = 0, CTL_ZERO_BYTES = 1 * MiB;
constexpr size_t WS_WTRIL = 1 * MiB;
constexpr size_t WS_WR = 1 * MiB + 256 * 1024;
constexpr size_t WS_LIST = 2 * MiB;
constexpr size_t WS_SELW = 4 * MiB;
constexpr size_t WS_WIN0 = 5 * MiB, WS_WOUT0 = 10 * MiB, WS_WIN1 = 12 * MiB, WS_WOUT1 = 18 * MiB;
constexpr size_t WS_WGU = 20 * MiB;
constexpr size_t WS_WD = 148 * MiB;
constexpr size_t WS_H = 212 * MiB;
constexpr size_t WS_ACT = 244 * MiB;
constexpr size_t WS_MIX = 324 * MiB;
constexpr size_t WS_X = 356 * MiB;
constexpr size_t WS_CONTRIB = 420 * MiB;
constexpr size_t WS_END = 484 * MiB;
constexpr int CW_CNT = 64;
constexpr int CW_TS = 12288;
constexpr int CW_BAR = 16384;

constexpr int RING_BYTES = 131072;
constexpr int LDSCTL_OFF = RING_BYTES, MISC_OFF = LDSCTL_OFF + 320;
constexpr int LDS_BYTES = 147456;

#define RLX_AGENT __ATOMIC_RELAXED, __HIP_MEMORY_SCOPE_AGENT
#define LDS_WAIT() asm volatile("s_waitcnt lgkmcnt(0)" ::: "memory")
#define VM_WAIT() asm volatile("s_waitcnt vmcnt(0)" ::: "memory")
__device__ __forceinline__ unsigned f2bf(float f) { unsigned u = __builtin_bit_cast(unsigned, f); return (u + 0x7fffu + ((u >> 16) & 1u)) >> 16; }
__device__ __forceinline__ unsigned pk2(float lo, float hi) { return f2bf(lo) | (f2bf(hi) << 16); }
__device__ __forceinline__ float bf_lo(unsigned w) { return __builtin_bit_cast(float, w << 16); }
__device__ __forceinline__ float bf_hi(unsigned w) { return __builtin_bit_cast(float, w & 0xffff0000u); }
__device__ __forceinline__ unsigned cvt_pk_bf16(float lo, float hi) { unsigned r; asm volatile("v_cvt_pk_bf16_f32 %0, %1, %2" : "=v"(r) : "v"(lo), "v"(hi)); return r; }
__device__ __forceinline__ float wave_sum(float v) {
#pragma unroll
    for (int o = 1; o < 64; o <<= 1) v += __shfl_xor(v, o);
    return v;
}

#define XB_TMO      128
#define XB_XCNT(j)  (256  + 64 * (j))
#define XB_XSUB(j)  (1280 + 64 * (j))
#define XB_XGEN(j)  (2304 + 64 * (j))
#define XB_TOP      3328
#define XB_TOPGEN   3392
#define XCD_BAR_WORDS 3456
#define XB_SPIN_CAP (1u << 18)
__device__ __forceinline__ unsigned xb_ld(unsigned* p)              { return __hip_atomic_load(p, __ATOMIC_RELAXED, __HIP_MEMORY_SCOPE_AGENT); }
__device__ __forceinline__ unsigned xb_add(unsigned* p, unsigned v) { return __hip_atomic_fetch_add(p, v, __ATOMIC_RELAXED, __HIP_MEMORY_SCOPE_AGENT); }
__device__ __forceinline__ unsigned xb_xcc_id() { return (unsigned)__builtin_amdgcn_s_getreg((3 << 11) | 20) & 0xFu; }
#define XB_SPIN(cond, bar) do { unsigned _sp = 0; while (cond) { __builtin_amdgcn_s_sleep(1); \
    if ((++_sp & 255u) == 0u) { if (xb_ld(&(bar)[XB_TMO])) break; if (_sp > XB_SPIN_CAP) { atomicAdd(&(bar)[XB_TMO], 1u); break; } } } } while (0)
struct XcdBarrier { unsigned* bar; unsigned x; volatile LAS unsigned* st; };
__device__ __forceinline__ XcdBarrier xcd_barrier_post(unsigned* bar, volatile LAS unsigned* st) {
    XcdBarrier b; b.bar = bar; b.x = xb_xcc_id(); b.st = st;
    if (threadIdx.x == 0) (void)xb_add(&bar[XB_XCNT(b.x)], 1u);
    return b;
}
__device__ __forceinline__ void xcd_barrier_complete(unsigned* bar, unsigned x, unsigned& nloc, unsigned& nx) {
    const unsigned G = gridDim.x * gridDim.y * gridDim.z;
    unsigned sum, cnt, mine, sp = 0u;
    for (;;) {
        sum = 0u; cnt = 0u; mine = 0u;
#pragma unroll
        for (unsigned j = 0; j < 16; ++j) { const unsigned c = xb_ld(&bar[XB_XCNT(j)]); sum += c; cnt += (c > 0u) ? 1u : 0u; mine = (j == x) ? c : mine; }
        if (sum == G) break;
        __builtin_amdgcn_s_sleep(1);
        if ((++sp & 255u) == 0u) { if (xb_ld(&bar[XB_TMO])) break; if (sp > XB_SPIN_CAP) { atomicAdd(&bar[XB_TMO], 1u); break; } }
    }
    nloc = mine > 0u ? mine : 1u; nx = cnt > 0u ? cnt : 1u;
}
__device__ __forceinline__ void xcd_barrier(const XcdBarrier& b) {
    asm volatile("s_waitcnt vmcnt(0)" ::: "memory");
    __syncthreads();
    if (threadIdx.x == 0) {
        unsigned* bar = b.bar;
        __builtin_amdgcn_s_waitcnt(0);
        unsigned nloc = b.st[0], nx = b.st[1];
        if (nloc == 0u) { xcd_barrier_complete(bar, b.x, nloc, nx); b.st[0] = nloc; b.st[1] = nx; }
        const unsigned old = xb_add(&bar[XB_XSUB(b.x)], 1u);
        const unsigned gen = old / nloc;
        if (old + 1u == (gen + 1u) * nloc) {
            __builtin_amdgcn_fence(__ATOMIC_RELEASE, "agent");
            asm volatile("s_waitcnt vmcnt(0)" ::: "memory");
            const unsigned og = xb_add(&bar[XB_TOP], 1u);
            const unsigned tg = og / nx;
            if (og + 1u == (tg + 1u) * nx) xb_add(&bar[XB_TOPGEN], 1u);
            else XB_SPIN(xb_ld(&bar[XB_TOPGEN]) == tg, bar);
            __builtin_amdgcn_fence(__ATOMIC_ACQUIRE, "agent");
            xb_add(&bar[XB_XGEN(b.x)], 1u);
            asm volatile("s_waitcnt vmcnt(0)" ::: "memory");
        } else {
            XB_SPIN(xb_ld(&bar[XB_XGEN(b.x)]) == gen, bar);
            __builtin_amdgcn_fence(__ATOMIC_ACQUIRE, "agent");
            asm volatile("s_waitcnt vmcnt(0)" ::: "memory");
        }
    }
    __syncthreads();
}

namespace pg8 {
constexpr int BM = 256, BK = 64, HALF = 128, HTB = HALF * BK * 2, STAGE_BYTES = 8 * HTB, NXCD = 8, WGM = 8;
__host__ __device__ __forceinline__ int lds_byte(int r, int c) { const int st = (r >> 4) * 2 + (c >> 5), rr = r & 15, cc = c & 31, ob = rr * 64 + cc * 2; return st * 1024 + (ob ^ (((ob >> 9) & 1) << 5)); }
__host__ __device__ __forceinline__ void stage_rc(int b, int& R, int& C) { const int st = b / 1024, sb = b % 1024, swz = sb ^ (((sb >> 9) & 1) << 5); R = (st >> 1) * 16 + swz / 64; C = (st & 1) * 32 + (swz % 64) / 2; }
__host__ __device__ __forceinline__ int perm32(int rho) { const int n = rho >> 4, i = rho & 15; return 8 * (i >> 2) + 4 * n + (i & 3); }

struct Unit { int pm, pn, e, mt; };

struct DenseOrder {
    int nM, nN, nwg, G, c; const bf16* Bt; int K;
    __device__ void init(int M, int N, int K_, const bf16* Bt_, int G_, int c_) { nM = M / BM; nN = N / BM; nwg = nM * nN; G = G_; c = c_; Bt = Bt_; K = K_; }
    __device__ bool next(int i, Unit& u) const {
        const long L = (long)i * G + c; if (L >= nwg) return false;
        int wgid = (int)L; { const int q = nwg / NXCD, r = nwg % NXCD, xcd = wgid % NXCD, off = wgid / NXCD; wgid = (xcd < r ? xcd * (q + 1) : r * (q + 1) + (xcd - r) * q) + off; }
        const int nig = WGM * nN, gid = wgid / nig, fm = gid * WGM, gsz = (nM - fm) < WGM ? (nM - fm) : WGM;
        u.pm = fm + ((wgid % nig) % gsz); u.pn = (wgid % nig) / gsz; u.e = 0; u.mt = 0; return true;
    }
    __device__ __forceinline__ int a_row(const Unit& u, int r) const { return u.pm * BM + r; }
    __device__ __forceinline__ const char* b_base(const Unit& u) const { return (const char*)Bt + (size_t)u.pn * BM * K * 2; }
};

struct MoeOrder {
    const LAS int* cnt; const LAS int* tstart; int c, G; const bf16* W; size_t wstride; int K; const unsigned* list; bool gather;
    __device__ bool next(int i, Unit& u) const {
        const int x = c & 7, j = c >> 3, per = (G - x + 7) >> 3;
        int L = i * per + j;
        int tl = L >> 2; const int pn = L & 3;
#pragma unroll
        for (int k = 0; k < 4; ++k) {
            const int e = x + 8 * k; const int nt = tstart[e + 1] - tstart[e];
            if (tl < nt) { u.e = e; u.mt = tl; u.pm = tstart[e] + tl; u.pn = pn; return true; }
            tl -= nt;
        }
        return false;
    }
    __device__ __forceinline__ int a_row(const Unit& u, int r) const {
        if (!gather) return u.pm * BM + r;
        const int idx = u.mt * BM + r;
        return idx < cnt[u.e] ? (int)(list[(size_t)u.e * LIST_CAP + idx] >> 1) : 0;
    }
    __device__ __forceinline__ const char* b_base(const Unit& u) const { return (const char*)W + ((size_t)u.e * wstride + (size_t)u.pn * BM * K) * 2; }
};

__device__ __forceinline__ f32x2 gelu_pk(f32x2 v) {
    const f32x2 av = __builtin_elementwise_abs(v), d = av * 0.2316418882f + 1.0f;
    f32x2 t; t.x = __builtin_amdgcn_rcpf(d.x); t.y = __builtin_amdgcn_rcpf(d.y);
    f32x2 q = t * 0.5307027145f + (-0.7265760135f); q = q * t + 0.7107068705f; q = q * t + (-0.142248368f); q = q * t + 0.127414796f; q = q * t;
    const f32x2 s = (v * v) * (-0.72134752044f);
    f32x2 e; e.x = __builtin_amdgcn_exp2f(s.x); e.y = __builtin_amdgcn_exp2f(s.y);
    const f32x2 m = v * (q * e), r = v - m;
    f32x2 o; o.x = v.x < 0.f ? m.x : r.x; o.y = v.y < 0.f ? m.y : r.y; return o;
}

typedef f32x4 Acc[2][2][4][2];

template <class Epi, class Sched, bool ALIGN_EPI>
__device__ __forceinline__ void gemm_phase(LAS unsigned char* lds, const bf16* A, const int K, const Sched& S, const Epi& E) {
    const int tid = threadIdx.x, wid = __builtin_amdgcn_readfirstlane(tid >> 6), lane = tid & 63, wr = wid >> 2, wc = wid & 3, fr = lane & 15, fq = lane >> 4;
    const int nt = K / BK;
    int Rr[2], Cc[2]; unsigned voffB[2];
#pragma unroll
    for (int i = 0; i < 2; ++i) { int R, C; stage_rc(tid * 16 + i * 8192, R, C); const int Rb = Epi::PERM ? ((R & ~31) + perm32(R & 31)) : R;
        Rr[i] = R; Cc[i] = C; voffB[i] = (unsigned)(Rb * K + C) * 2u; }
    const size_t kstep = (size_t)(BK * 2);
    const size_t hstep = (size_t)HALF * K * 2;
    const unsigned ldsw = (unsigned)wid * 1024u;
    const int aoff = lds_byte(wr * 64 + fr, fq * 8), boff = lds_byte(wc * 32 + fr, fq * 8);
#define PG8_SA(b, h) (((b) * 2 + (h)) * HTB)
#define PG8_SB(b, h) ((4 + (b) * 2 + (h)) * HTB)
#define PG8_STAGE(bufoff, gbase, voff) do { _Pragma("unroll") for (int _i = 0; _i < 2; ++_i) \
        __builtin_amdgcn_global_load_lds((const unsigned*)((const char*)(gbase) + (voff)[_i]), (LAS unsigned*)(lds + (bufoff) + ldsw + _i * 8192), 16, 0, 0); } while (0)
#define PG8_LDA(dst, b, h) do { _Pragma("unroll") for (int m = 0; m < 4; ++m) _Pragma("unroll") for (int k = 0; k < 2; ++k) dst[m][k] = *(const LAS bf16x8*)(lds + PG8_SA(b, h) + aoff + m * 2048 + k * 1024); } while (0)
#define PG8_LDB(dst, b, h) do { _Pragma("unroll") for (int n = 0; n < 2; ++n) _Pragma("unroll") for (int k = 0; k < 2; ++k) dst[n][k] = *(const LAS bf16x8*)(lds + PG8_SB(b, h) + boff + n * 2048 + k * 1024); } while (0)
#define PG8_MMA(ai, bj, At, Bt) do { __builtin_amdgcn_s_setprio(1); _Pragma("unroll") for (int m = 0; m < 4; ++m) _Pragma("unroll") for (int n = 0; n < 2; ++n) _Pragma("unroll") for (int k = 0; k < 2; ++k) \
        acc[ai][bj][m][n] = __builtin_amdgcn_mfma_f32_16x16x32_bf16(Bt[n][k], At[m][k], acc[ai][bj][m][n], 0, 0, 0); __builtin_amdgcn_s_setprio(0); } while (0)
#define PG8_WAIT_V(n) asm volatile("s_waitcnt vmcnt(" #n ")" ::: "memory")
#define PG8_WAIT_L(n) asm volatile("s_waitcnt lgkmcnt(" #n ")" ::: "memory")
#define PG8_BAR __builtin_amdgcn_s_barrier()
#define PG8_SCHED __builtin_amdgcn_sched_barrier(0)
#define PG8_VOFF(dst, u) do { _Pragma("unroll") for (int _h = 0; _h < 2; ++_h) _Pragma("unroll") for (int _i = 0; _i < 2; ++_i) \
        dst[_h][_i] = (unsigned)(S.a_row(u, _h * HALF + Rr[_i]) * K + Cc[_i]) * 2u; \
        asm volatile("" : "+v"(dst[0][0]), "+v"(dst[0][1]), "+v"(dst[1][0]), "+v"(dst[1][1])); } while (0)
    Unit cur, nxt; int ui = 0;
    if (!S.next(0, cur)) return;
    Acc acc;
#pragma unroll
    for (int a = 0; a < 2; ++a)
#pragma unroll
        for (int b = 0; b < 2; ++b)
#pragma unroll
            for (int m = 0; m < 4; ++m)
#pragma unroll
                for (int n = 0; n < 2; ++n) acc[a][b][m][n] = (f32x4){0.f, 0.f, 0.f, 0.f};
    bf16x8 At[4][2], B0[2][2], B1[2][2];
    unsigned vc[2][2], vn[2][2];
    PG8_VOFF(vc, cur);
    const char* const cA = (const char*)A;
    const char* cB = S.b_base(cur);
    PG8_STAGE(PG8_SB(0, 0), cB, voffB); PG8_STAGE(PG8_SB(0, 1), cB + hstep, voffB); PG8_STAGE(PG8_SA(0, 0), cA, vc[0]); PG8_STAGE(PG8_SA(0, 1), cA, vc[1]);
    if (wr == 1) PG8_BAR;
    PG8_WAIT_V(2); PG8_BAR;
    PG8_STAGE(PG8_SB(1, 0), cB + kstep, voffB); PG8_STAGE(PG8_SA(1, 0), cA + kstep, vc[0]); PG8_STAGE(PG8_SB(1, 1), cB + hstep + kstep, voffB);
    PG8_WAIT_V(6); PG8_BAR;
    for (;;) {
        const bool has_next = S.next(ui + 1, nxt);
        if (has_next) { PG8_VOFF(vn, nxt); } else {
#pragma unroll
            for (int h = 0; h < 2; ++h)
#pragma unroll
                for (int i = 0; i < 2; ++i) vn[h][i] = vc[h][i]; }
        const char* nB = has_next ? S.b_base(nxt) : cB;
        for (int t = 0; t < nt; t += 2) {
            const bool last = (t == nt - 2);
            const char* a1 = cA + (size_t)(t + 1) * kstep;
            const char* a2 = last ? cA : cA + (size_t)(t + 2) * kstep; const char* b2 = last ? nB : cB + (size_t)(t + 2) * kstep;
            const char* a3 = a2 + kstep; const char* b3 = b2 + kstep;
            unsigned v2[2][2];
#pragma unroll
            for (int h = 0; h < 2; ++h)
#pragma unroll
                for (int i = 0; i < 2; ++i) v2[h][i] = last ? vn[h][i] : vc[h][i];
            PG8_LDB(B0, 0, 0); PG8_LDB(B1, 0, 1); PG8_SCHED; PG8_LDA(At, 0, 0); PG8_STAGE(PG8_SA(1, 1), a1, vc[1]);
            PG8_WAIT_V(8); PG8_WAIT_L(0); PG8_BAR; PG8_MMA(0, 0, At, B0); PG8_MMA(0, 1, At, B1); PG8_BAR; PG8_SCHED;
            PG8_LDA(At, 0, 1); PG8_STAGE(PG8_SB(0, 0), b2, voffB); PG8_STAGE(PG8_SB(0, 1), b2 + hstep, voffB); PG8_STAGE(PG8_SA(0, 0), a2, v2[0]);
            PG8_WAIT_V(8); PG8_WAIT_L(0); PG8_BAR; PG8_MMA(1, 0, At, B0); PG8_MMA(1, 1, At, B1); PG8_BAR; PG8_SCHED;
            PG8_LDB(B0, 1, 0); PG8_LDB(B1, 1, 1); PG8_SCHED; PG8_LDA(At, 1, 0); PG8_STAGE(PG8_SA(0, 1), a2, v2[1]);
            PG8_WAIT_V(8); PG8_WAIT_L(0); PG8_BAR; PG8_MMA(0, 0, At, B0); PG8_MMA(0, 1, At, B1); PG8_BAR; PG8_SCHED;
            PG8_LDA(At, 1, 1); PG8_STAGE(PG8_SB(1, 0), b3, voffB); PG8_STAGE(PG8_SB(1, 1), b3 + hstep, voffB); PG8_STAGE(PG8_SA(1, 0), a3, v2[0]);
            PG8_WAIT_V(8); PG8_WAIT_L(0); PG8_BAR; PG8_MMA(1, 0, At, B0); PG8_MMA(1, 1, At, B1); PG8_BAR; PG8_SCHED;
        }
        if constexpr (ALIGN_EPI) { if (wr == 0) PG8_BAR; }
        E(acc, cur, wr, wc, fr, fq);
        if (!has_next) break;
#pragma unroll
        for (int a = 0; a < 2; ++a)
#pragma unroll
            for (int b = 0; b < 2; ++b)
#pragma unroll
                for (int m = 0; m < 4; ++m)
#pragma unroll
                    for (int n = 0; n < 2; ++n) acc[a][b][m][n] = (f32x4){0.f, 0.f, 0.f, 0.f};
        cur = nxt; cB = nB; ++ui;
#pragma unroll
        for (int h = 0; h < 2; ++h)
#pragma unroll
            for (int i = 0; i < 2; ++i) vc[h][i] = vn[h][i];
        if constexpr (ALIGN_EPI) { if (wr == 1) PG8_BAR; }
    }
    PG8_WAIT_V(0);
    if constexpr (!ALIGN_EPI) { if (wr == 0) PG8_BAR; }
    PG8_BAR;
#undef PG8_SA
#undef PG8_SB
#undef PG8_STAGE
#undef PG8_LDA
#undef PG8_LDB
#undef PG8_MMA
#undef PG8_WAIT_V
#undef PG8_WAIT_L
#undef PG8_BAR
#undef PG8_SCHED
#undef PG8_VOFF
}

struct EpiEvenIn {
    static constexpr bool PERM = true;
    bf16 *U, *GV, *Q, *Kb, *VT;
    __device__ __forceinline__ void operator()(const Acc& acc, const Unit& u, int wr, int wc, int fr, int fq) const {
        const int sel = u.pn >> 1;
        const int row0 = u.pm * BM + wr * 64 + fr;
        const int colt = (u.pn & 1) * BM + wc * 32 + 8 * fq;
        if (sel < 4) {
            bf16* base = sel == 0 ? U : sel == 1 ? GV : sel == 2 ? Q : Kb;
#pragma unroll
            for (int ai = 0; ai < 2; ++ai)
#pragma unroll
                for (int m = 0; m < 4; ++m) { bf16* rowp = base + (size_t)(row0 + ai * HALF + m * 16) * GW + colt;
#pragma unroll
                    for (int bj = 0; bj < 2; ++bj) { f32x4 v0 = acc[ai][bj][m][0], v1 = acc[ai][bj][m][1];
                        if (sel < 2) { f32x2 a = gelu_pk((f32x2){v0[0], v0[1]}), b = gelu_pk((f32x2){v0[2], v0[3]}), c = gelu_pk((f32x2){v1[0], v1[1]}), d = gelu_pk((f32x2){v1[2], v1[3]});
                            v0 = (f32x4){a.x, a.y, b.x, b.y}; v1 = (f32x4){c.x, c.y, d.x, d.y}; }
                        v4u w; w.x = cvt_pk_bf16(v0[0], v0[1]); w.y = cvt_pk_bf16(v0[2], v0[3]); w.z = cvt_pk_bf16(v1[0], v1[1]); w.w = cvt_pk_bf16(v1[2], v1[3]);
                        *(v4u*)(rowp + bj * HALF) = w; } }
        } else {
#pragma unroll
            for (int ai = 0; ai < 2; ++ai)
#pragma unroll
                for (int m = 0; m < 4; ++m) { const int tok = row0 + ai * HALF + m * 16; const int b = tok / SEQ, t = tok % SEQ;
#pragma unroll
                    for (int bj = 0; bj < 2; ++bj) { const int c0 = colt + bj * HALF;
#pragma unroll
                        for (int n = 0; n < 2; ++n)
#pragma unroll
                            for (int j = 0; j < 4; ++j) { const int c = c0 + 4 * n + j;
                                VT[((size_t)(b * NH) * HD + c) * SEQ + t] = (bf16)f2bf(acc[ai][bj][m][n][j]); } } }
        }
    }
};
struct EpiResF32 {
    static constexpr bool PERM = false;
    const float* R; float* X;
    __device__ __forceinline__ void operator()(const Acc& acc, const Unit& u, int wr, int wc, int fr, int fq) const {
        const int row0 = u.pm * BM + wr * 64 + fr, col0 = u.pn * BM + wc * 32 + 4 * fq;
#pragma unroll
        for (int ai = 0; ai < 2; ++ai)
#pragma unroll
            for (int m = 0; m < 4; ++m) { const size_t off = (size_t)(row0 + ai * HALF + m * 16) * D + col0;
#pragma unroll
                for (int bj = 0; bj < 2; ++bj)
#pragma unroll
                    for (int n = 0; n < 2; ++n) { const f32x4 r = *(const f32x4*)(R + off + bj * HALF + n * 16); *(f32x4*)(X + off + bj * HALF + n * 16) = r + acc[ai][bj][m][n]; } }
    }
};
struct EpiOddIn {
    static constexpr bool PERM = true;
    bf16 *Y, *GB;
    __device__ __forceinline__ void operator()(const Acc& acc, const Unit& u, int wr, int wc, int fr, int fq) const {
        const int row0 = u.pm * BM + wr * 64 + fr;
        if (u.pn < 8) {
            const int col = u.pn * HALF + wc * 32 + 8 * fq;
#pragma unroll
            for (int ai = 0; ai < 2; ++ai)
#pragma unroll
                for (int m = 0; m < 4; ++m) { const f32x4 v0 = acc[ai][0][m][0] * acc[ai][1][m][0], v1 = acc[ai][0][m][1] * acc[ai][1][m][1];
                    v4u w; w.x = cvt_pk_bf16(v0[0], v0[1]); w.y = cvt_pk_bf16(v0[2], v0[3]); w.z = cvt_pk_bf16(v1[0], v1[1]); w.w = cvt_pk_bf16(v1[2], v1[3]);
                    *(v4u*)(Y + (size_t)(row0 + ai * HALF + m * 16) * D + col) = w; }
        } else {
            const int col = (u.pn - 8) * BM + wc * 32 + 8 * fq;
#pragma unroll
            for (int ai = 0; ai < 2; ++ai)
#pragma unroll
                for (int m = 0; m < 4; ++m)
#pragma unroll
                    for (int bj = 0; bj < 2; ++bj) { const f32x4 v0 = acc[ai][bj][m][0], v1 = acc[ai][bj][m][1];
                        v4u w; w.x = cvt_pk_bf16(v0[0], v0[1]); w.y = cvt_pk_bf16(v0[2], v0[3]); w.z = cvt_pk_bf16(v1[0], v1[1]); w.w = cvt_pk_bf16(v1[2], v1[3]);
                        *(v4u*)(GB + (size_t)(row0 + ai * HALF + m * 16) * D + col + bj * HALF) = w; }
        }
    }
};
struct EpiMoeUp {
    static constexpr bool PERM = true;
    bf16* HM;
    __device__ __forceinline__ void operator()(const Acc& acc, const Unit& u, int wr, int wc, int fr, int fq) const {
        const int row0 = u.pm * BM + wr * 64 + fr, col = u.pn * HALF + wc * 32 + 8 * fq;
#pragma unroll
        for (int ai = 0; ai < 2; ++ai)
#pragma unroll
            for (int m = 0; m < 4; ++m) { float o[8];
#pragma unroll
                for (int n = 0; n < 2; ++n)
#pragma unroll
                    for (int j = 0; j < 4; ++j) { const float g = acc[ai][0][m][n][j], up = acc[ai][1][m][n][j];
                        o[4 * n + j] = g * __builtin_amdgcn_rcpf(1.0f + __builtin_amdgcn_exp2f(-1.44269504089f * g)) * up; }
                v4u w; w.x = cvt_pk_bf16(o[0], o[1]); w.y = cvt_pk_bf16(o[2], o[3]); w.z = cvt_pk_bf16(o[4], o[5]); w.w = cvt_pk_bf16(o[6], o[7]);
                *(v4u*)(HM + (size_t)(row0 + ai * HALF + m * 16) * FF + col) = w; }
    }
};
struct EpiMoeDown {
    static constexpr bool PERM = true;
    bf16* CONTRIB; const unsigned* list; const float* selw; const LAS int* cnt;
    __device__ __forceinline__ void operator()(const Acc& acc, const Unit& u, int wr, int wc, int fr, int fq) const {
        const int n_e = cnt[u.e]; const unsigned* le = list + (size_t)u.e * LIST_CAP + u.mt * BM;
        const int col = u.pn * BM + wc * 32 + 8 * fq;
#pragma unroll
        for (int ai = 0; ai < 2; ++ai)
#pragma unroll
            for (int m = 0; m < 4; ++m) { const int r = ai * HALF + wr * 64 + m * 16 + fr;
                if (u.mt * BM + r < n_e) { const unsigned ent = le[r]; const float w = selw[ent];
                    bf16* rowp = CONTRIB + ((size_t)(ent & 1u) * T + (ent >> 1)) * D + col;
#pragma unroll
                    for (int bj = 0; bj < 2; ++bj) { const f32x4 v0 = acc[ai][bj][m][0] * w, v1 = acc[ai][bj][m][1] * w;
                        v4u o; o.x = cvt_pk_bf16(v0[0], v0[1]); o.y = cvt_pk_bf16(v0[2], v0[3]); o.z = cvt_pk_bf16(v1[0], v1[1]); o.w = cvt_pk_bf16(v1[2], v1[3]);
                        *(v4u*)(rowp + bj * HALF) = o; } } }
    }
};
}

struct Frame {
    LAS unsigned char* lds;
    volatile LAS unsigned* MISC;
    gu32* ctl;
    int tid, lane, wave, vcu, G;
};

__device__ __forceinline__ void p0_transpose_item(const float* W, int K, int N, bf16* WT, int k0, int n0, int orow0, LAS float* scr, int lane) {
#pragma unroll 8
    for (int i = 0; i < 32; ++i) { const int kk = 2 * i + (lane >> 5); scr[kk * 33 + (lane & 31)] = W[(size_t)(k0 + kk) * N + n0 + (lane & 31)]; }
    LDS_WAIT(); asm volatile("" ::: "memory");
    const int c = lane & 7;
#pragma unroll
    for (int j = 0; j < 4; ++j) { const int n = (lane >> 3) + 8 * j; const LAS float* s = scr + (8 * c) * 33 + n;
        v4u o; o.x = pk2(s[0 * 33], s[1 * 33]); o.y = pk2(s[2 * 33], s[3 * 33]); o.z = pk2(s[4 * 33], s[5 * 33]); o.w = pk2(s[6 * 33], s[7 * 33]);
        *(GAS v4u*)(WT + (size_t)(orow0 + n) * K + k0 + 8 * c) = o; }
    LDS_WAIT(); asm volatile("" ::: "memory");
}
__device__ __forceinline__ void norm_row(int lane, const float* xrow, const bf16* c0, const bf16* c1, const float* gain, float* xs, bf16* ob, float* of32) {
    const GAS f32x4* xr = (const GAS f32x4*)xrow + lane;
    f32x4 v[4]; float s = 0.f;
#pragma unroll
    for (int j = 0; j < 4; ++j) v[j] = xr[64 * j];
    if (c0) {
#pragma unroll
        for (int j = 0; j < 4; ++j) { const v2u a = *((const GAS v2u*)c0 + lane + 64 * j), b = *((const GAS v2u*)c1 + lane + 64 * j);
            v[j].x += bf_lo(a.x) + bf_lo(b.x); v[j].y += bf_hi(a.x) + bf_hi(b.x); v[j].z += bf_lo(a.y) + bf_lo(b.y); v[j].w += bf_hi(a.y) + bf_hi(b.y); }
    }
#pragma unroll
    for (int j = 0; j < 4; ++j) s += (v[j].x * v[j].x + v[j].y * v[j].y) + (v[j].z * v[j].z + v[j].w * v[j].w);
    if (xs) {
#pragma unroll
        for (int j = 0; j < 4; ++j) *((GAS f32x4*)xs + lane + 64 * j) = v[j]; }
    const float rstd = rsqrtf(wave_sum(s) * (1.f / D) + EPS);
#pragma unroll
    for (int j = 0; j < 4; ++j) { const f32x4 g = *((const GAS f32x4*)gain + lane + 64 * j); v[j] = v[j] * rstd * g; }
    if (ob) {
#pragma unroll
        for (int j = 0; j < 4; ++j) { v2u o; o.x = pk2(v[j].x, v[j].y); o.y = pk2(v[j].z, v[j].w); *((GAS v2u*)ob + lane + 64 * j) = o; } }
    if (of32) {
#pragma unroll
        for (int j = 0; j < 4; ++j) *((GAS f32x4*)of32 + lane + 64 * j) = v[j]; }
}

struct Args { const float* in[17]; float* out; unsigned char* ws; unsigned mask; int single; };

__device__ __forceinline__ void phase_prologue(Frame& F, const Args& a) {
    LAS float* scr = (LAS float*)(F.lds + F.wave * 16384);
    const int gw = F.vcu * NWAVES + F.wave, NGW = F.G * NWAVES;
    unsigned char* ws = a.ws;
    constexpr int I_IN0 = 16 * (EVEN_IN / 32), I_OUT = 16 * (D / 32), I_IN1 = 16 * (ODD_IN / 32);
    constexpr int I_G = 16 * (FF / 32), I_D = 8 * (D / 32), I_E = 2 * I_G + I_D;
    constexpr int I_DENSE = I_IN0 + 2 * I_OUT + I_IN1, NITEMS = I_DENSE + 2 * NEXP * I_E;
    for (int it = gw; it < NITEMS; it += NGW) {
        int r = it;
        if (r < I_IN0) { const int nb = EVEN_IN / 32; p0_transpose_item(a.in[1], D, EVEN_IN, (bf16*)(ws + WS_WIN0), 64 * (r / nb), 32 * (r % nb), 32 * (r % nb), scr, F.lane); continue; } r -= I_IN0;
        if (r < I_OUT) { const int nb = D / 32; p0_transpose_item(a.in[2], D, D, (bf16*)(ws + WS_WOUT0), 64 * (r / nb), 32 * (r % nb), 32 * (r % nb), scr, F.lane); continue; } r -= I_OUT;
        if (r < I_IN1) { const int nb = ODD_IN / 32; const int n0 = 32 * (r % nb);
            const int sec = n0 / D, c = n0 % D; const int orow = sec == 0 ? 2048 + c : 256 * (c / 128) + (sec == 2 ? 128 : 0) + (c % 128);
            p0_transpose_item(a.in[6], D, ODD_IN, (bf16*)(ws + WS_WIN1), 64 * (r / nb), n0, orow, scr, F.lane); continue; } r -= I_IN1;
        if (r < I_OUT) { const int nb = D / 32; p0_transpose_item(a.in[8], D, D, (bf16*)(ws + WS_WOUT1), 64 * (r / nb), 32 * (r % nb), 32 * (r % nb), scr, F.lane); continue; } r -= I_OUT;
        const int le = r / I_E; r -= le * I_E;
        if (r < 2 * I_G) { const int up = r >= I_G; if (up) r -= I_G; const int nb = FF / 32; const int n0 = 32 * (r % nb);
            const float* W = (up ? a.in[14] : a.in[13]) + (size_t)le * D * FF;
            p0_transpose_item(W, D, FF, (bf16*)(ws + WS_WGU) + (size_t)le * 1024 * D, 64 * (r / nb), n0, 256 * (n0 / 128) + (up ? 128 : 0) + (n0 % 128), scr, F.lane); continue; }
        r -= 2 * I_G;
        { const int nb = D / 32; p0_transpose_item(a.in[15] + (size_t)le * FF * D, FF, D, (bf16*)(ws + WS_WD) + (size_t)le * D * FF, 64 * (r / nb), 32 * (r % nb), 32 * (r % nb), scr, F.lane); }
    }
    { const float* wsrc = a.in[3]; bf16* wt = (bf16*)(ws + WS_WTRIL);
      for (int i = (F.vcu * 512 + F.tid) * 4; i < NG * CHUNK * CHUNK; i += F.G * 512 * 4) { const int t = (i / CHUNK) % CHUNK, s = i % CHUNK; const f32x4 v = *(const f32x4*)(wsrc + i);
          v2u o; o.x = pk2(s <= t ? v.x : 0.f, s + 1 <= t ? v.y : 0.f); o.y = pk2(s + 2 <= t ? v.z : 0.f, s + 3 <= t ? v.w : 0.f); *(v2u*)(wt + i) = o; } }
    { bf16* wr = (bf16*)(ws + WS_WR);
      for (int i = F.vcu * 512 + F.tid; i < 2 * 48 * D; i += F.G * 512) { const int k = i % D, c = (i / D) % 48, l = i / (48 * D);
          float w = 0.f;
          if (c < NGRP) w = a.in[11][((size_t)l * D + k) * NGRP + c];
          else if (c < NGRP + NEXP) { const int g = (c - NGRP) / EPG, e = (c - NGRP) % EPG; w = a.in[12][(((size_t)l * NGRP + g) * D + k) * EPG + e]; }
          w *= a.in[10][l * D + k];
          const unsigned hi = f2bf(w); const float rem = w - __builtin_bit_cast(float, hi << 16);
          wr[((size_t)(l * 2 + 0) * 48 + c) * D + k] = (bf16)hi; wr[((size_t)(l * 2 + 1) * 48 + c) * D + k] = (bf16)f2bf(rem); } }
    for (int m = gw; m < T; m += NGW) norm_row(F.lane, a.in[0] + (size_t)m * D, nullptr, nullptr, a.in[9], nullptr, (bf16*)(ws + WS_H) + (size_t)m * D, nullptr);
}

__device__ __forceinline__ void gmlp_unit(Frame& F, const Args& a, int unit) {
    unsigned char* ws = a.ws;
    const bf16* U = (const bf16*)(ws + WS_ACT); const bf16* GV = U + (size_t)T * GW; const bf16* WT = (const bf16*)(ws + WS_WTRIL); bf16* MIX = (bf16*)(ws + WS_MIX);
    const int g = unit % NG, n = (unit / NG) % (SEQ / CHUNK), b = unit / (NG * (SEQ / CHUNK));
    const int tok0 = b * SEQ + n * CHUNK;
    constexpr int VSTR = 136;
    LAS bf16* vnT = (LAS bf16*)F.lds;
    { const int s = F.tid >> 2, cg = F.tid & 3;
      const v4u r0 = *(const v4u*)(GV + (size_t)(tok0 + s) * GW + g * GD + 16 * cg), r1 = *(const v4u*)(GV + (size_t)(tok0 + s) * GW + g * GD + 16 * cg + 8);
      float v[16]; const unsigned w[8] = {r0.x, r0.y, r0.z, r0.w, r1.x, r1.y, r1.z, r1.w};
#pragma unroll
      for (int i = 0; i < 8; ++i) { v[2 * i] = bf_lo(w[i]); v[2 * i + 1] = bf_hi(w[i]); }
      float ss = 0.f;
#pragma unroll
      for (int i = 0; i < 16; ++i) ss += v[i] * v[i];
      ss += __shfl_xor(ss, 1); ss += __shfl_xor(ss, 2);
      const float rstd = rsqrtf(ss * (1.0f / GD) + EPS);
      const float* gn = a.in[5] + g * GD + 16 * cg;
#pragma unroll
      for (int i = 0; i < 16; ++i) vnT[(16 * cg + i) * VSTR + s] = (bf16)f2bf(v[i] * rstd * gn[i]); }
    __syncthreads();
    { const int db = F.wave & 1, tb = F.wave >> 1, r = F.lane & 31, h = F.lane >> 5;
      f32x16 x;
_Pragma("unroll") for (int i = 0; i < 16; ++i) x[i] = 0.f;
      const bf16* wrow = WT + ((size_t)g * CHUNK + 32 * tb + r) * CHUNK + 8 * h;
      const LAS bf16* vrow = vnT + (32 * db + r) * VSTR + 8 * h;
      for (int kk = 0; kk < 2 * (tb + 1); ++kk) {
          const bf16x8 av = *(const LAS bf16x8*)(vrow + 16 * kk);
          const bf16x8 bw = *(const bf16x8*)(wrow + 16 * kk);
          x = __builtin_amdgcn_mfma_f32_32x32x16_bf16(av, bw, x, 0, 0, 0);
      }
      const int t = 32 * tb + r; const float bias = a.in[4][g * CHUNK + t];
      const bf16* urow = U + (size_t)(tok0 + t) * GW + g * GD + 32 * db + 4 * h; bf16* orow = MIX + (size_t)(tok0 + t) * D + g * GD + 32 * db + 4 * h;
#pragma unroll
      for (int q = 0; q < 4; ++q) { const v2u uu = *(const v2u*)(urow + 8 * q);
          v2u o; o.x = pk2(bf_lo(uu.x) * (x[4 * q] + bias), bf_hi(uu.x) * (x[4 * q + 1] + bias)); o.y = pk2(bf_lo(uu.y) * (x[4 * q + 2] + bias), bf_hi(uu.y) * (x[4 * q + 3] + bias));
          *(v2u*)(orow + 8 * q) = o; } }
    __syncthreads();
}

template <bool DIAG>
__device__ __forceinline__ void sb_tile(const f32x16& s, float& carry, bf16x8& p0, bf16x8& p1, int r, int hh) {
    float l[16], lk[16];
#pragma unroll
    for (int i = 0; i < 16; ++i) {
        const float n = fminf(s[i] * (-0.125f * 1.44269504089f), 126.0f);
        const float e = __builtin_amdgcn_exp2f(n);
        l[i] = __builtin_amdgcn_logf(1.0f + e);
        lk[i] = n - l[i];
        if (DIAG) { const int key = 16 * (i >> 3) + 8 * hh + (i & 7); if (key >= r) lk[i] = 0.f; }
    }
    float suf[16]; float run0 = 0.f, run1 = 0.f;
#pragma unroll
    for (int j = 7; j >= 0; --j) { suf[j] = run0; run0 += lk[j]; suf[8 + j] = run1; run1 += lk[8 + j]; }
    const float o0 = __shfl_xor(run0, 32), o1 = __shfl_xor(run1, 32);
    const float afterA = hh == 0 ? (o0 + run1 + o1) : (o1 + run1);
    const float afterB = hh == 0 ? o1 : 0.f;
    float pa[16];
#pragma unroll
    for (int i = 0; i < 16; ++i) {
        const float arg = carry + (i < 8 ? afterA : afterB) + suf[i] - l[i];
        pa[i] = __builtin_amdgcn_exp2f(arg);
        if (DIAG) { const int key = 16 * (i >> 3) + 8 * hh + (i & 7); if (key >= r) pa[i] = 0.f; }
    }
    carry += (run0 + run1) + (o0 + o1);
    v4u w0, w1;
    w0.x = cvt_pk_bf16(pa[0], pa[1]); w0.y = cvt_pk_bf16(pa[2], pa[3]); w0.z = cvt_pk_bf16(pa[4], pa[5]); w0.w = cvt_pk_bf16(pa[6], pa[7]);
    w1.x = cvt_pk_bf16(pa[8], pa[9]); w1.y = cvt_pk_bf16(pa[10], pa[11]); w1.z = cvt_pk_bf16(pa[12], pa[13]); w1.w = cvt_pk_bf16(pa[14], pa[15]);
    p0 = __builtin_bit_cast(bf16x8, w0); p1 = __builtin_bit_cast(bf16x8, w1);
}
__device__ __forceinline__ void sb_task(const Args& a, int lane, int bh, int qblk) {
    unsigned char* ws = a.ws;
    const bf16* Q = (const bf16*)(ws + WS_ACT) + (size_t)2 * T * GW; const bf16* Kb = Q + (size_t)T * SBW; const bf16* VT = Kb + (size_t)T * SBW; bf16* MIX = (bf16*)(ws + WS_MIX);
    const int b = bh / NH, h = bh % NH, r = lane & 31, hh = lane >> 5;
    const int q0 = qblk * 32;
    const int kap = (r & ~12) | ((r & 4) << 1) | ((r & 8) >> 1);
    bf16x8 qf[4];
    { const bf16* qp = Q + (size_t)(b * SEQ + q0 + r) * SBW + h * HD + 8 * hh;
#pragma unroll
      for (int kk = 0; kk < 4; ++kk) qf[kk] = *(const bf16x8*)(qp + 16 * kk); }
    const bf16* kbase = Kb + (size_t)(b * SEQ + kap) * SBW + h * HD + 8 * hh;
    const bf16* vbase = VT + ((size_t)bh * HD + r) * SEQ + 8 * hh;
    f32x16 o0, o1;
_Pragma("unroll") for (int i = 0; i < 16; ++i) { o0[i] = 0.f; o1[i] = 0.f; }
    float carry = 0.f;
    bf16x8 kf[4], vf[2][2];
    int k0 = q0;
#pragma unroll
    for (int kk = 0; kk < 4; ++kk) kf[kk] = *(const bf16x8*)(kbase + (size_t)k0 * SBW + 16 * kk);
#pragma unroll
    for (int db = 0; db < 2; ++db)
#pragma unroll
        for (int s = 0; s < 2; ++s) vf[db][s] = *(const bf16x8*)(vbase + (size_t)(32 * db) * SEQ + k0 + 16 * s);
    bool diag = true;
    for (;;) {
        f32x16 sc;
_Pragma("unroll") for (int i = 0; i < 16; ++i) sc[i] = 0.f;
#pragma unroll
        for (int kk = 0; kk < 4; ++kk) sc = __builtin_amdgcn_mfma_f32_32x32x16_bf16(kf[kk], qf[kk], sc, 0, 0, 0);
        bf16x8 vcur[2][2];
#pragma unroll
        for (int db = 0; db < 2; ++db)
#pragma unroll
            for (int s = 0; s < 2; ++s) vcur[db][s] = vf[db][s];
        const int kn = k0 - 32;
        if (kn >= 0) {
#pragma unroll
            for (int kk = 0; kk < 4; ++kk) kf[kk] = *(const bf16x8*)(kbase + (size_t)kn * SBW + 16 * kk);
#pragma unroll
            for (int db = 0; db < 2; ++db)
#pragma unroll
                for (int s = 0; s < 2; ++s) vf[db][s] = *(const bf16x8*)(vbase + (size_t)(32 * db) * SEQ + kn + 16 * s);
        }
        bf16x8 p0, p1;
        if (diag) sb_tile<true>(sc, carry, p0, p1, r, hh); else sb_tile<false>(sc, carry, p0, p1, r, hh);
        diag = false;
        o0 = __builtin_amdgcn_mfma_f32_32x32x16_bf16(vcur[0][0], p0, o0, 0, 0, 0);
        o0 = __builtin_amdgcn_mfma_f32_32x32x16_bf16(vcur[0][1], p1, o0, 0, 0, 0);
        o1 = __builtin_amdgcn_mfma_f32_32x32x16_bf16(vcur[1][0], p0, o1, 0, 0, 0);
        o1 = __builtin_amdgcn_mfma_f32_32x32x16_bf16(vcur[1][1], p1, o1, 0, 0, 0);
        if (kn < 0) break;
        if (__all(carry < -150.0f)) break;
        k0 = kn;
    }
    bf16* orow = MIX + (size_t)(b * SEQ + q0 + r) * D + GW + h * HD + 4 * hh;
#pragma unroll
    for (int q = 0; q < 4; ++q) {
        v2u w; w.x = cvt_pk_bf16(o0[4 * q], o0[4 * q + 1]); w.y = cvt_pk_bf16(o0[4 * q + 2], o0[4 * q + 3]); *(v2u*)(orow + 8 * q) = w;
        v2u w2; w2.x = cvt_pk_bf16(o1[4 * q], o1[4 * q + 1]); w2.y = cvt_pk_bf16(o1[4 * q + 2], o1[4 * q + 3]); *(v2u*)(orow + 32 + 8 * q) = w2;
    }
}

struct RouteW { bf16x8 w[3][4][2]; };
__device__ __forceinline__ void route_load_w(RouteW& R, const Args& a, int layer, int wave, int lane) {
    const int fr = lane & 15, fq = lane >> 4;
    const bf16* wh = (const bf16*)(a.ws + WS_WR) + ((size_t)(layer * 2) * 48 + fr) * D + 128 * wave + 8 * fq;
#pragma unroll
    for (int cb = 0; cb < 3; ++cb)
#pragma unroll
        for (int s = 0; s < 4; ++s)
#pragma unroll
            for (int p = 0; p < 2; ++p) R.w[cb][s][p] = *(const bf16x8*)(wh + ((size_t)p * 48 + 16 * cb) * D + 32 * s);
}
__device__ __forceinline__ void route_round(const RouteW& R, const Args& a, LAS unsigned char* lds, int tid, int wave, int lane, int layer, int tok0, const float* X, bf16* H, unsigned* cntw, unsigned* list, float* selw) {
    LAS float* plog = (LAS float*)lds;
    LAS float* psq = (LAS float*)(lds + 49152);
    LAS float* lgf = (LAS float*)(lds + 49152 + 1024);
    LAS float* rs = (LAS float*)(lds + 49152 + 1024 + 6144);
    volatile LAS unsigned* hist = (volatile LAS unsigned*)(lds + 49152 + 1024 + 6144 + 128);
    const int fr = lane & 15, fq = lane >> 4;
    if (tid < 64) hist[tid] = 0u;
    f32x4 xp[2][4], xq[2][4];
#pragma unroll
    for (int mt = 0; mt < 2; ++mt)
#pragma unroll
        for (int s = 0; s < 4; ++s) { const float* xr = X + (size_t)(tok0 + 16 * mt + fr) * D + 128 * wave + 32 * s + 8 * fq; xp[mt][s] = *(const f32x4*)xr; xq[mt][s] = *(const f32x4*)(xr + 4); }
#pragma unroll
    for (int mt = 0; mt < 2; ++mt) {
        f32x4 acc[3]; float ss = 0.f;
#pragma unroll
        for (int cb = 0; cb < 3; ++cb) acc[cb] = (f32x4){0.f, 0.f, 0.f, 0.f};
#pragma unroll
        for (int s = 0; s < 4; ++s) { const f32x4 p = xp[mt][s], q = xq[mt][s];
            ss += (p.x * p.x + p.y * p.y) + (p.z * p.z + p.w * p.w) + (q.x * q.x + q.y * q.y) + (q.z * q.z + q.w * q.w);
            v4u hi; hi.x = cvt_pk_bf16(p.x, p.y); hi.y = cvt_pk_bf16(p.z, p.w); hi.z = cvt_pk_bf16(q.x, q.y); hi.w = cvt_pk_bf16(q.z, q.w);
            v4u lo; lo.x = cvt_pk_bf16(p.x - bf_lo(hi.x), p.y - bf_hi(hi.x)); lo.y = cvt_pk_bf16(p.z - bf_lo(hi.y), p.w - bf_hi(hi.y));
            lo.z = cvt_pk_bf16(q.x - bf_lo(hi.z), q.y - bf_hi(hi.z)); lo.w = cvt_pk_bf16(q.z - bf_lo(hi.w), q.w - bf_hi(hi.w));
            const bf16x8 xh = __builtin_bit_cast(bf16x8, hi), xl = __builtin_bit_cast(bf16x8, lo);
#pragma unroll
            for (int cb = 0; cb < 3; ++cb) {
                acc[cb] = __builtin_amdgcn_mfma_f32_16x16x32_bf16(R.w[cb][s][0], xh, acc[cb], 0, 0, 0);
                acc[cb] = __builtin_amdgcn_mfma_f32_16x16x32_bf16(R.w[cb][s][1], xh, acc[cb], 0, 0, 0);
                acc[cb] = __builtin_amdgcn_mfma_f32_16x16x32_bf16(R.w[cb][s][0], xl, acc[cb], 0, 0, 0);
            } }
        ss += __shfl_xor(ss, 16); ss += __shfl_xor(ss, 32);
#pragma unroll
        for (int cb = 0; cb < 3; ++cb) *(LAS f32x4*)(plog + (wave * 32 + 16 * mt + fr) * 48 + 16 * cb + 4 * fq) = acc[cb];
        if (fq == 0) psq[wave * 32 + 16 * mt + fr] = ss;
    }
    __syncthreads();
    { const int t = tid >> 4, c0 = 3 * (tid & 15);
      float q = 0.f, l0 = 0.f, l1 = 0.f, l2 = 0.f;
#pragma unroll
      for (int w = 0; w < 8; ++w) { q += psq[w * 32 + t]; const LAS float* pl = plog + (w * 32 + t) * 48 + c0; l0 += pl[0]; l1 += pl[1]; l2 += pl[2]; }
      const float rstd = rsqrtf(q * (1.f / D) + EPS);
      lgf[t * 48 + c0] = l0 * rstd; lgf[t * 48 + c0 + 1] = l1 * rstd; lgf[t * 48 + c0 + 2] = l2 * rstd;
      if ((tid & 15) == 0) rs[t] = rstd; }
    __syncthreads();
    int ea = 0, eb = 0; unsigned ra = 0, rb = 0; float wa_ = 0.f, wb_ = 0.f;
    if (tid < 32) {
        const LAS float* my = lgf + tid * 48;
        float gl[4];
#pragma unroll
        for (int g = 0; g < NGRP; ++g) gl[g] = my[g];
        int tg = 0; float mx = gl[0];
#pragma unroll
        for (int g = 1; g < NGRP; ++g) if (gl[g] > mx) { mx = gl[g]; tg = g; }
        float den = 0.f;
#pragma unroll
        for (int g = 0; g < NGRP; ++g) den += __expf(gl[g] - mx);
        const float top_gp = 1.0f / den;
        float el[8];
#pragma unroll
        for (int e = 0; e < EPG; ++e) el[e] = my[NGRP + 8 * tg + e];
        int e0 = 0; float l0 = el[0];
#pragma unroll
        for (int e = 1; e < EPG; ++e) if (el[e] > l0) { l0 = el[e]; e0 = e; }
        int e1 = 0; float l1 = -INFINITY;
#pragma unroll
        for (int e = 0; e < EPG; ++e) if (e != e0 && el[e] > l1) { l1 = el[e]; e1 = e; }
        const float p1 = __expf(l1 - l0), inv = 1.0f / (1.0f + p1);
        ea = tg * EPG + e0; eb = tg * EPG + e1; wa_ = top_gp * inv; wb_ = top_gp * p1 * inv;
        ra = __hip_atomic_fetch_add((LAS unsigned*)hist + ea, 1u, __ATOMIC_RELAXED, __HIP_MEMORY_SCOPE_WORKGROUP);
        rb = __hip_atomic_fetch_add((LAS unsigned*)hist + eb, 1u, __ATOMIC_RELAXED, __HIP_MEMORY_SCOPE_WORKGROUP);
    }
    { const float* gain = a.in[10] + layer * D + 128 * wave + 8 * fq;
#pragma unroll
      for (int s = 0; s < 4; ++s) { const f32x4 gp = *(const f32x4*)(gain + 32 * s), gq = *(const f32x4*)(gain + 32 * s + 4);
#pragma unroll
          for (int mt = 0; mt < 2; ++mt) { const float r = rs[16 * mt + fr]; const f32x4 hp = xp[mt][s] * r * gp, hq = xq[mt][s] * r * gq;
              v4u hi; hi.x = cvt_pk_bf16(hp.x, hp.y); hi.y = cvt_pk_bf16(hp.z, hp.w); hi.z = cvt_pk_bf16(hq.x, hq.y); hi.w = cvt_pk_bf16(hq.z, hq.w);
              *(v4u*)(H + (size_t)(tok0 + 16 * mt + fr) * D + 128 * wave + 32 * s + 8 * fq) = hi; } } }
    __syncthreads();
    if (tid < NEXP) { const unsigned c = hist[tid]; if (c) hist[32 + tid] = __hip_atomic_fetch_add(cntw + (layer * NEXP + tid) * 64, c, RLX_AGENT); }
    __syncthreads();
    if (tid < 32) {
        const int t = tok0 + tid;
        list[(size_t)ea * LIST_CAP + hist[32 + ea] + ra] = (unsigned)(t * 2); list[(size_t)eb * LIST_CAP + hist[32 + eb] + rb] = (unsigned)(t * 2 + 1);
        selw[t * 2] = wa_; selw[t * 2 + 1] = wb_;
    }
    __syncthreads();
}

__device__ __forceinline__ void moe_tables(Frame& F, int layer) {
    volatile LAS int* cnt = (volatile LAS int*)(F.lds + LDSCTL_OFF);
    volatile LAS int* tst = cnt + 32;
    if (F.tid < NEXP) cnt[F.tid] = (int)__hip_atomic_load(F.ctl + CW_CNT + (layer * NEXP + F.tid) * 64, RLX_AGENT);
    __syncthreads();
    if (F.tid == 0) { int acc = 0; for (int e = 0; e < NEXP; ++e) { tst[e] = acc; acc += (cnt[e] + 255) >> 8; } tst[NEXP] = acc; }
    __syncthreads();
}

__device__ __forceinline__ void conv_phase(Frame& F, const Args& a) {
    unsigned char* ws = a.ws;
    const bf16* Y = (const bf16*)(ws + WS_ACT); const bf16* GB = Y + (size_t)T * D; bf16* MIX = (bf16*)(ws + WS_MIX);
    const float* cw = a.in[7];
    for (int it = F.vcu * 512 + F.tid; it < (T / 16) * (D / 8); it += F.G * 512) {
        const int cg = it % (D / 8), tb = it / (D / 8), c0 = cg * 8, tok0 = tb * 16;
        float w0[8], w1[8], w2[8];
#pragma unroll
        for (int j = 0; j < 8; ++j) { w0[j] = cw[c0 + j]; w1[j] = cw[D + c0 + j]; w2[j] = cw[2 * D + c0 + j]; }
        float ym2[8], ym1[8];
        const bool first = (tok0 % SEQ) == 0;
        { v4u r1 = {0, 0, 0, 0}, r2 = {0, 0, 0, 0};
          if (!first) { r2 = *(const v4u*)(Y + (size_t)(tok0 - 2) * D + c0); r1 = *(const v4u*)(Y + (size_t)(tok0 - 1) * D + c0); }
          const unsigned a2[4] = {r2.x, r2.y, r2.z, r2.w}, a1[4] = {r1.x, r1.y, r1.z, r1.w};
#pragma unroll
          for (int j = 0; j < 4; ++j) { ym2[2 * j] = bf_lo(a2[j]); ym2[2 * j + 1] = bf_hi(a2[j]); ym1[2 * j] = bf_lo(a1[j]); ym1[2 * j + 1] = bf_hi(a1[j]); } }
#pragma unroll 4
        for (int t = 0; t < 16; ++t) {
            const v4u ry = *(const v4u*)(Y + (size_t)(tok0 + t) * D + c0), rg = *(const v4u*)(GB + (size_t)(tok0 + t) * D + c0);
            const unsigned ay[4] = {ry.x, ry.y, ry.z, ry.w}, ag[4] = {rg.x, rg.y, rg.z, rg.w};
            float y[8], o[8];
#pragma unroll
            for (int j = 0; j < 4; ++j) { y[2 * j] = bf_lo(ay[j]); y[2 * j + 1] = bf_hi(ay[j]); }
#pragma unroll
            for (int j = 0; j < 8; ++j) { const float gbv = (j & 1) ? bf_hi(ag[j >> 1]) : bf_lo(ag[j >> 1]); o[j] = gbv * (w0[j] * ym2[j] + w1[j] * ym1[j] + w2[j] * y[j]); ym2[j] = ym1[j]; ym1[j] = y[j]; }
            v4u w; w.x = pk2(o[0], o[1]); w.y = pk2(o[2], o[3]); w.z = pk2(o[4], o[5]); w.w = pk2(o[6], o[7]);
            *(v4u*)(MIX + (size_t)(tok0 + t) * D + c0) = w;
        }
    }
}

constexpr int NPHASE = 15;
__global__ void __launch_bounds__(NWAVES * 64, 2) mk_fwd(Args args) {
    extern __shared__ __attribute__((aligned(16))) unsigned char lds[];
    Frame F;
    F.lds = (LAS unsigned char*)lds;
    F.MISC = (volatile LAS unsigned*)(F.lds + MISC_OFF);
    F.tid = threadIdx.x; F.lane = F.tid & 63; F.wave = __builtin_amdgcn_readfirstlane(F.tid >> 6);
    F.G = gridDim.x; { const int bx = blockIdx.x; F.vcu = (F.G % 8 == 0) ? (bx % 8) * (F.G / 8) + bx / 8 : bx; }
    unsigned char* ws = args.ws;
    F.ctl = (gu32*)(ws + WS_CTL);
    for (int u = F.tid; u < (LDS_BYTES - LDSCTL_OFF) / 4; u += NWAVES * 64) ((LAS unsigned*)(F.lds + LDSCTL_OFF))[u] = 0u;
    __syncthreads();
    XcdBarrier bar; bar.bar = (unsigned*)(F.ctl + CW_BAR); bar.x = 0; bar.st = nullptr;
    if (args.single) bar = xcd_barrier_post((unsigned*)(F.ctl + CW_BAR), F.MISC + 8);
    const unsigned mask = args.mask;
#ifndef PHCT
#define PHCT 0x7fffu
#endif
#define RUN(k) (((PHCT >> (k)) & 1u) && ((mask >> (k)) & 1u))
#define SEAM(k) do { STAMP(3 * (k) + 1); if (args.single && (k) + 1 < NPHASE) xcd_barrier(bar); STAMP(3 * (k) + 2); } while (0)
#ifndef REPEAT
#define REPEAT (-1)
#endif
#ifdef TS_A
#ifndef TS_BLOCK
#define TS_BLOCK 0
#endif
#define STAMP(k) do { if (blockIdx.x == (TS_BLOCK) && F.tid == 0) __hip_atomic_store(F.ctl + CW_TS + (k), (unsigned)__builtin_amdgcn_s_memrealtime(), RLX_AGENT); } while (0)
#else
#define STAMP(k) do { } while (0)
#endif
#ifndef RMODE
#define RMODE 0
#endif
#define REPS(k) for (int rep_ = 0; rep_ < ((REPEAT) == (k) ? 2 : 1); ++rep_)
    const LAS int* cntL = (const LAS int*)(F.lds + LDSCTL_OFF); const LAS int* tstL = cntL + 32;
    bf16* const Hb = (bf16*)(ws + WS_H); bf16* const ACT = (bf16*)(ws + WS_ACT); bf16* const MIXb = (bf16*)(ws + WS_MIX); float* const Xf = (float*)(ws + WS_X);
    bf16* const CONTRIB = (bf16*)(ws + WS_CONTRIB); unsigned* const LIST = (unsigned*)(ws + WS_LIST); float* const SELW = (float*)(ws + WS_SELW);
    const int gw = F.vcu * NWAVES + F.wave, NGW = F.G * NWAVES;

    if (RUN(0)) REPS(0) { phase_prologue(F, args); SEAM(0); }
    if (RUN(1)) REPS(1) {
        pg8::DenseOrder S; S.init(T, EVEN_IN, D, (const bf16*)(ws + WS_WIN0), F.G, (int)blockIdx.x);
        pg8::EpiEvenIn E{ACT, ACT + (size_t)T * GW, ACT + (size_t)2 * T * GW, ACT + (size_t)3 * T * GW, ACT + (size_t)4 * T * GW};
        pg8::gemm_phase<pg8::EpiEvenIn, pg8::DenseOrder, true>(F.lds, Hb, D, S, E);
        SEAM(1);
    }
    if (RUN(2)) REPS(2) {
        for (int u = F.vcu; u < BATCH * (SEQ / CHUNK) * NG; u += F.G) gmlp_unit(F, args, u);
        for (int t = gw; t < 2 * 2048; t += NGW) {
            const int rnd = t >> 11, tt = t & 2047; const int bh = (tt >> 6) + 32 * rnd, qb = tt & 63;
            sb_task(args, F.lane, bh, rnd ? 63 - qb : qb);
        }
        SEAM(2);
    }
    if (RUN(3)) REPS(3) {
        pg8::DenseOrder S; S.init(T, D, D, (const bf16*)(ws + WS_WOUT0), F.G, (int)blockIdx.x);
        pg8::EpiResF32 E{args.in[0], Xf};
        pg8::gemm_phase<pg8::EpiResF32, pg8::DenseOrder, false>(F.lds, MIXb, D, S, E);
        SEAM(3);
    }
#define MOE_PHASES(layer, pb) do { \
        if (RUN(pb)) REPS(pb) { \
            { RouteW RW; route_load_w(RW, args, layer, F.wave, F.lane); \
              for (int rd = F.vcu; rd < T / 32; rd += F.G) route_round(RW, args, F.lds, F.tid, F.wave, F.lane, layer, rd * 32, Xf, Hb, (unsigned*)(F.ctl + CW_CNT) + (rep_ ? 2 * NEXP * 64 : 0), rep_ ? (unsigned*)(ws + WS_CONTRIB) : LIST, rep_ ? (float*)(ws + WS_CONTRIB + 4 * MiB) : SELW); } \
            SEAM(pb); \
        } \
        if (RUN((pb) + 1)) REPS((pb) + 1) { \
            moe_tables(F, layer); \
            pg8::MoeOrder S{cntL, tstL, (int)blockIdx.x, F.G, (const bf16*)(ws + WS_WGU) + (size_t)(layer) * NEXP * 1024 * D, (size_t)1024 * D, D, LIST, true}; \
            pg8::EpiMoeUp E{ACT}; \
            pg8::gemm_phase<pg8::EpiMoeUp, pg8::MoeOrder, true>(F.lds, Hb, D, S, E); \
            SEAM((pb) + 1); \
        } \
        if (RUN((pb) + 2)) REPS((pb) + 2) { \
            moe_tables(F, layer); \
            pg8::MoeOrder S{cntL, tstL, (int)blockIdx.x, F.G, (const bf16*)(ws + WS_WD) + (size_t)(layer) * NEXP * D * FF, (size_t)D * FF, FF, LIST, false}; \
            pg8::EpiMoeDown E{CONTRIB, LIST, SELW, cntL}; \
            pg8::gemm_phase<pg8::EpiMoeDown, pg8::MoeOrder, true>(F.lds, ACT, FF, S, E); \
            SEAM((pb) + 2); \
        } } while (0)
    MOE_PHASES(0, 4);
    if (RUN(7)) {
        for (int m = gw; m < T; m += NGW) norm_row(F.lane, Xf + (size_t)m * D, CONTRIB + (size_t)m * D, CONTRIB + (size_t)(T + m) * D, args.in[9] + D, Xf + (size_t)m * D, Hb + (size_t)m * D, nullptr);
        SEAM(7);
    }
    if (RUN(8)) REPS(8) {
        pg8::DenseOrder S; S.init(T, ODD_IN, D, (const bf16*)(ws + WS_WIN1), F.G, (int)blockIdx.x);
        pg8::EpiOddIn E{ACT, ACT + (size_t)T * D};
        pg8::gemm_phase<pg8::EpiOddIn, pg8::DenseOrder, true>(F.lds, Hb, D, S, E);
        SEAM(8);
    }
    if (RUN(9)) REPS(9) { conv_phase(F, args); SEAM(9); }
    if (RUN(10)) {
        pg8::DenseOrder S; S.init(T, D, D, (const bf16*)(ws + WS_WOUT1), F.G, (int)blockIdx.x);
        pg8::EpiResF32 E{Xf, Xf};
        pg8::gemm_phase<pg8::EpiResF32, pg8::DenseOrder, false>(F.lds, MIXb, D, S, E);
        SEAM(10);
    }
    MOE_PHASES(1, 11);
#undef MOE_PHASES
    if (RUN(14)) REPS(14) {
        for (int m = gw; m < T; m += NGW) norm_row(F.lane, Xf + (size_t)m * D, CONTRIB + (size_t)m * D, CONTRIB + (size_t)(T + m) * D, args.in[16], nullptr, nullptr, args.out + (size_t)m * D);
#ifdef TS_A
        { VM_WAIT(); const unsigned ta = __hip_atomic_load(F.ctl + CW_TS + (TS_A), RLX_AGENT), tb = __hip_atomic_load(F.ctl + CW_TS + (TS_B), RLX_AGENT);
#ifndef TS_OFF
#define TS_OFF 0
#endif
          const float sc = 1.0f + (float)(((tb - ta) + (TS_OFF) * 100u) / 1000u) * 0.01f;
          for (int m = gw; m < T; m += NGW) { GAS f32x4* o = (GAS f32x4*)(args.out + (size_t)m * D) + F.lane;
#pragma unroll
              for (int j = 0; j < 4; ++j) o[64 * j] = o[64 * j] * sc; } }
#endif
    }
#undef RUN
#undef SEAM
}

#if HYBRID
__global__ void __launch_bounds__(256) k_rmsnorm(const float* __restrict__ x, const float* __restrict__ gain, float* __restrict__ out, int rows) {
    const int wave = (blockIdx.x * blockDim.x + threadIdx.x) >> 6, lane = threadIdx.x & 63;
    if (wave >= rows) return;
    const float* xr = x + (size_t)wave * D;
    float v[16]; float s = 0.f;
#pragma unroll
    for (int j = 0; j < 16; ++j) { v[j] = xr[lane + 64 * j]; s += v[j] * v[j]; }
    s = wave_sum(s);
    const float r = rsqrtf(s * (1.0f / D) + EPS);
#pragma unroll
    for (int j = 0; j < 16; ++j) out[(size_t)wave * D + lane + 64 * j] = v[j] * r * gain[lane + 64 * j];
}
__global__ void __launch_bounds__(256) k_sgemm(const float* __restrict__ A, const float* __restrict__ B, float* C, const float* R, int M, int N, int K) {
    __shared__ float As[16][65];
    __shared__ float Bs[16][65];
    const int tx = threadIdx.x & 15, ty = threadIdx.x >> 4;
    const int bm = blockIdx.y * 64, bn = blockIdx.x * 64;
    float acc[4][4] = {};
    for (int k0 = 0; k0 < K; k0 += 16) {
        for (int i = threadIdx.x; i < 64 * 16; i += 256) { const int r = i >> 4, c = i & 15; As[c][r] = A[(size_t)(bm + r) * K + k0 + c]; }
        for (int i = threadIdx.x; i < 16 * 64; i += 256) { const int r = i >> 6, c = i & 63; Bs[r][c] = B[(size_t)(k0 + r) * N + bn + c]; }
        __syncthreads();
#pragma unroll
        for (int k = 0; k < 16; ++k) {
            float a[4], b[4];
#pragma unroll
            for (int i = 0; i < 4; ++i) { a[i] = As[k][ty * 4 + i]; b[i] = Bs[k][tx * 4 + i]; }
#pragma unroll
            for (int i = 0; i < 4; ++i)
#pragma unroll
                for (int j = 0; j < 4; ++j) acc[i][j] += a[i] * b[j];
        }
        __syncthreads();
    }
#pragma unroll
    for (int i = 0; i < 4; ++i)
#pragma unroll
        for (int j = 0; j < 4; ++j) { const size_t o = (size_t)(bm + ty * 4 + i) * N + bn + tx * 4 + j; C[o] = (R ? R[o] : 0.f) + acc[i][j]; }
}
__device__ __forceinline__ float gelu_exact(float v) { return 0.5f * v * (1.0f + erff(v * 0.70710678118654752f)); }
__global__ void __launch_bounds__(256) k_even_post(float* P, const float* __restrict__ vgain) {
    const int w = (blockIdx.x * blockDim.x + threadIdx.x) >> 6, lane = threadIdx.x & 63;
    if (w >= T * NG) return;
    const int tok = w / NG, g = w % NG;
    float* pu = P + (size_t)tok * EVEN_IN + g * GD + lane;
    float* pv = P + (size_t)tok * EVEN_IN + GW + g * GD + lane;
    *pu = gelu_exact(*pu);
    const float v = gelu_exact(*pv);
    const float s = wave_sum(v * v);
    *pv = v * rsqrtf(s * (1.0f / GD) + EPS) * vgain[g * GD + lane];
}
__global__ void __launch_bounds__(256) k_gmlp(const float* __restrict__ P, const float* __restrict__ ws_, const float* __restrict__ bs_, float* __restrict__ mixcat) {
    __shared__ float vs[CHUNK][GD];
    const int g = blockIdx.x % NG, n = (blockIdx.x / NG) % (SEQ / CHUNK), b = blockIdx.x / (NG * (SEQ / CHUNK));
    const int tok0 = b * SEQ + n * CHUNK;
    for (int i = threadIdx.x; i < CHUNK * GD; i += 256) { const int s = i >> 6, d = i & 63; vs[s][d] = P[(size_t)(tok0 + s) * EVEN_IN + GW + g * GD + d]; }
    __syncthreads();
    const int d = threadIdx.x & 63;
    for (int t = threadIdx.x >> 6; t < CHUNK; t += 4) {
        float acc = 0.f;
        const float* wr = ws_ + ((size_t)g * CHUNK + t) * CHUNK;
        for (int s = 0; s <= t; ++s) acc += wr[s] * vs[s][d];
        acc += bs_[g * CHUNK + t];
        const float u = P[(size_t)(tok0 + t) * EVEN_IN + g * GD + d];
        mixcat[(size_t)(tok0 + t) * D + g * GD + d] = u * acc;
    }
}
__device__ __forceinline__ float log_sigmoid(float z) { return fminf(z, 0.f) - log1pf(expf(-fabsf(z))); }
__global__ void __launch_bounds__(256) k_sbattn(const float* __restrict__ P, float* __restrict__ mixcat) {
    const int w = (blockIdx.x * blockDim.x + threadIdx.x) >> 6, lane = threadIdx.x & 63;
    if (w >= T * NH) return;
    const int h = w % NH, tok = w / NH, b = tok / SEQ, t = tok % SEQ;
    const float q = P[(size_t)tok * EVEN_IN + 2 * GW + h * HD + lane];
    float acc = 0.f, suffix = 0.f;
    for (int s = t - 1; s >= 0; --s) {
        const size_t row = (size_t)(b * SEQ + s) * EVEN_IN;
        const float kk = P[row + 2 * GW + SBW + h * HD + lane];
        const float vv = P[row + 2 * GW + 2 * SBW + h * HD + lane];
        const float z = wave_sum(q * kk) * 0.125f;
        const float a = expf(log_sigmoid(z) + suffix);
        acc += a * vv;
        suffix += log_sigmoid(-z);
    }
    mixcat[(size_t)tok * D + GW + h * HD + lane] = acc;
}
__global__ void __launch_bounds__(256) k_conv(const float* __restrict__ P, const float* __restrict__ cw, float* __restrict__ mixin) {
    const size_t i = (size_t)blockIdx.x * blockDim.x + threadIdx.x;
    if (i >= (size_t)T * D) return;
    const int c = (int)(i % D), tok = (int)(i / D), t = tok % SEQ;
    float acc = 0.f;
#pragma unroll
    for (int k = 0; k < 3; ++k) { const int tt = t + k - 2;
        if (tt >= 0) { const size_t row = (size_t)(tok + k - 2) * ODD_IN; acc += cw[k * D + c] * (P[row + D + c] * P[row + 2 * D + c]); } }
    mixin[i] = P[(size_t)tok * ODD_IN + c] * acc;
}
__global__ void __launch_bounds__(256) k_route(const float* __restrict__ x, const float* __restrict__ gain, const float* __restrict__ wrg, const float* __restrict__ wre,
                                               float* __restrict__ h2, int* __restrict__ sel_e, float* __restrict__ sel_w) {
    const int w = (blockIdx.x * blockDim.x + threadIdx.x) >> 6, lane = threadIdx.x & 63;
    if (w >= T) return;
    const float* xr = x + (size_t)w * D;
    float v[16]; float s = 0.f;
#pragma unroll
    for (int j = 0; j < 16; ++j) { v[j] = xr[lane + 64 * j]; s += v[j] * v[j]; }
    s = wave_sum(s);
    const float r = rsqrtf(s * (1.0f / D) + EPS);
#pragma unroll
    for (int j = 0; j < 16; ++j) { v[j] = v[j] * r * gain[lane + 64 * j]; h2[(size_t)w * D + lane + 64 * j] = v[j]; }
    float gl[NGRP];
#pragma unroll
    for (int g = 0; g < NGRP; ++g) { float a = 0.f;
#pragma unroll
        for (int j = 0; j < 16; ++j) a += v[j] * wrg[(size_t)(lane + 64 * j) * NGRP + g];
        gl[g] = wave_sum(a); }
    int tg = 0; float mx = gl[0];
#pragma unroll
    for (int g = 1; g < NGRP; ++g) if (gl[g] > mx) { mx = gl[g]; tg = g; }
    float den = 0.f;
#pragma unroll
    for (int g = 0; g < NGRP; ++g) den += expf(gl[g] - mx);
    const float top_gp = 1.0f / den;
    float el[EPG];
#pragma unroll
    for (int e = 0; e < EPG; ++e) { float a = 0.f;
#pragma unroll
        for (int j = 0; j < 16; ++j) a += v[j] * wre[((size_t)tg * D + lane + 64 * j) * EPG + e];
        el[e] = wave_sum(a); }
    int e0 = 0; float l0 = el[0];
#pragma unroll
    for (int e = 1; e < EPG; ++e) if (el[e] > l0) { l0 = el[e]; e0 = e; }
    int e1 = -1; float l1 = -INFINITY;
#pragma unroll
    for (int e = 0; e < EPG; ++e) if (e != e0 && el[e] > l1) { l1 = el[e]; e1 = e; }
    const float p1 = expf(l1 - l0), inv = 1.0f / (1.0f + p1);
    if (lane == 0) { sel_e[w * 2 + 0] = tg * EPG + e0; sel_e[w * 2 + 1] = tg * EPG + e1; sel_w[w * 2 + 0] = top_gp * inv; sel_w[w * 2 + 1] = top_gp * p1 * inv; }
}
__global__ void __launch_bounds__(256) k_moe_up(const float* __restrict__ h2, const int* __restrict__ sel_e, const float* __restrict__ wg, const float* __restrict__ wu, float* __restrict__ hmid) {
    __shared__ float hs[D];
    const int row = blockIdx.x, tok = row >> 1;
    const int e = sel_e[row];
    for (int i = threadIdx.x; i < D; i += 256) hs[i] = h2[(size_t)tok * D + i];
    __syncthreads();
    const float* g = wg + (size_t)e * D * FF; const float* u = wu + (size_t)e * D * FF;
    float ag0 = 0.f, ag1 = 0.f, au0 = 0.f, au1 = 0.f;
    const int f = threadIdx.x;
    for (int k = 0; k < D; ++k) { const float hv = hs[k];
        ag0 += hv * g[(size_t)k * FF + f]; ag1 += hv * g[(size_t)k * FF + f + 256];
        au0 += hv * u[(size_t)k * FF + f]; au1 += hv * u[(size_t)k * FF + f + 256]; }
    hmid[(size_t)row * FF + f] = ag0 / (1.0f + expf(-ag0)) * au0;
    hmid[(size_t)row * FF + f + 256] = ag1 / (1.0f + expf(-ag1)) * au1;
}
__global__ void __launch_bounds__(256) k_moe_down(const float* __restrict__ hmid, const int* __restrict__ sel_e, const float* __restrict__ sel_w, const float* __restrict__ wd, float* x) {
    __shared__ float hs[2][FF];
    const int tok = blockIdx.x;
    for (int i = threadIdx.x; i < 2 * FF; i += 256) hs[i / FF][i % FF] = hmid[(size_t)tok * 2 * FF + i];
    __syncthreads();
    float acc[4] = {0.f, 0.f, 0.f, 0.f};
    for (int sl = 0; sl < 2; ++sl) {
        const int e = sel_e[tok * 2 + sl]; const float w = sel_w[tok * 2 + sl];
        const float* dmat = wd + (size_t)e * FF * D;
        float a[4] = {0.f, 0.f, 0.f, 0.f};
        for (int f = 0; f < FF; ++f) { const float hv = hs[sl][f];
#pragma unroll
            for (int j = 0; j < 4; ++j) a[j] += hv * dmat[(size_t)f * D + threadIdx.x + 256 * j]; }
#pragma unroll
        for (int j = 0; j < 4; ++j) acc[j] += w * a[j];
    }
#pragma unroll
    for (int j = 0; j < 4; ++j) x[(size_t)tok * D + threadIdx.x + 256 * j] += acc[j];
}
#endif

extern "C" void kernel_launch(void* const* d_in, const int* in_sizes, int n_in, void* d_out, int out_size, void* d_ws, size_t ws_size, hipStream_t stream) {
    static int grid = 0;
    if (grid == 0) {
        if (n_in != 17 || in_sizes[0] != T * D || out_size != T * D || ws_size < WS_END) { fprintf(stderr, "kernel_launch: unexpected shapes / workspace (%d inputs, ws %zu)\n", n_in, ws_size); grid = -1; return; }
        int dev = 0, cus = 0, per_cu = 0;
        if (hipGetDevice(&dev) != hipSuccess || hipDeviceGetAttribute(&cus, hipDeviceAttributeMultiprocessorCount, dev) != hipSuccess) { grid = -1; return; }
        if (hipFuncSetAttribute((const void*)mk_fwd, hipFuncAttributeMaxDynamicSharedMemorySize, LDS_BYTES) != hipSuccess) { fprintf(stderr, "kernel_launch: hipFuncSetAttribute failed\n"); grid = -1; return; }
        if (hipOccupancyMaxActiveBlocksPerMultiprocessor(&per_cu, (const void*)mk_fwd, NWAVES * 64, LDS_BYTES) != hipSuccess || per_cu < 1) { fprintf(stderr, "kernel_launch: occupancy query reports %d workgroups per CU\n", per_cu); }
        (void)hipGetLastError();
        grid = cus;
    }
    if (grid < 0) return;
    Args a{};
    for (int i = 0; i < 17; ++i) a.in[i] = (const float*)d_in[i];
    a.out = (float*)d_out; a.ws = (unsigned char*)d_ws;
#if !HYBRID
    hipMemsetAsync((char*)d_ws + WS_CTL, 0, CTL_ZERO_BYTES, stream);
    a.mask = (1u << NPHASE) - 1u; a.single = 1;
    hipLaunchKernelGGL(mk_fwd, dim3(grid), dim3(NWAVES * 64), LDS_BYTES, stream, a);
#else
    char* ws = (char*)d_ws;
    float* X = (float*)(ws + WS_X);
    float* sH = (float*)(ws + 0 * MiB); float* sP = (float*)(ws + 64 * MiB); float* sMC = (float*)(ws + 256 * MiB);
    int* sSE = (int*)(ws + 320 * MiB); float* sSW = (float*)(ws + 321 * MiB); float* sHM = (float*)(ws + 420 * MiB);
    const float** in = (const float**)a.in;
    auto fast = [&](unsigned mask) {
        for (int k = 0; k < NPHASE; ++k) if ((mask >> k) & 1u) { a.mask = 1u << k; a.single = 0; hipLaunchKernelGGL(mk_fwd, dim3(grid), dim3(NWAVES * 64), LDS_BYTES, stream, a); } };
    auto fast_prep = [&]() { hipMemsetAsync(ws + WS_CTL, 0, CTL_ZERO_BYTES, stream); fast(1u << 0); };
    auto slow_mixer = [&](int l) {
        const float* xin = (l == 0) ? in[0] : X;
        k_rmsnorm<<<T / 4, 256, 0, stream>>>(xin, in[9] + l * D, sH, T);
        if (l == 0) {
            k_sgemm<<<dim3(EVEN_IN / 64, T / 64), 256, 0, stream>>>(sH, in[1], sP, nullptr, T, EVEN_IN, D);
            k_even_post<<<T * NG / 4, 256, 0, stream>>>(sP, in[5]);
            k_gmlp<<<BATCH * (SEQ / CHUNK) * NG, 256, 0, stream>>>(sP, in[3], in[4], sMC);
            k_sbattn<<<T * NH / 4, 256, 0, stream>>>(sP, sMC);
            k_sgemm<<<dim3(D / 64, T / 64), 256, 0, stream>>>(sMC, in[2], X, xin, T, D, D);
        } else {
            k_sgemm<<<dim3(ODD_IN / 64, T / 64), 256, 0, stream>>>(sH, in[6], sP, nullptr, T, ODD_IN, D);
            k_conv<<<T * D / 256, 256, 0, stream>>>(sP, in[7], sMC);
            k_sgemm<<<dim3(D / 64, T / 64), 256, 0, stream>>>(sMC, in[8], X, xin, T, D, D);
        } };
    auto slow_moe = [&](int l) {
        k_route<<<T / 4, 256, 0, stream>>>(X, in[10] + l * D, in[11] + (size_t)l * D * NGRP, in[12] + (size_t)l * NGRP * D * EPG, sH, sSE, sSW);
        k_moe_up<<<T * 2, 256, 0, stream>>>(sH, sSE, in[13] + (size_t)l * NEXP * D * FF, in[14] + (size_t)l * NEXP * D * FF, sHM);
        k_moe_down<<<T, 256, 0, stream>>>(sHM, sSE, sSW, in[15] + (size_t)l * NEXP * FF * D, X);
        hipMemsetAsync(ws + WS_CONTRIB, 0, (size_t)2 * T * D * 2, stream); };
    const unsigned hy = HYBRID;
    if (hy & 1u) slow_mixer(0); else { fast_prep(); fast(0xEu); }
    if (hy & 2u) slow_moe(0); else { if (hy & 1u) fast_prep(); fast(0x70u); }
    if (hy & 4u) { if (!(hy & 2u)) fast(1u << 7); slow_mixer(1); }
    else { if (hy & 2u) fast_prep(); fast(0x780u); }
    if (hy & 8u) slow_moe(1); else { if (hy & 4u) fast_prep(); fast(0x3800u); }
    fast(1u << 14);
#endif
}
```

```cpp
#include <hip/hip_runtime.h>
#include <cstdio>
#include <cstdint>
#include <cmath>

#ifndef HYBRID
#define HYBRID 0
#endif

#define GAS __attribute__((address_space(1)))
#define LAS __attribute__((address_space(3)))
typedef unsigned short bf16;
typedef unsigned v4u __attribute__((ext_vector_type(4)));
typedef unsigned v2u __attribute__((ext_vector_type(2)));
typedef float f32x4 __attribute__((ext_vector_type(4)));
typedef float f32x2 __attribute__((ext_vector_type(2)));
typedef float f32x16 __attribute__((ext_vector_type(16)));
typedef short bf16x8 __attribute__((ext_vector_type(8)));
typedef GAS unsigned gu32;

constexpr int D = 1024, BATCH = 8, SEQ = 2048, T = BATCH * SEQ;
constexpr int NG = 8, GD = 64, GW = 512, CHUNK = 128;
constexpr int NH = 8, HD = 64, SBW = 512;
constexpr int EVEN_IN = 2560, ODD_IN = 3072;
constexpr int NGRP = 4, EPG = 8, NEXP = 32, FF = 512;
constexpr float EPS = 1e-6f;
constexpr int NWAVES = 8;
constexpr int LIST_CAP = T;
constexpr int MAX_MT = 2 * T / 256 + NEXP;

constexpr size_t MiB = 1u << 20;
constexpr size_t WS_CTL = 0, CTL_ZERO_BYTES = 1 * MiB;
constexpr size_t WS_WTRIL = 1 * MiB;
constexpr size_t WS_WR = 1 * MiB + 256 * 1024;
constexpr size_t WS_LIST = 2 * MiB;
constexpr size_t WS_SELW = 4 * MiB;
constexpr size_t WS_WIN0 = 5 * MiB, WS_WOUT0 = 10 * MiB, WS_WIN1 = 12 * MiB, WS_WOUT1 = 18 * MiB;
constexpr size_t WS_WGU = 20 * MiB;
constexpr size_t WS_WD = 148 * MiB;
constexpr size_t WS_H = 212 * MiB;
constexpr size_t WS_ACT = 244 * MiB;
constexpr size_t WS_MIX = 324 * MiB;
constexpr size_t WS_X = 356 * MiB;
constexpr size_t WS_CONTRIB = 420 * MiB;
constexpr size_t WS_END = 484 * MiB;
constexpr int CW_CNT = 64;
constexpr int CW_TS = 12288;
constexpr int CW_BAR = 16384;

constexpr int RING_BYTES = 131072;
constexpr int LDSCTL_OFF = RING_BYTES, MISC_OFF = LDSCTL_OFF + 320;
constexpr int LDS_BYTES = 147456;

#define RLX_AGENT __ATOMIC_RELAXED, __HIP_MEMORY_SCOPE_AGENT
#define LDS_WAIT() asm volatile("s_waitcnt lgkmcnt(0)" ::: "memory")
#define VM_WAIT() asm volatile("s_waitcnt vmcnt(0)" ::: "memory")
__device__ __forceinline__ unsigned f2bf(float f) { unsigned u = __builtin_bit_cast(unsigned, f); return (u + 0x7fffu + ((u >> 16) & 1u)) >> 16; }
__device__ __forceinline__ unsigned pk2(float lo, float hi) { return f2bf(lo) | (f2bf(hi) << 16); }
__device__ __forceinline__ float bf_lo(unsigned w) { return __builtin_bit_cast(float, w << 16); }
__device__ __forceinline__ float bf_hi(unsigned w) { return __builtin_bit_cast(float, w & 0xffff0000u); }
__device__ __forceinline__ unsigned cvt_pk_bf16(float lo, float hi) { unsigned r; asm volatile("v_cvt_pk_bf16_f32 %0, %1, %2" : "=v"(r) : "v"(lo), "v"(hi)); return r; }
__device__ __forceinline__ float wave_sum(float v) {
#pragma unroll
    for (int o = 1; o < 64; o <<= 1) v += __shfl_xor(v, o);
    return v;
}

#define XB_TMO      128
#define XB_XCNT(j)  (256  + 64 * (j))
#define XB_XSUB(j)  (1280 + 64 * (j))
#define XB_XGEN(j)  (2304 + 64 * (j))
#define XB_TOP      3328
#define XB_TOPGEN   3392
#define XCD_BAR_WORDS 3456
#define XB_SPIN_CAP (1u << 18)
__device__ __forceinline__ unsigned xb_ld(unsigned* p)              { return __hip_atomic_load(p, __ATOMIC_RELAXED, __HIP_MEMORY_SCOPE_AGENT); }
__device__ __forceinline__ unsigned xb_add(unsigned* p, unsigned v) { return __hip_atomic_fetch_add(p, v, __ATOMIC_RELAXED, __HIP_MEMORY_SCOPE_AGENT); }
__device__ __forceinline__ unsigned xb_xcc_id() { return (unsigned)__builtin_amdgcn_s_getreg((3 << 11) | 20) & 0xFu; }
#define XB_SPIN(cond, bar) do { unsigned _sp = 0; while (cond) { __builtin_amdgcn_s_sleep(1); \
    if ((++_sp & 255u) == 0u) { if (xb_ld(&(bar)[XB_TMO])) break; if (_sp > XB_SPIN_CAP) { atomicAdd(&(bar)[XB_TMO], 1u); break; } } } } while (0)
struct XcdBarrier { unsigned* bar; unsigned x; volatile LAS unsigned* st; };
__device__ __forceinline__ XcdBarrier xcd_barrier_post(unsigned* bar, volatile LAS unsigned* st) {
    XcdBarrier b; b.bar = bar; b.x = xb_xcc_id(); b.st = st;
    if (threadIdx.x == 0) (void)xb_add(&bar[XB_XCNT(b.x)], 1u);
    return b;
}
__device__ __forceinline__ void xcd_barrier_complete(unsigned* bar, unsigned x, unsigned& nloc, unsigned& nx) {
    const unsigned G = gridDim.x * gridDim.y * gridDim.z;
    unsigned sum, cnt, mine, sp = 0u;
    for (;;) {
        sum = 0u; cnt = 0u; mine = 0u;
#pragma unroll
        for (unsigned j = 0; j < 16; ++j) { const unsigned c = xb_ld(&bar[XB_XCNT(j)]); sum += c; cnt += (c > 0u) ? 1u : 0u; mine = (j == x) ? c : mine; }
        if (sum == G) break;
        __builtin_amdgcn_s_sleep(1);
        if ((++sp & 255u) == 0u) { if (xb_ld(&bar[XB_TMO])) break; if (sp > XB_SPIN_CAP) { atomicAdd(&bar[XB_TMO], 1u); break; } }
    }
    nloc = mine > 0u ? mine : 1u; nx = cnt > 0u ? cnt : 1u;
}
__device__ __forceinline__ void xcd_barrier(const XcdBarrier& b) {
    asm volatile("s_waitcnt vmcnt(0)" ::: "memory");
    __syncthreads();
    if (threadIdx.x == 0) {
        unsigned* bar = b.bar;
        __builtin_amdgcn_s_waitcnt(0);
        unsigned nloc = b.st[0], nx = b.st[1];
        if (nloc == 0u) { xcd_barrier_complete(bar, b.x, nloc, nx); b.st[0] = nloc; b.st[1] = nx; }
        const unsigned old = xb_add(&bar[XB_XSUB(b.x)], 1u);
        const unsigned gen = old / nloc;
        if (old + 1u == (gen + 1u) * nloc) {
            __builtin_amdgcn_fence(__ATOMIC_RELEASE, "agent");
            asm volatile("s_waitcnt vmcnt(0)" ::: "memory");
            const unsigned og = xb_add(&bar[XB_TOP], 1u);
            const unsigned tg = og / nx;
            if (og + 1u == (tg + 1u) * nx) xb_add(&bar[XB_TOPGEN], 1u);
            else XB_SPIN(xb_ld(&bar[XB_TOPGEN]) == tg, bar);
            __builtin_amdgcn_fence(__ATOMIC_ACQUIRE, "agent");
            xb_add(&bar[XB_XGEN(b.x)], 1u);
            asm volatile("s_waitcnt vmcnt(0)" ::: "memory");
        } else {
            XB_SPIN(xb_ld(&bar[XB_XGEN(b.x)]) == gen, bar);
            __builtin_amdgcn_fence(__ATOMIC_ACQUIRE, "agent");
            asm volatile("s_waitcnt vmcnt(0)" ::: "memory");
        }
    }
    __syncthreads();
}

namespace pg8 {
constexpr int BM = 256, BK = 64, HALF = 128, HTB = HALF * BK * 2, STAGE_BYTES = 8 * HTB, NXCD = 8, WGM = 8;
__host__ __device__ __forceinline__ int lds_byte(int r, int c) { const int st = (r >> 4) * 2 + (c >> 5), rr = r & 15, cc = c & 31, ob = rr * 64 + cc * 2; return st * 1024 + (ob ^ (((ob >> 9) & 1) << 5)); }
__host__ __device__ __forceinline__ void stage_rc(int b, int& R, int& C) { const int st = b / 1024, sb = b % 1024, swz = sb ^ (((sb >> 9) & 1) << 5); R = (st >> 1) * 16 + swz / 64; C = (st & 1) * 32 + (swz % 64) / 2; }
__host__ __device__ __forceinline__ int perm32(int rho) { const int n = rho >> 4, i = rho & 15; return 8 * (i >> 2) + 4 * n + (i & 3); }

struct Unit { int pm, pn, e, mt, sh; };

struct DenseOrder {
    static constexpr bool HAS_SHORT = false;
    int nM, nN, nwg, G, c; const bf16* Bt; int K;
    __device__ void init(int M, int N, int K_, const bf16* Bt_, int G_, int c_) { nM = M / BM; nN = N / BM; nwg = nM * nN; G = G_; c = c_; Bt = Bt_; K = K_; }
    __device__ bool next(int i, Unit& u) const {
        const long L = (long)i * G + c; if (L >= nwg) return false;
        int wgid = (int)L; { const int q = nwg / NXCD, r = nwg % NXCD, xcd = wgid % NXCD, off = wgid / NXCD; wgid = (xcd < r ? xcd * (q + 1) : r * (q + 1) + (xcd - r) * q) + off; }
        const int nig = WGM * nN, gid = wgid / nig, fm = gid * WGM, gsz = (nM - fm) < WGM ? (nM - fm) : WGM;
        u.pm = fm + ((wgid % nig) % gsz); u.pn = (wgid % nig) / gsz; u.e = 0; u.mt = 0; u.sh = 0; return true;
    }
    __device__ __forceinline__ int a_row(const Unit& u, int r) const { return u.pm * BM + r; }
    __device__ __forceinline__ const char* b_base(const Unit& u) const { return (const char*)Bt + (size_t)u.pn * BM * K * 2; }
};

struct MoeOrder {
    const LAS int* cnt; const LAS int* tstart; int c, G; const bf16* W; size_t wstride; int K; const unsigned* list; bool gather;
    static constexpr bool HAS_SHORT = true;
    __device__ bool next(int i, Unit& u) const {
        const int x = c & 7, j = c >> 3, per = (G - x + 7) >> 3;
        int L = i * per + j;
        int tl = L >> 2; const int pn = L & 3;
#pragma unroll
        for (int k = 0; k < 4; ++k) {
            const int e = x + 8 * k; const int nt = tstart[e + 1] - tstart[e]; const int shrt = (nt > 0 && cnt[e] - (nt - 1) * BM <= HALF) ? 1 : 0; const int nf = nt - shrt;
            if (tl < nf) { u.e = e; u.mt = tl; u.pm = tstart[e] + tl; u.pn = pn; u.sh = 0; return true; }
            tl -= nf;
        }
#pragma unroll
        for (int k = 0; k < 4; ++k) {
            const int e = x + 8 * k; const int nt = tstart[e + 1] - tstart[e]; const int shrt = (nt > 0 && cnt[e] - (nt - 1) * BM <= HALF) ? 1 : 0;
            if (shrt) { if (tl == 0) { u.e = e; u.mt = nt - 1; u.pm = tstart[e] + nt - 1; u.pn = pn; u.sh = 1; return true; } --tl; }
        }
        return false;
    }
    __device__ __forceinline__ int a_row(const Unit& u, int r) const {
        if (!gather) return u.pm * BM + r;
        const int idx = u.mt * BM + r;
        return idx < cnt[u.e] ? (int)(list[(size_t)u.e * LIST_CAP + idx] >> 1) : 0;
    }
    __device__ __forceinline__ const char* b_base(const Unit& u) const { return (const char*)W + ((size_t)u.e * wstride + (size_t)u.pn * BM * K) * 2; }
};

__device__ __forceinline__ f32x2 gelu_pk(f32x2 v) {
    const f32x2 av = __builtin_elementwise_abs(v), d = av * 0.2316418882f + 1.0f;
    f32x2 t; t.x = __builtin_amdgcn_rcpf(d.x); t.y = __builtin_amdgcn_rcpf(d.y);
    f32x2 q = t * 0.5307027145f + (-0.7265760135f); q = q * t + 0.7107068705f; q = q * t + (-0.142248368f); q = q * t + 0.127414796f; q = q * t;
    const f32x2 s = (v * v) * (-0.72134752044f);
    f32x2 e; e.x = __builtin_amdgcn_exp2f(s.x); e.y = __builtin_amdgcn_exp2f(s.y);
    const f32x2 m = v * (q * e), r = v - m;
    f32x2 o; o.x = v.x < 0.f ? m.x : r.x; o.y = v.y < 0.f ? m.y : r.y; return o;
}

typedef f32x4 Acc[2][2][4][2];

template <class Epi, class Sched, bool ALIGN_EPI>
__device__ __forceinline__ void gemm_phase(LAS unsigned char* lds, const bf16* A, const int K, const Sched& S, const Epi& E) {
    const int tid = threadIdx.x, wid = __builtin_amdgcn_readfirstlane(tid >> 6), lane = tid & 63, wr = wid >> 2, wc = wid & 3, fr = lane & 15, fq = lane >> 4;
    const int nt = K / BK;
    int Rr[2], Cc[2]; unsigned voffB[2];
#pragma unroll
    for (int i = 0; i < 2; ++i) { int R, C; stage_rc(tid * 16 + i * 8192, R, C); const int Rb = Epi::PERM ? ((R & ~31) + perm32(R & 31)) : R;
        Rr[i] = R; Cc[i] = C; voffB[i] = (unsigned)(Rb * K + C) * 2u; }
    const size_t kstep = (size_t)(BK * 2);
    const size_t hstep = (size_t)HALF * K * 2;
    const unsigned ldsw = (unsigned)wid * 1024u;
    const int aoff = lds_byte(wr * 64 + fr, fq * 8), boff = lds_byte(wc * 32 + fr, fq * 8);
#define PG8_SA(b, h) (((b) * 2 + (h)) * HTB)
#define PG8_SB(b, h) ((4 + (b) * 2 + (h)) * HTB)
#define PG8_STAGE(bufoff, gbase, voff) do { _Pragma("unroll") for (int _i = 0; _i < 2; ++_i) \
        __builtin_amdgcn_global_load_lds((const unsigned*)((const char*)(gbase) + (voff)[_i]), (LAS unsigned*)(lds + (bufoff) + ldsw + _i * 8192), 16, 0, 0); } while (0)
#define PG8_LDA(dst, b, h) do { _Pragma("unroll") for (int m = 0; m < 4; ++m) _Pragma("unroll") for (int k = 0; k < 2; ++k) dst[m][k] = *(const LAS bf16x8*)(lds + PG8_SA(b, h) + aoff + m * 2048 + k * 1024); } while (0)
#define PG8_LDB(dst, b, h) do { _Pragma("unroll") for (int n = 0; n < 2; ++n) _Pragma("unroll") for (int k = 0; k < 2; ++k) dst[n][k] = *(const LAS bf16x8*)(lds + PG8_SB(b, h) + boff + n * 2048 + k * 1024); } while (0)
#define PG8_MMA(ai, bj, At, Bt) do { __builtin_amdgcn_s_setprio(1); _Pragma("unroll") for (int m = 0; m < 4; ++m) _Pragma("unroll") for (int n = 0; n < 2; ++n) _Pragma("unroll") for (int k = 0; k < 2; ++k) \
        acc[ai][bj][m][n] = __builtin_amdgcn_mfma_f32_16x16x32_bf16(Bt[n][k], At[m][k], acc[ai][bj][m][n], 0, 0, 0); __builtin_amdgcn_s_setprio(0); } while (0)
#define PG8_WAIT_V(n) asm volatile("s_waitcnt vmcnt(" #n ")" ::: "memory")
#define PG8_WAIT_L(n) asm volatile("s_waitcnt lgkmcnt(" #n ")" ::: "memory")
#define PG8_BAR __builtin_amdgcn_s_barrier()
#define PG8_SCHED __builtin_amdgcn_sched_barrier(0)
#define PG8_VOFF(dst, u) do { _Pragma("unroll") for (int _h = 0; _h < 2; ++_h) _Pragma("unroll") for (int _i = 0; _i < 2; ++_i) \
        dst[_h][_i] = (unsigned)(S.a_row(u, _h * HALF + Rr[_i]) * K + Cc[_i]) * 2u; \
        asm volatile("" : "+v"(dst[0][0]), "+v"(dst[0][1]), "+v"(dst[1][0]), "+v"(dst[1][1])); } while (0)
    Unit cur, nxt; int ui = 0;
    if (!S.next(0, cur)) return;
    Acc acc;
#pragma unroll
    for (int a = 0; a < 2; ++a)
#pragma unroll
        for (int b = 0; b < 2; ++b)
#pragma unroll
            for (int m = 0; m < 4; ++m)
#pragma unroll
                for (int n = 0; n < 2; ++n) acc[a][b][m][n] = (f32x4){0.f, 0.f, 0.f, 0.f};
    bf16x8 At[4][2], B0[2][2], B1[2][2];
    unsigned vc[2][2], vn[2][2];
    PG8_VOFF(vc, cur);
    const char* const cA = (const char*)A;
    const char* cB = S.b_base(cur);
    PG8_STAGE(PG8_SB(0, 0), cB, voffB); PG8_STAGE(PG8_SB(0, 1), cB + hstep, voffB); PG8_STAGE(PG8_SA(0, 0), cA, vc[0]); PG8_STAGE(PG8_SA(0, 1), cA, vc[1]);
    if (wr == 1) PG8_BAR;
    PG8_WAIT_V(2); PG8_BAR;
    PG8_STAGE(PG8_SB(1, 0), cB + kstep, voffB); PG8_STAGE(PG8_SA(1, 0), cA + kstep, vc[0]); PG8_STAGE(PG8_SB(1, 1), cB + hstep + kstep, voffB);
    PG8_WAIT_V(6); PG8_BAR;
    for (;;) {
        const bool has_next = S.next(ui + 1, nxt);
        if (has_next) { PG8_VOFF(vn, nxt); } else {
#pragma unroll
            for (int h = 0; h < 2; ++h)
#pragma unroll
                for (int i = 0; i < 2; ++i) vn[h][i] = vc[h][i]; }
        const char* nB = has_next ? S.b_base(nxt) : cB;
        const bool sh = Sched::HAS_SHORT && cur.sh != 0;
        for (int t = 0; t < nt; t += 2) {
            const bool last = (t == nt - 2);
            const char* a1 = cA + (size_t)(t + 1) * kstep;
            const char* a2 = last ? cA : cA + (size_t)(t + 2) * kstep; const char* b2 = last ? nB : cB + (size_t)(t + 2) * kstep;
            const char* a3 = a2 + kstep; const char* b3 = b2 + kstep;
            unsigned v2[2][2];
#pragma unroll
            for (int h = 0; h < 2; ++h)
#pragma unroll
                for (int i = 0; i < 2; ++i) v2[h][i] = last ? vn[h][i] : vc[h][i];
            PG8_LDB(B0, 0, 0); PG8_LDB(B1, 0, 1); PG8_SCHED; PG8_LDA(At, 0, 0); PG8_STAGE(PG8_SA(1, 1), a1, vc[1]);
            PG8_WAIT_V(8); PG8_WAIT_L(0); PG8_BAR; PG8_MMA(0, 0, At, B0); PG8_MMA(0, 1, At, B1); PG8_BAR; PG8_SCHED;
            if (!sh) { PG8_LDA(At, 0, 1); } PG8_STAGE(PG8_SB(0, 0), b2, voffB); PG8_STAGE(PG8_SB(0, 1), b2 + hstep, voffB); PG8_STAGE(PG8_SA(0, 0), a2, v2[0]);
            PG8_WAIT_V(8); PG8_WAIT_L(0); PG8_BAR; if (!sh) { PG8_MMA(1, 0, At, B0); PG8_MMA(1, 1, At, B1); } PG8_BAR; PG8_SCHED;
            PG8_LDB(B0, 1, 0); PG8_LDB(B1, 1, 1); PG8_SCHED; PG8_LDA(At, 1, 0); PG8_STAGE(PG8_SA(0, 1), a2, v2[1]);
            PG8_WAIT_V(8); PG8_WAIT_L(0); PG8_BAR; PG8_MMA(0, 0, At, B0); PG8_MMA(0, 1, At, B1); PG8_BAR; PG8_SCHED;
            if (!sh) { PG8_LDA(At, 1, 1); } PG8_STAGE(PG8_SB(1, 0), b3, voffB); PG8_STAGE(PG8_SB(1, 1), b3 + hstep, voffB); PG8_STAGE(PG8_SA(1, 0), a3, v2[0]);
            PG8_WAIT_V(8); PG8_WAIT_L(0); PG8_BAR; if (!sh) { PG8_MMA(1, 0, At, B0); PG8_MMA(1, 1, At, B1); } PG8_BAR; PG8_SCHED;
        }
        if constexpr (ALIGN_EPI) { if (wr == 0) PG8_BAR; }
        E(acc, cur, wr, wc, fr, fq);
        if (!has_next) break;
#pragma unroll
        for (int a = 0; a < 2; ++a)
#pragma unroll
            for (int b = 0; b < 2; ++b)
#pragma unroll
                for (int m = 0; m < 4; ++m)
#pragma unroll
                    for (int n = 0; n < 2; ++n) acc[a][b][m][n] = (f32x4){0.f, 0.f, 0.f, 0.f};
        cur = nxt; cB = nB; ++ui;
#pragma unroll
        for (int h = 0; h < 2; ++h)
#pragma unroll
            for (int i = 0; i < 2; ++i) vc[h][i] = vn[h][i];
        if constexpr (ALIGN_EPI) { if (wr == 1) PG8_BAR; }
    }
    PG8_WAIT_V(0);
    if constexpr (!ALIGN_EPI) { if (wr == 0) PG8_BAR; }
    PG8_BAR;
#undef PG8_SA
#undef PG8_SB
#undef PG8_STAGE
#undef PG8_LDA
#undef PG8_LDB
#undef PG8_MMA
#undef PG8_WAIT_V
#undef PG8_WAIT_L
#undef PG8_BAR
#undef PG8_SCHED
#undef PG8_VOFF
}

struct EpiEvenIn {
    static constexpr bool PERM = true;
    bf16 *U, *GV, *Q, *Kb, *VT;
    __device__ __forceinline__ void operator()(const Acc& acc, const Unit& u, int wr, int wc, int fr, int fq) const {
        const int sel = u.pn >> 1;
        const int row0 = u.pm * BM + wr * 64 + fr;
        const int colt = (u.pn & 1) * BM + wc * 32 + 8 * fq;
        if (sel < 4) {
            bf16* base = sel == 0 ? U : sel == 1 ? GV : sel == 2 ? Q : Kb;
#pragma unroll
            for (int ai = 0; ai < 2; ++ai)
#pragma unroll
                for (int m = 0; m < 4; ++m) { bf16* rowp = base + (size_t)(row0 + ai * HALF + m * 16) * GW + colt;
#pragma unroll
                    for (int bj = 0; bj < 2; ++bj) { f32x4 v0 = acc[ai][bj][m][0], v1 = acc[ai][bj][m][1];
                        if (sel < 2) { f32x2 a = gelu_pk((f32x2){v0[0], v0[1]}), b = gelu_pk((f32x2){v0[2], v0[3]}), c = gelu_pk((f32x2){v1[0], v1[1]}), d = gelu_pk((f32x2){v1[2], v1[3]});
                            v0 = (f32x4){a.x, a.y, b.x, b.y}; v1 = (f32x4){c.x, c.y, d.x, d.y}; }
                        v4u w; w.x = cvt_pk_bf16(v0[0], v0[1]); w.y = cvt_pk_bf16(v0[2], v0[3]); w.z = cvt_pk_bf16(v1[0], v1[1]); w.w = cvt_pk_bf16(v1[2], v1[3]);
                        *(v4u*)(rowp + bj * HALF) = w; } }
        } else {
#pragma unroll
            for (int ai = 0; ai < 2; ++ai)
#pragma unroll
                for (int m = 0; m < 4; ++m) { const int tok = row0 + ai * HALF + m * 16; const int b = tok / SEQ, t = tok % SEQ;
#pragma unroll
                    for (int bj = 0; bj < 2; ++bj) { const int c0 = colt + bj * HALF;
#pragma unroll
                        for (int n = 0; n < 2; ++n)
#pragma unroll
                            for (int j = 0; j < 4; ++j) { const int c = c0 + 4 * n + j;
                                VT[((size_t)(b * NH) * HD + c) * SEQ + t] = (bf16)f2bf(acc[ai][bj][m][n][j]); } } }
        }
    }
};
struct EpiResF32 {
    static constexpr bool PERM = false;
    const float* R; float* X;
    __device__ __forceinline__ void operator()(const Acc& acc, const Unit& u, int wr, int wc, int fr, int fq) const {
        const int row0 = u.pm * BM + wr * 64 + fr, col0 = u.pn * BM + wc * 32 + 4 * fq;
#pragma unroll
        for (int ai = 0; ai < 2; ++ai)
#pragma unroll
            for (int m = 0; m < 4; ++m) { const size_t off = (size_t)(row0 + ai * HALF + m * 16) * D + col0;
#pragma unroll
                for (int bj = 0; bj < 2; ++bj)
#pragma unroll
                    for (int n = 0; n < 2; ++n) { const f32x4 r = *(const f32x4*)(R + off + bj * HALF + n * 16); *(f32x4*)(X + off + bj * HALF + n * 16) = r + acc[ai][bj][m][n]; } }
    }
};
struct EpiMixBf16 {
    static constexpr bool PERM = true;
    bf16* MO;
    __device__ __forceinline__ void operator()(const Acc& acc, const Unit& u, int wr, int wc, int fr, int fq) const {
        const int row0 = u.pm * BM + wr * 64 + fr, col = u.pn * BM + wc * 32 + 8 * fq;
#pragma unroll
        for (int ai = 0; ai < 2; ++ai)
#pragma unroll
            for (int m = 0; m < 4; ++m)
#pragma unroll
                for (int bj = 0; bj < 2; ++bj) { const f32x4 v0 = acc[ai][bj][m][0], v1 = acc[ai][bj][m][1];
                    v4u w; w.x = cvt_pk_bf16(v0[0], v0[1]); w.y = cvt_pk_bf16(v0[2], v0[3]); w.z = cvt_pk_bf16(v1[0], v1[1]); w.w = cvt_pk_bf16(v1[2], v1[3]);
                    *(v4u*)(MO + (size_t)(row0 + ai * HALF + m * 16) * D + col + bj * HALF) = w; }
    }
};
struct EpiOddIn {
    static constexpr bool PERM = true;
    bf16 *Y, *GB;
    __device__ __forceinline__ void operator()(const Acc& acc, const Unit& u, int wr, int wc, int fr, int fq) const {
        const int row0 = u.pm * BM + wr * 64 + fr;
        if (u.pn < 8) {
            const int col = u.pn * HALF + wc * 32 + 8 * fq;
#pragma unroll
            for (int ai = 0; ai < 2; ++ai)
#pragma unroll
                for (int m = 0; m < 4; ++m) { const f32x4 v0 = acc[ai][0][m][0] * acc[ai][1][m][0], v1 = acc[ai][0][m][1] * acc[ai][1][m][1];
                    v4u w; w.x = cvt_pk_bf16(v0[0], v0[1]); w.y = cvt_pk_bf16(v0[2], v0[3]); w.z = cvt_pk_bf16(v1[0], v1[1]); w.w = cvt_pk_bf16(v1[2], v1[3]);
                    *(v4u*)(Y + (size_t)(row0 + ai * HALF + m * 16) * D + col) = w; }
        } else {
            const int col = (u.pn - 8) * BM + wc * 32 + 8 * fq;
#pragma unroll
            for (int ai = 0; ai < 2; ++ai)
#pragma unroll
                for (int m = 0; m < 4; ++m)
#pragma unroll
                    for (int bj = 0; bj < 2; ++bj) { const f32x4 v0 = acc[ai][bj][m][0], v1 = acc[ai][bj][m][1];
                        v4u w; w.x = cvt_pk_bf16(v0[0], v0[1]); w.y = cvt_pk_bf16(v0[2], v0[3]); w.z = cvt_pk_bf16(v1[0], v1[1]); w.w = cvt_pk_bf16(v1[2], v1[3]);
                        *(v4u*)(GB + (size_t)(row0 + ai * HALF + m * 16) * D + col + bj * HALF) = w; }
        }
    }
};
struct EpiMoeUp {
    static constexpr bool PERM = true;
    bf16* HM;
    __device__ __forceinline__ void operator()(const Acc& acc, const Unit& u, int wr, int wc, int fr, int fq) const {
        const int row0 = u.pm * BM + wr * 64 + fr, col = u.pn * HALF + wc * 32 + 8 * fq;
#pragma unroll
        for (int ai = 0; ai < 2; ++ai)
#pragma unroll
            for (int m = 0; m < 4; ++m) { float o[8];
#pragma unroll
                for (int n = 0; n < 2; ++n)
#pragma unroll
                    for (int j = 0; j < 4; ++j) { const float g = acc[ai][0][m][n][j], up = acc[ai][1][m][n][j];
                        o[4 * n + j] = g * __builtin_amdgcn_rcpf(1.0f + __builtin_amdgcn_exp2f(-1.44269504089f * g)) * up; }
                v4u w; w.x = cvt_pk_bf16(o[0], o[1]); w.y = cvt_pk_bf16(o[2], o[3]); w.z = cvt_pk_bf16(o[4], o[5]); w.w = cvt_pk_bf16(o[6], o[7]);
                *(v4u*)(HM + (size_t)(row0 + ai * HALF + m * 16) * FF + col) = w; }
    }
};
struct EpiMoeDown {
    static constexpr bool PERM = true;
    bf16* CONTRIB; const unsigned* list; const float* selw; const LAS int* cnt;
    __device__ __forceinline__ void operator()(const Acc& acc, const Unit& u, int wr, int wc, int fr, int fq) const {
        const int n_e = cnt[u.e]; const unsigned* le = list + (size_t)u.e * LIST_CAP + u.mt * BM;
        const int col = u.pn * BM + wc * 32 + 8 * fq;
#pragma unroll
        for (int ai = 0; ai < 2; ++ai)
#pragma unroll
            for (int m = 0; m < 4; ++m) { const int r = ai * HALF + wr * 64 + m * 16 + fr;
                if (u.mt * BM + r < n_e) { const unsigned ent = le[r]; const float w = selw[ent];
                    bf16* rowp = CONTRIB + ((size_t)(ent & 1u) * T + (ent >> 1)) * D + col;
#pragma unroll
                    for (int bj = 0; bj < 2; ++bj) { const f32x4 v0 = acc[ai][bj][m][0] * w, v1 = acc[ai][bj][m][1] * w;
                        v4u o; o.x = cvt_pk_bf16(v0[0], v0[1]); o.y = cvt_pk_bf16(v0[2], v0[3]); o.z = cvt_pk_bf16(v1[0], v1[1]); o.w = cvt_pk_bf16(v1[2], v1[3]);
                        *(v4u*)(rowp + bj * HALF) = o; } } }
    }
};
}

struct Frame {
    LAS unsigned char* lds;
    volatile LAS unsigned* MISC;
    gu32* ctl;
    int tid, lane, wave, vcu, G;
};

struct TrDesc { const float* W; bf16* WT; int K, N, k0, n0, orow0; };
__device__ __forceinline__ void tr_load(const TrDesc& d, f32x4 (&v)[16], int lane) {
    const int kk = lane >> 4, nq = (lane & 15) * 4;
#pragma unroll
    for (int i = 0; i < 16; ++i) v[i] = *(const GAS f32x4*)(d.W + (size_t)(d.k0 + 4 * i + kk) * d.N + d.n0 + nq);
}
__device__ __forceinline__ void tr_finish(const TrDesc& d, const f32x4 (&v)[16], LAS float* scr, int lane) {
    const int kk = lane >> 4, nq = (lane & 15) * 4;
    const int c0 = (nq + 0) ^ kk, c1 = (nq + 1) ^ kk, c2 = (nq + 2) ^ kk, c3 = (nq + 3) ^ kk;
#pragma unroll
    for (int i = 0; i < 16; ++i) { const int k = 4 * i + kk, sw = 8 * (i >> 1); LAS float* row = scr + k * 64;
        row[c0 ^ sw] = v[i].x; row[c1 ^ sw] = v[i].y; row[c2 ^ sw] = v[i].z; row[c3 ^ sw] = v[i].w; }
    LDS_WAIT(); asm volatile("" ::: "memory");
    const int c = lane & 7, nl = lane >> 3;
#pragma unroll
    for (int j = 0; j < 8; ++j) { const int n = nl + 8 * j; const LAS float* s = scr + (8 * c) * 64; const int q0 = n ^ (8 * c), q1 = q0 ^ 1, q2 = q0 ^ 2, q3 = q0 ^ 3;
        v4u o; o.x = pk2(s[0 * 64 + q0], s[1 * 64 + q1]); o.y = pk2(s[2 * 64 + q2], s[3 * 64 + q3]); o.z = pk2(s[4 * 64 + q0], s[5 * 64 + q1]); o.w = pk2(s[6 * 64 + q2], s[7 * 64 + q3]);
        *(GAS v4u*)(d.WT + (size_t)(d.orow0 + n) * d.K + d.k0 + 8 * c) = o; }
    LDS_WAIT(); asm volatile("" ::: "memory");
}
__device__ __forceinline__ void tr_item64(const float* W, int K, int N, bf16* WT, int k0, int n0, int orow0, LAS float* scr, int lane) {
    const TrDesc d{W, WT, K, N, k0, n0, orow0}; f32x4 v[16]; tr_load(d, v, lane); tr_finish(d, v, scr, lane);
}
struct Args;
constexpr int I_IN0 = 16 * (EVEN_IN / 64), I_OUT = 16 * (D / 64), I_IN1 = 16 * (ODD_IN / 64), I_DENSE = I_IN0 + 2 * I_OUT + I_IN1;
constexpr int I_MOE = NEXP * 384;
__device__ __forceinline__ void norm_row(int lane, const float* xrow, const bf16* mo, const bf16* c0, const bf16* c1, const float* gain, float* xs, bf16* ob, float* of32) {
    const GAS f32x4* xr = (const GAS f32x4*)xrow + lane;
    f32x4 v[4]; float s = 0.f;
#pragma unroll
    for (int j = 0; j < 4; ++j) v[j] = xr[64 * j];
    if (mo) {
#pragma unroll
        for (int j = 0; j < 4; ++j) { const v2u a = *((const GAS v2u*)mo + lane + 64 * j); v[j].x += bf_lo(a.x); v[j].y += bf_hi(a.x); v[j].z += bf_lo(a.y); v[j].w += bf_hi(a.y); }
    }
    if (c0) {
#pragma unroll
        for (int j = 0; j < 4; ++j) { const v2u a = *((const GAS v2u*)c0 + lane + 64 * j), b = *((const GAS v2u*)c1 + lane + 64 * j);
            v[j].x += bf_lo(a.x) + bf_lo(b.x); v[j].y += bf_hi(a.x) + bf_hi(b.x); v[j].z += bf_lo(a.y) + bf_lo(b.y); v[j].w += bf_hi(a.y) + bf_hi(b.y); }
    }
#pragma unroll
    for (int j = 0; j < 4; ++j) s += (v[j].x * v[j].x + v[j].y * v[j].y) + (v[j].z * v[j].z + v[j].w * v[j].w);
    if (xs) {
#pragma unroll
        for (int j = 0; j < 4; ++j) *((GAS f32x4*)xs + lane + 64 * j) = v[j]; }
    const float rstd = rsqrtf(wave_sum(s) * (1.f / D) + EPS);
#pragma unroll
    for (int j = 0; j < 4; ++j) { const f32x4 g = *((const GAS f32x4*)gain + lane + 64 * j); v[j] = v[j] * rstd * g; }
    if (ob) {
#pragma unroll
        for (int j = 0; j < 4; ++j) { v2u o; o.x = pk2(v[j].x, v[j].y); o.y = pk2(v[j].z, v[j].w); *((GAS v2u*)ob + lane + 64 * j) = o; } }
    if (of32) {
#pragma unroll
        for (int j = 0; j < 4; ++j) *((GAS f32x4*)of32 + lane + 64 * j) = v[j]; }
}

struct Args { const float* in[17]; float* out; unsigned char* ws; unsigned mask; int single; };

__device__ __forceinline__ void conv_dense_item(const Args& a, int r, LAS float* scr, int lane) {
    unsigned char* ws = a.ws;
    if (r < I_IN0) { const int nb = EVEN_IN / 64; tr_item64(a.in[1], D, EVEN_IN, (bf16*)(ws + WS_WIN0), 64 * (r / nb), 64 * (r % nb), 64 * (r % nb), scr, lane); return; } r -= I_IN0;
    if (r < I_OUT) { const int nb = D / 64; tr_item64(a.in[2], D, D, (bf16*)(ws + WS_WOUT0), 64 * (r / nb), 64 * (r % nb), 64 * (r % nb), scr, lane); return; } r -= I_OUT;
    if (r < I_IN1) { const int nb = ODD_IN / 64; const int n0 = 64 * (r % nb);
        const int sec = n0 / D, c = n0 % D; const int orow = sec == 0 ? 2048 + c : 256 * (c / 128) + (sec == 2 ? 128 : 0) + (c % 128);
        tr_item64(a.in[6], D, ODD_IN, (bf16*)(ws + WS_WIN1), 64 * (r / nb), n0, orow, scr, lane); return; } r -= I_IN1;
    { const int nb = D / 64; tr_item64(a.in[8], D, D, (bf16*)(ws + WS_WOUT1), 64 * (r / nb), 64 * (r % nb), 64 * (r % nb), scr, lane); }
}
__device__ __forceinline__ TrDesc moe_item_desc(const Args& a, int layer, int q) {
    unsigned char* ws = a.ws;
    const int le = layer * NEXP + q / 384; int r = q % 384;
    if (r < 256) { const int up = r >= 128; if (up) r -= 128; const int n0 = 64 * (r % 8);
        const float* W = (up ? a.in[14] : a.in[13]) + (size_t)le * D * FF;
        return TrDesc{W, (bf16*)(ws + WS_WGU) + (size_t)le * 1024 * D, D, FF, 64 * (r / 8), n0, 256 * (n0 / 128) + (up ? 128 : 0) + (n0 % 128)}; }
    r -= 256;
    return TrDesc{a.in[15] + (size_t)le * FF * D, (bf16*)(ws + WS_WD) + (size_t)le * D * FF, FF, D, 64 * (r / 16), 64 * (r % 16), 64 * (r % 16)};
}
__device__ __forceinline__ void conv_moe_range(const Args& a, LAS unsigned char* lds, int wave, int lane, int layer, int first, int last, int widx, int nw) {
    LAS float* scr = (LAS float*)(lds + wave * 16384);
    int q = first + widx;
    if (q >= last) return;
    TrDesc d0 = moe_item_desc(a, layer, q), d1 = d0; f32x4 v0[16], v1[16];
    tr_load(d0, v0, lane);
    for (;;) {
        const int q1 = q + nw; const bool h1 = q1 < last;
        if (h1) { d1 = moe_item_desc(a, layer, q1); tr_load(d1, v1, lane); }
        tr_finish(d0, v0, scr, lane);
        if (!h1) break;
        const int q2 = q1 + nw; const bool h2 = q2 < last;
        if (h2) { d0 = moe_item_desc(a, layer, q2); tr_load(d0, v0, lane); }
        tr_finish(d1, v1, scr, lane);
        if (!h2) break;
        q = q2;
    }
}
constexpr int L0_P0 = 7288;

__device__ __forceinline__ void phase_prologue(Frame& F, const Args& a, int l0_last) {
    LAS float* scr = (LAS float*)(F.lds + F.wave * 16384);
    const int gw = F.vcu * NWAVES + F.wave, NGW = F.G * NWAVES;
    unsigned char* ws = a.ws;
#ifdef TS_A
#define PSTAMP(k) do { if (blockIdx.x == 0 && F.tid == 0) __hip_atomic_store(F.ctl + CW_TS + (k), (unsigned)__builtin_amdgcn_s_memrealtime(), RLX_AGENT); } while (0)
#else
#define PSTAMP(k) do { } while (0)
#endif
    for (int m = gw; m < T; m += NGW) norm_row(F.lane, a.in[0] + (size_t)m * D, nullptr, nullptr, nullptr, a.in[9], nullptr, (bf16*)(ws + WS_H) + (size_t)m * D, nullptr);
    PSTAMP(53);
    for (int it = gw; it < I_DENSE; it += NGW) conv_dense_item(a, it, scr, F.lane);
    PSTAMP(50);
    conv_moe_range(a, F.lds, F.wave, F.lane, 0, 0, l0_last, gw, NGW);
    PSTAMP(51);
    { const float* wsrc = a.in[3]; bf16* wt = (bf16*)(ws + WS_WTRIL);
      for (int i = (F.vcu * 512 + F.tid) * 4; i < NG * CHUNK * CHUNK; i += F.G * 512 * 4) { const int t = (i / CHUNK) % CHUNK, s = i % CHUNK; const f32x4 v = *(const f32x4*)(wsrc + i);
          v2u o; o.x = pk2(s <= t ? v.x : 0.f, s + 1 <= t ? v.y : 0.f); o.y = pk2(s + 2 <= t ? v.z : 0.f, s + 3 <= t ? v.w : 0.f); *(v2u*)(wt + i) = o; } }
    { bf16* wr = (bf16*)(ws + WS_WR);
      for (int i = F.vcu * 512 + F.tid; i < 2 * 48 * D; i += F.G * 512) { const int k = i % D, c = (i / D) % 48, l = i / (48 * D);
          float w = 0.f;
          if (c < NGRP) w = a.in[11][((size_t)l * D + k) * NGRP + c];
          else if (c < NGRP + NEXP) { const int g = (c - NGRP) / EPG, e = (c - NGRP) % EPG; w = a.in[12][(((size_t)l * NGRP + g) * D + k) * EPG + e]; }
          w *= a.in[10][l * D + k];
          const unsigned hi = f2bf(w); const float rem = w - __builtin_bit_cast(float, hi << 16);
          wr[((size_t)(l * 2 + 0) * 48 + c) * D + k] = (bf16)hi; wr[((size_t)(l * 2 + 1) * 48 + c) * D + k] = (bf16)f2bf(rem); } }
    PSTAMP(52);
}

__device__ __forceinline__ void gmlp_unit(Frame& F, const Args& a, int unit) {
    unsigned char* ws = a.ws;
    const bf16* U = (const bf16*)(ws + WS_ACT); const bf16* GV = U + (size_t)T * GW; const bf16* WT = (const bf16*)(ws + WS_WTRIL); bf16* MIX = (bf16*)(ws + WS_MIX);
    const int g = unit % NG, n = (unit / NG) % (SEQ / CHUNK), b = unit / (NG * (SEQ / CHUNK));
    const int tok0 = b * SEQ + n * CHUNK;
    constexpr int VSTR = 136;
    LAS bf16* vnT = (LAS bf16*)F.lds;
    { const int s = F.tid >> 2, cg = F.tid & 3;
      const v4u r0 = *(const v4u*)(GV + (size_t)(tok0 + s) * GW + g * GD + 16 * cg), r1 = *(const v4u*)(GV + (size_t)(tok0 + s) * GW + g * GD + 16 * cg + 8);
      float v[16]; const unsigned w[8] = {r0.x, r0.y, r0.z, r0.w, r1.x, r1.y, r1.z, r1.w};
#pragma unroll
      for (int i = 0; i < 8; ++i) { v[2 * i] = bf_lo(w[i]); v[2 * i + 1] = bf_hi(w[i]); }
      float ss = 0.f;
#pragma unroll
      for (int i = 0; i < 16; ++i) ss += v[i] * v[i];
      ss += __shfl_xor(ss, 1); ss += __shfl_xor(ss, 2);
      const float rstd = rsqrtf(ss * (1.0f / GD) + EPS);
      const float* gn = a.in[5] + g * GD + 16 * cg;
#pragma unroll
      for (int i = 0; i < 16; ++i) vnT[(16 * cg + i) * VSTR + s] = (bf16)f2bf(v[i] * rstd * gn[i]); }
    __syncthreads();
    { const int db = F.wave & 1, tb = F.wave >> 1, r = F.lane & 31, h = F.lane >> 5;
      f32x16 x;
_Pragma("unroll") for (int i = 0; i < 16; ++i) x[i] = 0.f;
      const bf16* wrow = WT + ((size_t)g * CHUNK + 32 * tb + r) * CHUNK + 8 * h;
      const LAS bf16* vrow = vnT + (32 * db + r) * VSTR + 8 * h;
      for (int kk = 0; kk < 2 * (tb + 1); ++kk) {
          const bf16x8 av = *(const LAS bf16x8*)(vrow + 16 * kk);
          const bf16x8 bw = *(const bf16x8*)(wrow + 16 * kk);
          x = __builtin_amdgcn_mfma_f32_32x32x16_bf16(av, bw, x, 0, 0, 0);
      }
      const int t = 32 * tb + r; const float bias = a.in[4][g * CHUNK + t];
      const bf16* urow = U + (size_t)(tok0 + t) * GW + g * GD + 32 * db + 4 * h; bf16* orow = MIX + (size_t)(tok0 + t) * D + g * GD + 32 * db + 4 * h;
#pragma unroll
      for (int q = 0; q < 4; ++q) { const v2u uu = *(const v2u*)(urow + 8 * q);
          v2u o; o.x = pk2(bf_lo(uu.x) * (x[4 * q] + bias), bf_hi(uu.x) * (x[4 * q + 1] + bias)); o.y = pk2(bf_lo(uu.y) * (x[4 * q + 2] + bias), bf_hi(uu.y) * (x[4 * q + 3] + bias));
          *(v2u*)(orow + 8 * q) = o; } }
    __syncthreads();
}

template <bool DIAG>
__device__ __forceinline__ void sb_tile(const f32x16& s, float& carry, bf16x8& p0, bf16x8& p1, int r, int hh) {
    float l[16], lk[16];
#pragma unroll
    for (int i = 0; i < 16; ++i) {
        const float n = fminf(s[i] * (-0.125f * 1.44269504089f), 126.0f);
        const float e = __builtin_amdgcn_exp2f(n);
        l[i] = __builtin_amdgcn_logf(1.0f + e);
        lk[i] = n - l[i];
        if (DIAG) { const int key = 16 * (i >> 3) + 8 * hh + (i & 7); if (key >= r) lk[i] = 0.f; }
    }
    float suf[16]; float run0 = 0.f, run1 = 0.f;
#pragma unroll
    for (int j = 7; j >= 0; --j) { suf[j] = run0; run0 += lk[j]; suf[8 + j] = run1; run1 += lk[8 + j]; }
    const float o0 = __shfl_xor(run0, 32), o1 = __shfl_xor(run1, 32);
    const float afterA = hh == 0 ? (o0 + run1 + o1) : (o1 + run1);
    const float afterB = hh == 0 ? o1 : 0.f;
    float pa[16];
#pragma unroll
    for (int i = 0; i < 16; ++i) {
        const float arg = carry + (i < 8 ? afterA : afterB) + suf[i] - l[i];
        pa[i] = __builtin_amdgcn_exp2f(arg);
        if (DIAG) { const int key = 16 * (i >> 3) + 8 * hh + (i & 7); if (key >= r) pa[i] = 0.f; }
    }
    carry += (run0 + run1) + (o0 + o1);
    v4u w0, w1;
    w0.x = cvt_pk_bf16(pa[0], pa[1]); w0.y = cvt_pk_bf16(pa[2], pa[3]); w0.z = cvt_pk_bf16(pa[4], pa[5]); w0.w = cvt_pk_bf16(pa[6], pa[7]);
    w1.x = cvt_pk_bf16(pa[8], pa[9]); w1.y = cvt_pk_bf16(pa[10], pa[11]); w1.z = cvt_pk_bf16(pa[12], pa[13]); w1.w = cvt_pk_bf16(pa[14], pa[15]);
    p0 = __builtin_bit_cast(bf16x8, w0); p1 = __builtin_bit_cast(bf16x8, w1);
}
__device__ __forceinline__ void sb_task(const Args& a, int lane, int bh, int qblk) {
    unsigned char* ws = a.ws;
    const bf16* Q = (const bf16*)(ws + WS_ACT) + (size_t)2 * T * GW; const bf16* Kb = Q + (size_t)T * SBW; const bf16* VT = Kb + (size_t)T * SBW; bf16* MIX = (bf16*)(ws + WS_MIX);
    const int b = bh / NH, h = bh % NH, r = lane & 31, hh = lane >> 5;
    const int q0 = qblk * 32;
    const int kap = (r & ~12) | ((r & 4) << 1) | ((r & 8) >> 1);
    bf16x8 qf[4];
    { const bf16* qp = Q + (size_t)(b * SEQ + q0 + r) * SBW + h * HD + 8 * hh;
#pragma unroll
      for (int kk = 0; kk < 4; ++kk) qf[kk] = *(const bf16x8*)(qp + 16 * kk); }
    const bf16* kbase = Kb + (size_t)(b * SEQ + kap) * SBW + h * HD + 8 * hh;
    const bf16* vbase = VT + ((size_t)bh * HD + r) * SEQ + 8 * hh;
    f32x16 o0, o1;
_Pragma("unroll") for (int i = 0; i < 16; ++i) { o0[i] = 0.f; o1[i] = 0.f; }
    float carry = 0.f;
    bf16x8 kf[4], vf[2][2];
    int k0 = q0;
#pragma unroll
    for (int kk = 0; kk < 4; ++kk) kf[kk] = *(const bf16x8*)(kbase + (size_t)k0 * SBW + 16 * kk);
#pragma unroll
    for (int db = 0; db < 2; ++db)
#pragma unroll
        for (int s = 0; s < 2; ++s) vf[db][s] = *(const bf16x8*)(vbase + (size_t)(32 * db) * SEQ + k0 + 16 * s);
    bool diag = true;
    for (;;) {
        f32x16 sc;
_Pragma("unroll") for (int i = 0; i < 16; ++i) sc[i] = 0.f;
#pragma unroll
        for (int kk = 0; kk < 4; ++kk) sc = __builtin_amdgcn_mfma_f32_32x32x16_bf16(kf[kk], qf[kk], sc, 0, 0, 0);
        bf16x8 vcur[2][2];
#pragma unroll
        for (int db = 0; db < 2; ++db)
#pragma unroll
            for (int s = 0; s < 2; ++s) vcur[db][s] = vf[db][s];
        const int kn = k0 - 32;
        if (kn >= 0) {
#pragma unroll
            for (int kk = 0; kk < 4; ++kk) kf[kk] = *(const bf16x8*)(kbase + (size_t)kn * SBW + 16 * kk);
#pragma unroll
            for (int db = 0; db < 2; ++db)
#pragma unroll
                for (int s = 0; s < 2; ++s) vf[db][s] = *(const bf16x8*)(vbase + (size_t)(32 * db) * SEQ + kn + 16 * s);
        }
        bf16x8 p0, p1;
        if (diag) sb_tile<true>(sc, carry, p0, p1, r, hh); else sb_tile<false>(sc, carry, p0, p1, r, hh);
        diag = false;
        o0 = __builtin_amdgcn_mfma_f32_32x32x16_bf16(vcur[0][0], p0, o0, 0, 0, 0);
        o0 = __builtin_amdgcn_mfma_f32_32x32x16_bf16(vcur[0][1], p1, o0, 0, 0, 0);
        o1 = __builtin_amdgcn_mfma_f32_32x32x16_bf16(vcur[1][0], p0, o1, 0, 0, 0);
        o1 = __builtin_amdgcn_mfma_f32_32x32x16_bf16(vcur[1][1], p1, o1, 0, 0, 0);
        if (kn < 0) break;
        if (__all(carry < -150.0f)) break;
        k0 = kn;
    }
    bf16* orow = MIX + (size_t)(b * SEQ + q0 + r) * D + GW + h * HD + 4 * hh;
#pragma unroll
    for (int q = 0; q < 4; ++q) {
        v2u w; w.x = cvt_pk_bf16(o0[4 * q], o0[4 * q + 1]); w.y = cvt_pk_bf16(o0[4 * q + 2], o0[4 * q + 3]); *(v2u*)(orow + 8 * q) = w;
        v2u w2; w2.x = cvt_pk_bf16(o1[4 * q], o1[4 * q + 1]); w2.y = cvt_pk_bf16(o1[4 * q + 2], o1[4 * q + 3]); *(v2u*)(orow + 32 + 8 * q) = w2;
    }
}

struct RouteW { bf16x8 w[3][4][2]; };
__device__ __forceinline__ void route_load_w(RouteW& R, const Args& a, int layer, int wave, int lane) {
    const int fr = lane & 15, fq = lane >> 4;
    const bf16* wh = (const bf16*)(a.ws + WS_WR) + ((size_t)(layer * 2) * 48 + fr) * D + 128 * wave + 8 * fq;
#pragma unroll
    for (int cb = 0; cb < 3; ++cb)
#pragma unroll
        for (int s = 0; s < 4; ++s)
#pragma unroll
            for (int p = 0; p < 2; ++p) R.w[cb][s][p] = *(const bf16x8*)(wh + ((size_t)p * 48 + 16 * cb) * D + 32 * s);
}
__device__ __forceinline__ void route_round(const RouteW& R, const Args& a, LAS unsigned char* lds, int tid, int wave, int lane, int layer, int tok0, const float* X, const bf16* MO, bf16* H, unsigned* cntw, unsigned* list, float* selw) {
    LAS float* plog = (LAS float*)lds;
    LAS float* psq = (LAS float*)(lds + 49152);
    LAS float* lgf = (LAS float*)(lds + 49152 + 1024);
    LAS float* rs = (LAS float*)(lds + 49152 + 1024 + 6144);
    volatile LAS unsigned* hist = (volatile LAS unsigned*)(lds + 49152 + 1024 + 6144 + 128);
    const int fr = lane & 15, fq = lane >> 4;
    if (tid < 64) hist[tid] = 0u;
    f32x4 xp[2][4], xq[2][4]; v4u mo[2][4];
#pragma unroll
    for (int mt = 0; mt < 2; ++mt)
#pragma unroll
        for (int s = 0; s < 4; ++s) { const size_t o = (size_t)(tok0 + 16 * mt + fr) * D + 128 * wave + 32 * s + 8 * fq; xp[mt][s] = *(const f32x4*)(X + o); xq[mt][s] = *(const f32x4*)(X + o + 4); mo[mt][s] = *(const v4u*)(MO + o); }
#pragma unroll
    for (int mt = 0; mt < 2; ++mt)
#pragma unroll
        for (int s = 0; s < 4; ++s) { const v4u m = mo[mt][s]; xp[mt][s] += (f32x4){bf_lo(m.x), bf_hi(m.x), bf_lo(m.y), bf_hi(m.y)}; xq[mt][s] += (f32x4){bf_lo(m.z), bf_hi(m.z), bf_lo(m.w), bf_hi(m.w)}; }
#pragma unroll
    for (int mt = 0; mt < 2; ++mt) {
        f32x4 acc[3]; float ss = 0.f;
#pragma unroll
        for (int cb = 0; cb < 3; ++cb) acc[cb] = (f32x4){0.f, 0.f, 0.f, 0.f};
#pragma unroll
        for (int s = 0; s < 4; ++s) { const f32x4 p = xp[mt][s], q = xq[mt][s];
            ss += (p.x * p.x + p.y * p.y) + (p.z * p.z + p.w * p.w) + (q.x * q.x + q.y * q.y) + (q.z * q.z + q.w * q.w);
            v4u hi; hi.x = cvt_pk_bf16(p.x, p.y); hi.y = cvt_pk_bf16(p.z, p.w); hi.z = cvt_pk_bf16(q.x, q.y); hi.w = cvt_pk_bf16(q.z, q.w);
            v4u lo; lo.x = cvt_pk_bf16(p.x - bf_lo(hi.x), p.y - bf_hi(hi.x)); lo.y = cvt_pk_bf16(p.z - bf_lo(hi.y), p.w - bf_hi(hi.y));
            lo.z = cvt_pk_bf16(q.x - bf_lo(hi.z), q.y - bf_hi(hi.z)); lo.w = cvt_pk_bf16(q.z - bf_lo(hi.w), q.w - bf_hi(hi.w));
            const bf16x8 xh = __builtin_bit_cast(bf16x8, hi), xl = __builtin_bit_cast(bf16x8, lo);
#pragma unroll
            for (int cb = 0; cb < 3; ++cb) {
                acc[cb] = __builtin_amdgcn_mfma_f32_16x16x32_bf16(R.w[cb][s][0], xh, acc[cb], 0, 0, 0);
                acc[cb] = __builtin_amdgcn_mfma_f32_16x16x32_bf16(R.w[cb][s][1], xh, acc[cb], 0, 0, 0);
                acc[cb] = __builtin_amdgcn_mfma_f32_16x16x32_bf16(R.w[cb][s][0], xl, acc[cb], 0, 0, 0);
            } }
        ss += __shfl_xor(ss, 16); ss += __shfl_xor(ss, 32);
#pragma unroll
        for (int cb = 0; cb < 3; ++cb) *(LAS f32x4*)(plog + (wave * 32 + 16 * mt + fr) * 48 + 16 * cb + 4 * fq) = acc[cb];
        if (fq == 0) psq[wave * 32 + 16 * mt + fr] = ss;
    }
    __syncthreads();
    { const int t = tid >> 4, c0 = 3 * (tid & 15);
      float q = 0.f, l0 = 0.f, l1 = 0.f, l2 = 0.f;
#pragma unroll
      for (int w = 0; w < 8; ++w) { q += psq[w * 32 + t]; const LAS float* pl = plog + (w * 32 + t) * 48 + c0; l0 += pl[0]; l1 += pl[1]; l2 += pl[2]; }
      const float rstd = rsqrtf(q * (1.f / D) + EPS);
      lgf[t * 48 + c0] = l0 * rstd; lgf[t * 48 + c0 + 1] = l1 * rstd; lgf[t * 48 + c0 + 2] = l2 * rstd;
      if ((tid & 15) == 0) rs[t] = rstd; }
    __syncthreads();
    int ea = 0, eb = 0; unsigned ra = 0, rb = 0; float wa_ = 0.f, wb_ = 0.f;
    if (tid < 32) {
        const LAS float* my = lgf + tid * 48;
        float gl[4];
#pragma unroll
        for (int g = 0; g < NGRP; ++g) gl[g] = my[g];
        int tg = 0; float mx = gl[0];
#pragma unroll
        for (int g = 1; g < NGRP; ++g) if (gl[g] > mx) { mx = gl[g]; tg = g; }
        float den = 0.f;
#pragma unroll
        for (int g = 0; g < NGRP; ++g) den += __expf(gl[g] - mx);
        const float top_gp = 1.0f / den;
        float el[8];
#pragma unroll
        for (int e = 0; e < EPG; ++e) el[e] = my[NGRP + 8 * tg + e];
        int e0 = 0; float l0 = el[0];
#pragma unroll
        for (int e = 1; e < EPG; ++e) if (el[e] > l0) { l0 = el[e]; e0 = e; }
        int e1 = 0; float l1 = -INFINITY;
#pragma unroll
        for (int e = 0; e < EPG; ++e) if (e != e0 && el[e] > l1) { l1 = el[e]; e1 = e; }
        const float p1 = __expf(l1 - l0), inv = 1.0f / (1.0f + p1);
        ea = tg * EPG + e0; eb = tg * EPG + e1; wa_ = top_gp * inv; wb_ = top_gp * p1 * inv;
        ra = __hip_atomic_fetch_add((LAS unsigned*)hist + ea, 1u, __ATOMIC_RELAXED, __HIP_MEMORY_SCOPE_WORKGROUP);
        rb = __hip_atomic_fetch_add((LAS unsigned*)hist + eb, 1u, __ATOMIC_RELAXED, __HIP_MEMORY_SCOPE_WORKGROUP);
    }
    { const float* gain = a.in[10] + layer * D + 128 * wave + 8 * fq;
#pragma unroll
      for (int s = 0; s < 4; ++s) { const f32x4 gp = *(const f32x4*)(gain + 32 * s), gq = *(const f32x4*)(gain + 32 * s + 4);
#pragma unroll
          for (int mt = 0; mt < 2; ++mt) { const float r = rs[16 * mt + fr]; const f32x4 hp = xp[mt][s] * r * gp, hq = xq[mt][s] * r * gq;
              v4u hi; hi.x = cvt_pk_bf16(hp.x, hp.y); hi.y = cvt_pk_bf16(hp.z, hp.w); hi.z = cvt_pk_bf16(hq.x, hq.y); hi.w = cvt_pk_bf16(hq.z, hq.w);
              *(v4u*)(H + (size_t)(tok0 + 16 * mt + fr) * D + 128 * wave + 32 * s + 8 * fq) = hi; } } }
    __syncthreads();
    if (tid < NEXP) { const unsigned c = hist[tid]; if (c) hist[32 + tid] = __hip_atomic_fetch_add(cntw + (layer * NEXP + tid) * 64, c, RLX_AGENT); }
    __syncthreads();
    if (tid < 32) {
        const int t = tok0 + tid;
        list[(size_t)ea * LIST_CAP + hist[32 + ea] + ra] = (unsigned)(t * 2); list[(size_t)eb * LIST_CAP + hist[32 + eb] + rb] = (unsigned)(t * 2 + 1);
        selw[t * 2] = wa_; selw[t * 2 + 1] = wb_;
    }
    __syncthreads();
}

__device__ __forceinline__ void moe_tables(Frame& F, int layer) {
    volatile LAS int* cnt = (volatile LAS int*)(F.lds + LDSCTL_OFF);
    volatile LAS int* tst = cnt + 32;
    if (F.tid < NEXP) cnt[F.tid] = (int)__hip_atomic_load(F.ctl + CW_CNT + (layer * NEXP + F.tid) * 64, RLX_AGENT);
    __syncthreads();
    if (F.tid == 0) { int acc = 0; for (int e = 0; e < NEXP; ++e) { tst[e] = acc; acc += (cnt[e] + 255) >> 8; } tst[NEXP] = acc; }
    __syncthreads();
}

__device__ __forceinline__ void conv_phase(Frame& F, const Args& a) {
    unsigned char* ws = a.ws;
    const bf16* Y = (const bf16*)(ws + WS_ACT); const bf16* GB = Y + (size_t)T * D; bf16* MIX = (bf16*)(ws + WS_MIX);
    const float* cw = a.in[7];
    for (int it = F.vcu * 512 + F.tid; it < (T / 16) * (D / 8); it += F.G * 512) {
        const int cg = it % (D / 8), tb = it / (D / 8), c0 = cg * 8, tok0 = tb * 16;
        float w0[8], w1[8], w2[8];
#pragma unroll
        for (int j = 0; j < 8; ++j) { w0[j] = cw[c0 + j]; w1[j] = cw[D + c0 + j]; w2[j] = cw[2 * D + c0 + j]; }
        float ym2[8], ym1[8];
        const bool first = (tok0 % SEQ) == 0;
        { v4u r1 = {0, 0, 0, 0}, r2 = {0, 0, 0, 0};
          if (!first) { r2 = *(const v4u*)(Y + (size_t)(tok0 - 2) * D + c0); r1 = *(const v4u*)(Y + (size_t)(tok0 - 1) * D + c0); }
          const unsigned a2[4] = {r2.x, r2.y, r2.z, r2.w}, a1[4] = {r1.x, r1.y, r1.z, r1.w};
#pragma unroll
          for (int j = 0; j < 4; ++j) { ym2[2 * j] = bf_lo(a2[j]); ym2[2 * j + 1] = bf_hi(a2[j]); ym1[2 * j] = bf_lo(a1[j]); ym1[2 * j + 1] = bf_hi(a1[j]); } }
#pragma unroll 4
        for (int t = 0; t < 16; ++t) {
            const v4u ry = *(const v4u*)(Y + (size_t)(tok0 + t) * D + c0), rg = *(const v4u*)(GB + (size_t)(tok0 + t) * D + c0);
            const unsigned ay[4] = {ry.x, ry.y, ry.z, ry.w}, ag[4] = {rg.x, rg.y, rg.z, rg.w};
            float y[8], o[8];
#pragma unroll
            for (int j = 0; j < 4; ++j) { y[2 * j] = bf_lo(ay[j]); y[2 * j + 1] = bf_hi(ay[j]); }
#pragma unroll
            for (int j = 0; j < 8; ++j) { const float gbv = (j & 1) ? bf_hi(ag[j >> 1]) : bf_lo(ag[j >> 1]); o[j] = gbv * (w0[j] * ym2[j] + w1[j] * ym1[j] + w2[j] * y[j]); ym2[j] = ym1[j]; ym1[j] = y[j]; }
            v4u w; w.x = pk2(o[0], o[1]); w.y = pk2(o[2], o[3]); w.z = pk2(o[4], o[5]); w.w = pk2(o[6], o[7]);
            *(v4u*)(MIX + (size_t)(tok0 + t) * D + c0) = w;
        }
    }
}

constexpr int NPHASE = 15;
__global__ void __launch_bounds__(NWAVES * 64, 2) mk_fwd(Args args) {
    extern __shared__ __attribute__((aligned(16))) unsigned char lds[];
    Frame F;
    F.lds = (LAS unsigned char*)lds;
    F.MISC = (volatile LAS unsigned*)(F.lds + MISC_OFF);
    F.tid = threadIdx.x; F.lane = F.tid & 63; F.wave = __builtin_amdgcn_readfirstlane(F.tid >> 6);
    F.G = gridDim.x; { const int bx = blockIdx.x; F.vcu = (F.G % 8 == 0) ? (bx % 8) * (F.G / 8) + bx / 8 : bx; }
    unsigned char* ws = args.ws;
    F.ctl = (gu32*)(ws + WS_CTL);
#ifdef TS_FIXED
    const unsigned long long t_start_ = __builtin_amdgcn_s_memrealtime();
#endif
#ifdef TS_A
    if (blockIdx.x == 0 && threadIdx.x == 0) __hip_atomic_store(F.ctl + CW_TS + 45, (unsigned)__builtin_amdgcn_s_memrealtime(), RLX_AGENT);
#endif
    for (int u = F.tid; u < (LDS_BYTES - LDSCTL_OFF) / 4; u += NWAVES * 64) ((LAS unsigned*)(F.lds + LDSCTL_OFF))[u] = 0u;
    __syncthreads();
    XcdBarrier bar; bar.bar = (unsigned*)(F.ctl + CW_BAR); bar.x = 0; bar.st = nullptr;
    if (args.single) bar = xcd_barrier_post((unsigned*)(F.ctl + CW_BAR), F.MISC + 8);
    const unsigned mask = args.mask;
#ifndef PHCT
#define PHCT 0x7fffu
#endif
#define RUN(k) (((PHCT >> (k)) & 1u) && ((mask >> (k)) & 1u))
#define SEAM(k) do { STAMP(3 * (k) + 1); if (args.single && (k) + 1 < NPHASE) xcd_barrier(bar); STAMP(3 * (k) + 2); } while (0)
#ifndef REPEAT
#define REPEAT (-1)
#endif
#ifdef TS_A
#ifndef TS_BLOCK
#define TS_BLOCK 0
#endif
#define STAMP(k) do { if (blockIdx.x == (TS_BLOCK) && F.tid == 0) __hip_atomic_store(F.ctl + CW_TS + (k), (unsigned)__builtin_amdgcn_s_memrealtime(), RLX_AGENT); } while (0)
#else
#define STAMP(k) do { } while (0)
#endif
#ifndef RMODE
#define RMODE 0
#endif
#define REPS(k) for (int rep_ = 0; rep_ < ((REPEAT) == (k) ? 2 : 1); ++rep_)
    const LAS int* cntL = (const LAS int*)(F.lds + LDSCTL_OFF); const LAS int* tstL = cntL + 32;
    bf16* const Hb = (bf16*)(ws + WS_H); bf16* const ACT = (bf16*)(ws + WS_ACT); bf16* const MIXb = (bf16*)(ws + WS_MIX); float* const Xf = (float*)(ws + WS_X);
    bf16* const MOb = (bf16*)(ws + WS_ACT + 40 * MiB);
    bf16* const CONTRIB = (bf16*)(ws + WS_CONTRIB); unsigned* const LIST = (unsigned*)(ws + WS_LIST); float* const SELW = (float*)(ws + WS_SELW);
    const int gw = F.vcu * NWAVES + F.wave, NGW = F.G * NWAVES;

    STAMP(46);
#ifdef TS_SKEW
    if (F.tid == 0) { const unsigned t = (unsigned)__builtin_amdgcn_s_memrealtime(); __hip_atomic_fetch_max(F.ctl + CW_TS + 60, ~t, RLX_AGENT); __hip_atomic_fetch_max(F.ctl + CW_TS + 61, t, RLX_AGENT); }
#endif
    const int GEMM_G = (F.G == 256) ? 216 : F.G;
    const bool conv_wg = (int)blockIdx.x >= GEMM_G; const int cwi = ((int)blockIdx.x - GEMM_G) * NWAVES + F.wave, ncw = (F.G - GEMM_G) * NWAVES;
    if (RUN(0)) REPS(0) { phase_prologue(F, args, GEMM_G == F.G ? I_MOE : L0_P0); conv_moe_range(args, F.lds, F.wave, F.lane, 1, 0, I_MOE, gw, NGW); SEAM(0); }
    if (RUN(1)) REPS(1) {
        if (!conv_wg) {
#ifdef P1_CONV_ONLY_REP
        if (rep_ == 0)
#endif
        {
        pg8::DenseOrder S; S.init(T, EVEN_IN, D, (const bf16*)(ws + WS_WIN0), GEMM_G, (int)blockIdx.x);
        pg8::EpiEvenIn E{ACT, ACT + (size_t)T * GW, ACT + (size_t)2 * T * GW, ACT + (size_t)3 * T * GW, ACT + (size_t)4 * T * GW};
        pg8::gemm_phase<pg8::EpiEvenIn, pg8::DenseOrder, true>(F.lds, Hb, D, S, E);
        }
        } else { conv_moe_range(args, F.lds, F.wave, F.lane, 0, L0_P0, I_MOE, cwi, ncw); }
        SEAM(1);
    }
#ifdef PROBE_CONV
    if (RUN(1)) { if (conv_wg) { conv_moe_range(args, F.lds, F.wave, F.lane, 0, L0_P0, I_MOE, cwi, ncw); } if (args.single) xcd_barrier(bar); }
#endif
    if (RUN(2)) REPS(2) {
        for (int u = F.vcu; u < BATCH * (SEQ / CHUNK) * NG; u += F.G) gmlp_unit(F, args, u);
        for (int t = gw; t < 2 * 2048; t += NGW) {
            const int rnd = t >> 11, tt = t & 2047; const int bh = (tt >> 6) + 32 * rnd, qb = tt & 63;
            sb_task(args, F.lane, bh, rnd ? 63 - qb : qb);
        }
        SEAM(2);
    }
    if (RUN(3)) REPS(3) {
        pg8::DenseOrder S; S.init(T, D, D, (const bf16*)(ws + WS_WOUT0), F.G, (int)blockIdx.x);
        pg8::EpiMixBf16 E{MOb};
        pg8::gemm_phase<pg8::EpiMixBf16, pg8::DenseOrder, false>(F.lds, MIXb, D, S, E);
        SEAM(3);
    }
#define MOE_PHASES(layer, pb) do { \
        if (RUN(pb)) REPS(pb) { \
            { RouteW RW; route_load_w(RW, args, layer, F.wave, F.lane); \
              for (int rd = F.vcu; rd < T / 32; rd += F.G) route_round(RW, args, F.lds, F.tid, F.wave, F.lane, layer, rd * 32, (layer) == 0 ? args.in[0] : Xf, MOb, Hb, (unsigned*)(F.ctl + CW_CNT) + (rep_ ? 2 * NEXP * 64 : 0), rep_ ? (unsigned*)(ws + WS_CONTRIB) : LIST, rep_ ? (float*)(ws + WS_CONTRIB + 4 * MiB) : SELW); } \
            SEAM(pb); \
        } \
        if (RUN((pb) + 1)) REPS((pb) + 1) { \
            moe_tables(F, layer); \
            { \
            pg8::MoeOrder S{cntL, tstL, (int)blockIdx.x, F.G, (const bf16*)(ws + WS_WGU) + (size_t)(layer) * NEXP * 1024 * D, (size_t)1024 * D, D, LIST, true}; \
            pg8::EpiMoeUp E{ACT}; \
            pg8::gemm_phase<pg8::EpiMoeUp, pg8::MoeOrder, true>(F.lds, Hb, D, S, E); } \
            SEAM((pb) + 1); \
        } \
        if (RUN((pb) + 2)) REPS((pb) + 2) { \
            moe_tables(F, layer); \
            { \
            pg8::MoeOrder S{cntL, tstL, (int)blockIdx.x, F.G, (const bf16*)(ws + WS_WD) + (size_t)(layer) * NEXP * D * FF, (size_t)D * FF, FF, LIST, false}; \
            pg8::EpiMoeDown E{CONTRIB, LIST, SELW, cntL}; \
            pg8::gemm_phase<pg8::EpiMoeDown, pg8::MoeOrder, true>(F.lds, ACT, FF, S, E); } \
            SEAM((pb) + 2); \
        } } while (0)
    MOE_PHASES(0, 4);
    if (RUN(7)) REPS(7) {
        for (int m = gw; m < T; m += NGW) norm_row(F.lane, args.in[0] + (size_t)m * D, MOb + (size_t)m * D, CONTRIB + (size_t)m * D, CONTRIB + (size_t)(T + m) * D, args.in[9] + D, (rep_ ? (float*)ACT : Xf) + (size_t)m * D, (rep_ ? MIXb : Hb) + (size_t)m * D, nullptr);
        SEAM(7);
    }
    if (RUN(8)) REPS(8) {
        pg8::DenseOrder S; S.init(T, ODD_IN, D, (const bf16*)(ws + WS_WIN1), F.G, (int)blockIdx.x);
        pg8::EpiOddIn E{ACT, ACT + (size_t)T * D};
        pg8::gemm_phase<pg8::EpiOddIn, pg8::DenseOrder, true>(F.lds, Hb, D, S, E);
        SEAM(8);
    }
    if (RUN(9)) REPS(9) { conv_phase(F, args); SEAM(9); }
    if (RUN(10)) {
        pg8::DenseOrder S; S.init(T, D, D, (const bf16*)(ws + WS_WOUT1), F.G, (int)blockIdx.x);
        pg8::EpiMixBf16 E{MOb};
        pg8::gemm_phase<pg8::EpiMixBf16, pg8::DenseOrder, false>(F.lds, MIXb, D, S, E);
        SEAM(10);
    }
    MOE_PHASES(1, 11);
#undef MOE_PHASES
    if (RUN(14)) REPS(14) {
        for (int m = gw; m < T; m += NGW) norm_row(F.lane, Xf + (size_t)m * D, MOb + (size_t)m * D, CONTRIB + (size_t)m * D, CONTRIB + (size_t)(T + m) * D, args.in[16], nullptr, nullptr, args.out + (size_t)m * D);
    }
#ifdef TS_FIXED
    { const unsigned long long tend = t_start_ + (unsigned long long)(TS_FIXED) * 100ull; while (__builtin_amdgcn_s_memrealtime() < tend) __builtin_amdgcn_s_sleep(8); }
#endif
#ifdef TS_A
    STAMP(47);
    if (blockIdx.x == (TS_BLOCK) && F.tid == 0) {
        const unsigned s0 = __hip_atomic_load(F.ctl + CW_TS + (TS_A), RLX_AGENT), s1 = __hip_atomic_load(F.ctl + CW_TS + (TS_A1), RLX_AGENT);
        const unsigned s2 = __hip_atomic_load(F.ctl + CW_TS + (TS_B), RLX_AGENT), s3 = __hip_atomic_load(F.ctl + CW_TS + (TS_B1), RLX_AGENT);
#ifdef TS_SKEW
        const unsigned e0 = ~__hip_atomic_load(F.ctl + CW_TS + 60, RLX_AGENT), e1 = __hip_atomic_load(F.ctl + CW_TS + 61, RLX_AGENT);
        const unsigned long long delay = 100ull * (unsigned long long)(e1 - e0);
#else
        const unsigned long long delay = (unsigned long long)(s1 - s0) + 400ull * (unsigned long long)(((s3 - s2) / 100u) * 100u);
#endif
        const unsigned long long t0 = __builtin_amdgcn_s_memrealtime();
        while (__builtin_amdgcn_s_memrealtime() - t0 < delay) __builtin_amdgcn_s_sleep(8);
    }
#endif
#undef RUN
#undef SEAM
}

#if HYBRID
__global__ void __launch_bounds__(256) k_rmsnorm(const float* __restrict__ x, const float* __restrict__ gain, float* __restrict__ out, int rows) {
    const int wave = (blockIdx.x * blockDim.x + threadIdx.x) >> 6, lane = threadIdx.x & 63;
    if (wave >= rows) return;
    const float* xr = x + (size_t)wave * D;
    float v[16]; float s = 0.f;
#pragma unroll
    for (int j = 0; j < 16; ++j) { v[j] = xr[lane + 64 * j]; s += v[j] * v[j]; }
    s = wave_sum(s);
    const float r = rsqrtf(s * (1.0f / D) + EPS);
#pragma unroll
    for (int j = 0; j < 16; ++j) out[(size_t)wave * D + lane + 64 * j] = v[j] * r * gain[lane + 64 * j];
}
__global__ void __launch_bounds__(256) k_sgemm(const float* __restrict__ A, const float* __restrict__ B, float* C, const float* R, int M, int N, int K) {
    __shared__ float As[16][65];
    __shared__ float Bs[16][65];
    const int tx = threadIdx.x & 15, ty = threadIdx.x >> 4;
    const int bm = blockIdx.y * 64, bn = blockIdx.x * 64;
    float acc[4][4] = {};
    for (int k0 = 0; k0 < K; k0 += 16) {
        for (int i = threadIdx.x; i < 64 * 16; i += 256) { const int r = i >> 4, c = i & 15; As[c][r] = A[(size_t)(bm + r) * K + k0 + c]; }
        for (int i = threadIdx.x; i < 16 * 64; i += 256) { const int r = i >> 6, c = i & 63; Bs[r][c] = B[(size_t)(k0 + r) * N + bn + c]; }
        __syncthreads();
#pragma unroll
        for (int k = 0; k < 16; ++k) {
            float a[4], b[4];
#pragma unroll
            for (int i = 0; i < 4; ++i) { a[i] = As[k][ty * 4 + i]; b[i] = Bs[k][tx * 4 + i]; }
#pragma unroll
            for (int i = 0; i < 4; ++i)
#pragma unroll
                for (int j = 0; j < 4; ++j) acc[i][j] += a[i] * b[j];
        }
        __syncthreads();
    }
#pragma unroll
    for (int i = 0; i < 4; ++i)
#pragma unroll
        for (int j = 0; j < 4; ++j) { const size_t o = (size_t)(bm + ty * 4 + i) * N + bn + tx * 4 + j; C[o] = (R ? R[o] : 0.f) + acc[i][j]; }
}
__device__ __forceinline__ float gelu_exact(float v) { return 0.5f * v * (1.0f + erff(v * 0.70710678118654752f)); }
__global__ void __launch_bounds__(256) k_even_post(float* P, const float* __restrict__ vgain) {
    const int w = (blockIdx.x * blockDim.x + threadIdx.x) >> 6, lane = threadIdx.x & 63;
    if (w >= T * NG) return;
    const int tok = w / NG, g = w % NG;
    float* pu = P + (size_t)tok * EVEN_IN + g * GD + lane;
    float* pv = P + (size_t)tok * EVEN_IN + GW + g * GD + lane;
    *pu = gelu_exact(*pu);
    const float v = gelu_exact(*pv);
    const float s = wave_sum(v * v);
    *pv = v * rsqrtf(s * (1.0f / GD) + EPS) * vgain[g * GD + lane];
}
__global__ void __launch_bounds__(256) k_gmlp(const float* __restrict__ P, const float* __restrict__ ws_, const float* __restrict__ bs_, float* __restrict__ mixcat) {
    __shared__ float vs[CHUNK][GD];
    const int g = blockIdx.x % NG, n = (blockIdx.x / NG) % (SEQ / CHUNK), b = blockIdx.x / (NG * (SEQ / CHUNK));
    const int tok0 = b * SEQ + n * CHUNK;
    for (int i = threadIdx.x; i < CHUNK * GD; i += 256) { const int s = i >> 6, d = i & 63; vs[s][d] = P[(size_t)(tok0 + s) * EVEN_IN + GW + g * GD + d]; }
    __syncthreads();
    const int d = threadIdx.x & 63;
    for (int t = threadIdx.x >> 6; t < CHUNK; t += 4) {
        float acc = 0.f;
        const float* wr = ws_ + ((size_t)g * CHUNK + t) * CHUNK;
        for (int s = 0; s <= t; ++s) acc += wr[s] * vs[s][d];
        acc += bs_[g * CHUNK + t];
        const float u = P[(size_t)(tok0 + t) * EVEN_IN + g * GD + d];
        mixcat[(size_t)(tok0 + t) * D + g * GD + d] = u * acc;
    }
}
__device__ __forceinline__ float log_sigmoid(float z) { return fminf(z, 0.f) - log1pf(expf(-fabsf(z))); }
__global__ void __launch_bounds__(256) k_sbattn(const float* __restrict__ P, float* __restrict__ mixcat) {
    const int w = (blockIdx.x * blockDim.x + threadIdx.x) >> 6, lane = threadIdx.x & 63;
    if (w >= T * NH) return;
    const int h = w % NH, tok = w / NH, b = tok / SEQ, t = tok % SEQ;
    const float q = P[(size_t)tok * EVEN_IN + 2 * GW + h * HD + lane];
    float acc = 0.f, suffix = 0.f;
    for (int s = t - 1; s >= 0; --s) {
        const size_t row = (size_t)(b * SEQ + s) * EVEN_IN;
        const float kk = P[row + 2 * GW + SBW + h * HD + lane];
        const float vv = P[row + 2 * GW + 2 * SBW + h * HD + lane];
        const float z = wave_sum(q * kk) * 0.125f;
        const float a = expf(log_sigmoid(z) + suffix);
        acc += a * vv;
        suffix += log_sigmoid(-z);
    }
    mixcat[(size_t)tok * D + GW + h * HD + lane] = acc;
}
__global__ void __launch_bounds__(256) k_conv(const float* __restrict__ P, const float* __restrict__ cw, float* __restrict__ mixin) {
    const size_t i = (size_t)blockIdx.x * blockDim.x + threadIdx.x;
    if (i >= (size_t)T * D) return;
    const int c = (int)(i % D), tok = (int)(i / D), t = tok % SEQ;
    float acc = 0.f;
#pragma unroll
    for (int k = 0; k < 3; ++k) { const int tt = t + k - 2;
        if (tt >= 0) { const size_t row = (size_t)(tok + k - 2) * ODD_IN; acc += cw[k * D + c] * (P[row + D + c] * P[row + 2 * D + c]); } }
    mixin[i] = P[(size_t)tok * ODD_IN + c] * acc;
}
__global__ void __launch_bounds__(256) k_route(const float* __restrict__ x, const float* __restrict__ gain, const float* __restrict__ wrg, const float* __restrict__ wre,
                                               float* __restrict__ h2, int* __restrict__ sel_e, float* __restrict__ sel_w) {
    const int w = (blockIdx.x * blockDim.x + threadIdx.x) >> 6, lane = threadIdx.x & 63;
    if (w >= T) return;
    const float* xr = x + (size_t)w * D;
    float v[16]; float s = 0.f;
#pragma unroll
    for (int j = 0; j < 16; ++j) { v[j] = xr[lane + 64 * j]; s += v[j] * v[j]; }
    s = wave_sum(s);
    const float r = rsqrtf(s * (1.0f / D) + EPS);
#pragma unroll
    for (int j = 0; j < 16; ++j) { v[j] = v[j] * r * gain[lane + 64 * j]; h2[(size_t)w * D + lane + 64 * j] = v[j]; }
    float gl[NGRP];
#pragma unroll
    for (int g = 0; g < NGRP; ++g) { float a = 0.f;
#pragma unroll
        for (int j = 0; j < 16; ++j) a += v[j] * wrg[(size_t)(lane + 64 * j) * NGRP + g];
        gl[g] = wave_sum(a); }
    int tg = 0; float mx = gl[0];
#pragma unroll
    for (int g = 1; g < NGRP; ++g) if (gl[g] > mx) { mx = gl[g]; tg = g; }
    float den = 0.f;
#pragma unroll
    for (int g = 0; g < NGRP; ++g) den += expf(gl[g] - mx);
    const float top_gp = 1.0f / den;
    float el[EPG];
#pragma unroll
    for (int e = 0; e < EPG; ++e) { float a = 0.f;
#pragma unroll
        for (int j = 0; j < 16; ++j) a += v[j] * wre[((size_t)tg * D + lane + 64 * j) * EPG + e];
        el[e] = wave_sum(a); }
    int e0 = 0; float l0 = el[0];
#pragma unroll
    for (int e = 1; e < EPG; ++e) if (el[e] > l0) { l0 = el[e]; e0 = e; }
    int e1 = -1; float l1 = -INFINITY;
#pragma unroll
    for (int e = 0; e < EPG; ++e) if (e != e0 && el[e] > l1) { l1 = el[e]; e1 = e; }
    const float p1 = expf(l1 - l0), inv = 1.0f / (1.0f + p1);
    if (lane == 0) { sel_e[w * 2 + 0] = tg * EPG + e0; sel_e[w * 2 + 1] = tg * EPG + e1; sel_w[w * 2 + 0] = top_gp * inv; sel_w[w * 2 + 1] = top_gp * p1 * inv; }
}
__global__ void __launch_bounds__(256) k_moe_up(const float* __restrict__ h2, const int* __restrict__ sel_e, const float* __restrict__ wg, const float* __restrict__ wu, float* __restrict__ hmid) {
    __shared__ float hs[D];
    const int row = blockIdx.x, tok = row >> 1;
    const int e = sel_e[row];
    for (int i = threadIdx.x; i < D; i += 256) hs[i] = h2[(size_t)tok * D + i];
    __syncthreads();
    const float* g = wg + (size_t)e * D * FF; const float* u = wu + (size_t)e * D * FF;
    float ag0 = 0.f, ag1 = 0.f, au0 = 0.f, au1 = 0.f;
    const int f = threadIdx.x;
    for (int k = 0; k < D; ++k) { const float hv = hs[k];
        ag0 += hv * g[(size_t)k * FF + f]; ag1 += hv * g[(size_t)k * FF + f + 256];
        au0 += hv * u[(size_t)k * FF + f]; au1 += hv * u[(size_t)k * FF + f + 256]; }
    hmid[(size_t)row * FF + f] = ag0 / (1.0f + expf(-ag0)) * au0;
    hmid[(size_t)row * FF + f + 256] = ag1 / (1.0f + expf(-ag1)) * au1;
}
__global__ void __launch_bounds__(256) k_moe_down(const float* __restrict__ hmid, const int* __restrict__ sel_e, const float* __restrict__ sel_w, const float* __restrict__ wd, float* x) {
    __shared__ float hs[2][FF];
    const int tok = blockIdx.x;
    for (int i = threadIdx.x; i < 2 * FF; i += 256) hs[i / FF][i % FF] = hmid[(size_t)tok * 2 * FF + i];
    __syncthreads();
    float acc[4] = {0.f, 0.f, 0.f, 0.f};
    for (int sl = 0; sl < 2; ++sl) {
        const int e = sel_e[tok * 2 + sl]; const float w = sel_w[tok * 2 + sl];
        const float* dmat = wd + (size_t)e * FF * D;
        float a[4] = {0.f, 0.f, 0.f, 0.f};
        for (int f = 0; f < FF; ++f) { const float hv = hs[sl][f];
#pragma unroll
            for (int j = 0; j < 4; ++j) a[j] += hv * dmat[(size_t)f * D + threadIdx.x + 256 * j]; }
#pragma unroll
        for (int j = 0; j < 4; ++j) acc[j] += w * a[j];
    }
#pragma unroll
    for (int j = 0; j < 4; ++j) x[(size_t)tok * D + threadIdx.x + 256 * j] += acc[j];
}
#endif

extern "C" void kernel_launch(void* const* d_in, const int* in_sizes, int n_in, void* d_out, int out_size, void* d_ws, size_t ws_size, hipStream_t stream) {
    static int grid = 0;
    if (grid == 0) {
        if (n_in != 17 || in_sizes[0] != T * D || out_size != T * D || ws_size < WS_END) { fprintf(stderr, "kernel_launch: unexpected shapes / workspace (%d inputs, ws %zu)\n", n_in, ws_size); grid = -1; return; }
        int dev = 0, cus = 0, per_cu = 0;
        if (hipGetDevice(&dev) != hipSuccess || hipDeviceGetAttribute(&cus, hipDeviceAttributeMultiprocessorCount, dev) != hipSuccess) { grid = -1; return; }
        if (hipFuncSetAttribute((const void*)mk_fwd, hipFuncAttributeMaxDynamicSharedMemorySize, LDS_BYTES) != hipSuccess) { fprintf(stderr, "kernel_launch: hipFuncSetAttribute failed\n"); grid = -1; return; }
        if (hipOccupancyMaxActiveBlocksPerMultiprocessor(&per_cu, (const void*)mk_fwd, NWAVES * 64, LDS_BYTES) != hipSuccess || per_cu < 1) { fprintf(stderr, "kernel_launch: occupancy query reports %d workgroups per CU\n", per_cu); }
        (void)hipGetLastError();
        grid = cus;
    }
    if (grid < 0) return;
    Args a{};
    for (int i = 0; i < 17; ++i) a.in[i] = (const float*)d_in[i];
    a.out = (float*)d_out; a.ws = (unsigned char*)d_ws;
#if !HYBRID
    hipMemsetAsync((char*)d_ws + WS_CTL, 0, CTL_ZERO_BYTES, stream);
    a.mask = (1u << NPHASE) - 1u; a.single = 1;
    hipLaunchKernelGGL(mk_fwd, dim3(grid), dim3(NWAVES * 64), LDS_BYTES, stream, a);
#else
    char* ws = (char*)d_ws;
    float* X = (float*)(ws + WS_X);
    float* sH = (float*)(ws + 0 * MiB); float* sP = (float*)(ws + 64 * MiB); float* sMC = (float*)(ws + 256 * MiB);
    int* sSE = (int*)(ws + 320 * MiB); float* sSW = (float*)(ws + 321 * MiB); float* sHM = (float*)(ws + 420 * MiB);
    const float** in = (const float**)a.in;
    auto fast = [&](unsigned mask) {
        for (int k = 0; k < NPHASE; ++k) if ((mask >> k) & 1u) { a.mask = 1u << k; a.single = 0; hipLaunchKernelGGL(mk_fwd, dim3(grid), dim3(NWAVES * 64), LDS_BYTES, stream, a); } };
    auto fast_prep = [&]() { hipMemsetAsync(ws + WS_CTL, 0, CTL_ZERO_BYTES, stream); fast(1u << 0); };
    auto slow_mixer = [&](int l) {
        const float* xin = (l == 0) ? in[0] : X;
        k_rmsnorm<<<T / 4, 256, 0, stream>>>(xin, in[9] + l * D, sH, T);
        if (l == 0) {
            k_sgemm<<<dim3(EVEN_IN / 64, T / 64), 256, 0, stream>>>(sH, in[1], sP, nullptr, T, EVEN_IN, D);
            k_even_post<<<T * NG / 4, 256, 0, stream>>>(sP, in[5]);
            k_gmlp<<<BATCH * (SEQ / CHUNK) * NG, 256, 0, stream>>>(sP, in[3], in[4], sMC);
            k_sbattn<<<T * NH / 4, 256, 0, stream>>>(sP, sMC);
            k_sgemm<<<dim3(D / 64, T / 64), 256, 0, stream>>>(sMC, in[2], X, xin, T, D, D);
        } else {
            k_sgemm<<<dim3(ODD_IN / 64, T / 64), 256, 0, stream>>>(sH, in[6], sP, nullptr, T, ODD_IN, D);
            k_conv<<<T * D / 256, 256, 0, stream>>>(sP, in[7], sMC);
            k_sgemm<<<dim3(D / 64, T / 64), 256, 0, stream>>>(sMC, in[8], X, xin, T, D, D);
        } };
    auto slow_moe = [&](int l) {
        k_route<<<T / 4, 256, 0, stream>>>(X, in[10] + l * D, in[11] + (size_t)l * D * NGRP, in[12] + (size_t)l * NGRP * D * EPG, sH, sSE, sSW);
        k_moe_up<<<T * 2, 256, 0, stream>>>(sH, sSE, in[13] + (size_t)l * NEXP * D * FF, in[14] + (size_t)l * NEXP * D * FF, sHM);
        k_moe_down<<<T, 256, 0, stream>>>(sHM, sSE, sSW, in[15] + (size_t)l * NEXP * FF * D, X);
        hipMemsetAsync(ws + WS_CONTRIB, 0, (size_t)2 * T * D * 2, stream); };
    const unsigned hy = HYBRID;
    if (hy & 1u) slow_mixer(0); else { fast_prep(); fast(0xEu); }
    if (hy & 2u) slow_moe(0); else { if (hy & 1u) fast_prep(); fast(0x70u); }
    if (hy & 4u) { if (!(hy & 2u)) fast(1u << 7); slow_mixer(1); }
    else { if (hy & 2u) fast_prep(); fast(0x780u); }
    if (hy & 8u) slow_moe(1); else { if (hy & 4u) fast_prep(); fast(0x3800u); }
    fast(1u << 14);
#endif
}
```

```cpp
#include <hip/hip_runtime.h>
#include <cstdio>
#include <cstdint>
#include <cmath>

#ifndef HYBRID
#define HYBRID 0
#endif

#define GAS __attribute__((address_space(1)))
#define LAS __attribute__((address_space(3)))
typedef unsigned short bf16;
typedef unsigned v4u __attribute__((ext_vector_type(4)));
typedef unsigned v2u __attribute__((ext_vector_type(2)));
typedef float f32x4 __attribute__((ext_vector_type(4)));
typedef float f32x2 __attribute__((ext_vector_type(2)));
typedef float f32x16 __attribute__((ext_vector_type(16)));
typedef short bf16x8 __attribute__((ext_vector_type(8)));
typedef GAS unsigned gu32;

constexpr int D = 1024, BATCH = 8, SEQ = 2048, T = BATCH * SEQ;
constexpr int NG = 8, GD = 64, GW = 512, CHUNK = 128;
constexpr int NH = 8, HD = 64, SBW = 512;
constexpr int EVEN_IN = 2560, ODD_IN = 3072;
constexpr int NGRP = 4, EPG = 8, NEXP = 32, FF = 512;
constexpr float EPS = 1e-6f;
constexpr int NWAVES = 8;
constexpr int LIST_CAP = T;
constexpr int MAX_MT = 2 * T / 256 + NEXP;

constexpr size_t MiB = 1u << 20;
constexpr size_t WS_CTL = 0, CTL_ZERO_BYTES = 128 * 1024;
constexpr size_t WS_WTRIL = 128 * 1024;
constexpr size_t WS_WR = 384 * 1024;
constexpr size_t WS_LIST = 1 * MiB;
constexpr size_t WS_SELW = 3 * MiB;
constexpr size_t WS_WIN0 = 5 * MiB, WS_WOUT0 = 10 * MiB, WS_WIN1 = 12 * MiB, WS_WOUT1 = 18 * MiB;
constexpr size_t WS_WGU = 20 * MiB;
constexpr size_t WS_WD = 148 * MiB;
constexpr size_t WS_H = 212 * MiB;
constexpr size_t WS_ACT = 244 * MiB;
constexpr size_t WS_MIX = 324 * MiB;
constexpr size_t WS_X = 356 * MiB;
constexpr size_t WS_CONTRIB = 420 * MiB;
constexpr size_t WS_END = 484 * MiB;
constexpr int CW_CNT = 64;
constexpr int CW_TS = 12288;
constexpr int CW_BAR = 16384;

constexpr int RING_BYTES = 131072;
constexpr int LDSCTL_OFF = RING_BYTES, MISC_OFF = LDSCTL_OFF + 320;
constexpr int LDS_BYTES = 147456;

#define RLX_AGENT __ATOMIC_RELAXED, __HIP_MEMORY_SCOPE_AGENT
#define LDS_WAIT() asm volatile("s_waitcnt lgkmcnt(0)" ::: "memory")
#define VM_WAIT() asm volatile("s_waitcnt vmcnt(0)" ::: "memory")
__device__ __forceinline__ unsigned f2bf(float f) { unsigned u = __builtin_bit_cast(unsigned, f); return (u + 0x7fffu + ((u >> 16) & 1u)) >> 16; }
__device__ __forceinline__ unsigned pk2(float lo, float hi) { return f2bf(lo) | (f2bf(hi) << 16); }
__device__ __forceinline__ float bf_lo(unsigned w) { return __builtin_bit_cast(float, w << 16); }
__device__ __forceinline__ float bf_hi(unsigned w) { return __builtin_bit_cast(float, w & 0xffff0000u); }
__device__ __forceinline__ unsigned cvt_pk_bf16(float lo, float hi) { unsigned r; asm volatile("v_cvt_pk_bf16_f32 %0, %1, %2" : "=v"(r) : "v"(lo), "v"(hi)); return r; }
__device__ __forceinline__ float wave_sum(float v) {
#pragma unroll
    for (int o = 1; o < 64; o <<= 1) v += __shfl_xor(v, o);
    return v;
}

#define XB_TMO      128
#define XB_XCNT(j)  (256  + 64 * (j))
#define XB_XSUB(j)  (1280 + 64 * (j))
#define XB_XGEN(j)  (2304 + 64 * (j))
#define XB_TOP      3328
#define XB_TOPGEN   3392
#define XCD_BAR_WORDS 3456
#define XB_SPIN_CAP (1u << 18)
__device__ __forceinline__ unsigned xb_ld(unsigned* p)              { return __hip_atomic_load(p, __ATOMIC_RELAXED, __HIP_MEMORY_SCOPE_AGENT); }
__device__ __forceinline__ unsigned xb_add(unsigned* p, unsigned v) { return __hip_atomic_fetch_add(p, v, __ATOMIC_RELAXED, __HIP_MEMORY_SCOPE_AGENT); }
__device__ __forceinline__ unsigned xb_xcc_id() { return (unsigned)__builtin_amdgcn_s_getreg((3 << 11) | 20) & 0xFu; }
#define XB_SPIN(cond, bar) do { unsigned _sp = 0; while (cond) { __builtin_amdgcn_s_sleep(1); \
    if ((++_sp & 255u) == 0u) { if (xb_ld(&(bar)[XB_TMO])) break; if (_sp > XB_SPIN_CAP) { atomicAdd(&(bar)[XB_TMO], 1u); break; } } } } while (0)
struct XcdBarrier { unsigned* bar; unsigned x; volatile LAS unsigned* st; };
__device__ __forceinline__ XcdBarrier xcd_barrier_post(unsigned* bar, volatile LAS unsigned* st) {
    XcdBarrier b; b.bar = bar; b.x = xb_xcc_id(); b.st = st;
    if (threadIdx.x == 0) (void)xb_add(&bar[XB_XCNT(b.x)], 1u);
    return b;
}
__device__ __forceinline__ void xcd_barrier_complete(unsigned* bar, unsigned x, unsigned& nloc, unsigned& nx) {
    const unsigned G = gridDim.x * gridDim.y * gridDim.z;
    unsigned sum, cnt, mine, sp = 0u;
    for (;;) {
        sum = 0u; cnt = 0u; mine = 0u;
#pragma unroll
        for (unsigned j = 0; j < 16; ++j) { const unsigned c = xb_ld(&bar[XB_XCNT(j)]); sum += c; cnt += (c > 0u) ? 1u : 0u; mine = (j == x) ? c : mine; }
        if (sum == G) break;
        __builtin_amdgcn_s_sleep(1);
        if ((++sp & 255u) == 0u) { if (xb_ld(&bar[XB_TMO])) break; if (sp > XB_SPIN_CAP) { atomicAdd(&bar[XB_TMO], 1u); break; } }
    }
    nloc = mine > 0u ? mine : 1u; nx = cnt > 0u ? cnt : 1u;
}
__device__ __forceinline__ void xcd_barrier(const XcdBarrier& b) {
    asm volatile("s_waitcnt vmcnt(0)" ::: "memory");
    __syncthreads();
    if (threadIdx.x == 0) {
        unsigned* bar = b.bar;
        __builtin_amdgcn_s_waitcnt(0);
        unsigned nloc = b.st[0], nx = b.st[1];
        if (nloc == 0u) { xcd_barrier_complete(bar, b.x, nloc, nx); b.st[0] = nloc; b.st[1] = nx; }
        const unsigned old = xb_add(&bar[XB_XSUB(b.x)], 1u);
        const unsigned gen = old / nloc;
        if (old + 1u == (gen + 1u) * nloc) {
            __builtin_amdgcn_fence(__ATOMIC_RELEASE, "agent");
            asm volatile("s_waitcnt vmcnt(0)" ::: "memory");
            const unsigned og = xb_add(&bar[XB_TOP], 1u);
            const unsigned tg = og / nx;
            if (og + 1u == (tg + 1u) * nx) xb_add(&bar[XB_TOPGEN], 1u);
            else XB_SPIN(xb_ld(&bar[XB_TOPGEN]) == tg, bar);
            __builtin_amdgcn_fence(__ATOMIC_ACQUIRE, "agent");
            xb_add(&bar[XB_XGEN(b.x)], 1u);
            asm volatile("s_waitcnt vmcnt(0)" ::: "memory");
        } else {
            XB_SPIN(xb_ld(&bar[XB_XGEN(b.x)]) == gen, bar);
            __builtin_amdgcn_fence(__ATOMIC_ACQUIRE, "agent");
            asm volatile("s_waitcnt vmcnt(0)" ::: "memory");
        }
    }
    __syncthreads();
}

namespace pg8 {
constexpr int BM = 256, BK = 64, HALF = 128, HTB = HALF * BK * 2, STAGE_BYTES = 8 * HTB, NXCD = 8, WGM = 8;
__host__ __device__ __forceinline__ int lds_byte(int r, int c) { const int st = (r >> 4) * 2 + (c >> 5), rr = r & 15, cc = c & 31, ob = rr * 64 + cc * 2; return st * 1024 + (ob ^ (((ob >> 9) & 1) << 5)); }
__host__ __device__ __forceinline__ void stage_rc(int b, int& R, int& C) { const int st = b / 1024, sb = b % 1024, swz = sb ^ (((sb >> 9) & 1) << 5); R = (st >> 1) * 16 + swz / 64; C = (st & 1) * 32 + (swz % 64) / 2; }
__host__ __device__ __forceinline__ int perm32(int rho) { const int n = rho >> 4, i = rho & 15; return 8 * (i >> 2) + 4 * n + (i & 3); }

struct Unit { int pm, pn, e, mt, sh; };

struct DenseOrder {
    static constexpr bool HAS_SHORT = false;
    int nM, nN, nwg, G, c; const bf16* Bt; int K;
    __device__ void init(int M, int N, int K_, const bf16* Bt_, int G_, int c_) { nM = M / BM; nN = N / BM; nwg = nM * nN; G = G_; c = c_; Bt = Bt_; K = K_; }
    __device__ bool next(int i, Unit& u) const {
        const long L = (long)i * G + c; if (L >= nwg) return false;
        int wgid = (int)L; { const int q = nwg / NXCD, r = nwg % NXCD, xcd = wgid % NXCD, off = wgid / NXCD; wgid = (xcd < r ? xcd * (q + 1) : r * (q + 1) + (xcd - r) * q) + off; }
        const int nig = WGM * nN, gid = wgid / nig, fm = gid * WGM, gsz = (nM - fm) < WGM ? (nM - fm) : WGM;
        u.pm = fm + ((wgid % nig) % gsz); u.pn = (wgid % nig) / gsz; u.e = 0; u.mt = 0; u.sh = 0; return true;
    }
    __device__ __forceinline__ int a_row(const Unit& u, int r) const { return u.pm * BM + r; }
    __device__ __forceinline__ const char* b_base(const Unit& u) const { return (const char*)Bt + (size_t)u.pn * BM * K * 2; }
};

struct MoeOrder {
    const LAS int* cnt; const LAS int* tstart; int c, G; const bf16* W; size_t wstride; int K; const unsigned* list; bool gather;
    static constexpr bool HAS_SHORT = true;
    __device__ bool next(int i, Unit& u) const {
        const int x = c & 7, j = c >> 3, per = (G - x + 7) >> 3;
        int L = i * per + j;
        int tl = L >> 2; const int pn = L & 3;
#pragma unroll
        for (int k = 0; k < 4; ++k) {
            const int e = x + 8 * k; const int nt = tstart[e + 1] - tstart[e]; const int shrt = (nt > 0 && cnt[e] - (nt - 1) * BM <= HALF) ? 1 : 0; const int nf = nt - shrt;
            if (tl < nf) { u.e = e; u.mt = tl; u.pm = tstart[e] + tl; u.pn = pn; u.sh = 0; return true; }
            tl -= nf;
        }
#pragma unroll
        for (int k = 0; k < 4; ++k) {
            const int e = x + 8 * k; const int nt = tstart[e + 1] - tstart[e]; const int shrt = (nt > 0 && cnt[e] - (nt - 1) * BM <= HALF) ? 1 : 0;
            if (shrt) { if (tl == 0) { u.e = e; u.mt = nt - 1; u.pm = tstart[e] + nt - 1; u.pn = pn; u.sh = 1; return true; } --tl; }
        }
        return false;
    }
    __device__ __forceinline__ int a_row(const Unit& u, int r) const {
        if (!gather) return u.pm * BM + r;
        const int idx = u.mt * BM + r;
        return idx < cnt[u.e] ? (int)(list[(size_t)u.e * LIST_CAP + idx] >> 1) : 0;
    }
    __device__ __forceinline__ const char* b_base(const Unit& u) const { return (const char*)W + ((size_t)u.e * wstride + (size_t)u.pn * BM * K) * 2; }
};

__device__ __forceinline__ f32x2 gelu_pk(f32x2 v) {
    const f32x2 av = __builtin_elementwise_abs(v), d = av * 0.2316418882f + 1.0f;
    f32x2 t; t.x = __builtin_amdgcn_rcpf(d.x); t.y = __builtin_amdgcn_rcpf(d.y);
    f32x2 q = t * 0.5307027145f + (-0.7265760135f); q = q * t + 0.7107068705f; q = q * t + (-0.142248368f); q = q * t + 0.127414796f; q = q * t;
    const f32x2 s = (v * v) * (-0.72134752044f);
    f32x2 e; e.x = __builtin_amdgcn_exp2f(s.x); e.y = __builtin_amdgcn_exp2f(s.y);
    const f32x2 m = v * (q * e), r = v - m;
    f32x2 o; o.x = v.x < 0.f ? m.x : r.x; o.y = v.y < 0.f ? m.y : r.y; return o;
}

typedef f32x4 Acc[2][2][4][2];

template <class Epi, class Sched, bool ALIGN_EPI>
__device__ __forceinline__ void gemm_phase(LAS unsigned char* lds, const bf16* A, const int K, const Sched& S, const Epi& E) {
    const int tid = threadIdx.x, wid = __builtin_amdgcn_readfirstlane(tid >> 6), lane = tid & 63, wr = wid >> 2, wc = wid & 3, fr = lane & 15, fq = lane >> 4;
    const int nt = K / BK;
    int Rr[2], Cc[2]; unsigned voffB[2];
#pragma unroll
    for (int i = 0; i < 2; ++i) { int R, C; stage_rc(tid * 16 + i * 8192, R, C); const int Rb = Epi::PERM ? ((R & ~31) + perm32(R & 31)) : R;
        Rr[i] = R; Cc[i] = C; voffB[i] = (unsigned)(Rb * K + C) * 2u; }
    const size_t kstep = (size_t)(BK * 2);
    const size_t hstep = (size_t)HALF * K * 2;
    const unsigned ldsw = (unsigned)wid * 1024u;
    const int aoff = lds_byte(wr * 64 + fr, fq * 8), boff = lds_byte(wc * 32 + fr, fq * 8);
#define PG8_SA(b, h) (((b) * 2 + (h)) * HTB)
#define PG8_SB(b, h) ((4 + (b) * 2 + (h)) * HTB)
#define PG8_STAGE(bufoff, gbase, voff) do { _Pragma("unroll") for (int _i = 0; _i < 2; ++_i) \
        __builtin_amdgcn_global_load_lds((const unsigned*)((const char*)(gbase) + (voff)[_i]), (LAS unsigned*)(lds + (bufoff) + ldsw + _i * 8192), 16, 0, 0); } while (0)
#define PG8_LDA(dst, b, h) do { _Pragma("unroll") for (int m = 0; m < 4; ++m) _Pragma("unroll") for (int k = 0; k < 2; ++k) dst[m][k] = *(const LAS bf16x8*)(lds + PG8_SA(b, h) + aoff + m * 2048 + k * 1024); } while (0)
#define PG8_LDB(dst, b, h) do { _Pragma("unroll") for (int n = 0; n < 2; ++n) _Pragma("unroll") for (int k = 0; k < 2; ++k) dst[n][k] = *(const LAS bf16x8*)(lds + PG8_SB(b, h) + boff + n * 2048 + k * 1024); } while (0)
#define PG8_MMA(ai, bj, At, Bt) do { __builtin_amdgcn_s_setprio(1); _Pragma("unroll") for (int m = 0; m < 4; ++m) _Pragma("unroll") for (int n = 0; n < 2; ++n) _Pragma("unroll") for (int k = 0; k < 2; ++k) \
        acc[ai][bj][m][n] = __builtin_amdgcn_mfma_f32_16x16x32_bf16(Bt[n][k], At[m][k], acc[ai][bj][m][n], 0, 0, 0); __builtin_amdgcn_s_setprio(0); } while (0)
#define PG8_WAIT_V(n) asm volatile("s_waitcnt vmcnt(" #n ")" ::: "memory")
#define PG8_WAIT_L(n) asm volatile("s_waitcnt lgkmcnt(" #n ")" ::: "memory")
#define PG8_BAR __builtin_amdgcn_s_barrier()
#define PG8_SCHED __builtin_amdgcn_sched_barrier(0)
#define PG8_VOFF(dst, u) do { _Pragma("unroll") for (int _h = 0; _h < 2; ++_h) _Pragma("unroll") for (int _i = 0; _i < 2; ++_i) \
        dst[_h][_i] = (unsigned)(S.a_row(u, _h * HALF + Rr[_i]) * K + Cc[_i]) * 2u; \
        asm volatile("" : "+v"(dst[0][0]), "+v"(dst[0][1]), "+v"(dst[1][0]), "+v"(dst[1][1])); } while (0)
    Unit cur, nxt; int ui = 0;
    if (!S.next(0, cur)) return;
    Acc acc;
#pragma unroll
    for (int a = 0; a < 2; ++a)
#pragma unroll
        for (int b = 0; b < 2; ++b)
#pragma unroll
            for (int m = 0; m < 4; ++m)
#pragma unroll
                for (int n = 0; n < 2; ++n) acc[a][b][m][n] = (f32x4){0.f, 0.f, 0.f, 0.f};
    bf16x8 At[4][2], B0[2][2], B1[2][2];
    unsigned vc[2][2], vn[2][2];
    PG8_VOFF(vc, cur);
    const char* const cA = (const char*)A;
    const char* cB = S.b_base(cur);
    PG8_STAGE(PG8_SB(0, 0), cB, voffB); PG8_STAGE(PG8_SB(0, 1), cB + hstep, voffB); PG8_STAGE(PG8_SA(0, 0), cA, vc[0]); PG8_STAGE(PG8_SA(0, 1), cA, vc[1]);
    if (wr == 1) PG8_BAR;
    PG8_WAIT_V(2); PG8_BAR;
    PG8_STAGE(PG8_SB(1, 0), cB + kstep, voffB); PG8_STAGE(PG8_SA(1, 0), cA + kstep, vc[0]); PG8_STAGE(PG8_SB(1, 1), cB + hstep + kstep, voffB);
    PG8_WAIT_V(6); PG8_BAR;
    for (;;) {
        const bool has_next = S.next(ui + 1, nxt);
        if (has_next) { PG8_VOFF(vn, nxt); } else {
#pragma unroll
            for (int h = 0; h < 2; ++h)
#pragma unroll
                for (int i = 0; i < 2; ++i) vn[h][i] = vc[h][i]; }
        const char* nB = has_next ? S.b_base(nxt) : cB;
        const bool sh = Sched::HAS_SHORT && cur.sh != 0;
        for (int t = 0; t < nt; t += 2) {
            const bool last = (t == nt - 2);
            const char* a1 = cA + (size_t)(t + 1) * kstep;
            const char* a2 = last ? cA : cA + (size_t)(t + 2) * kstep; const char* b2 = last ? nB : cB + (size_t)(t + 2) * kstep;
            const char* a3 = a2 + kstep; const char* b3 = b2 + kstep;
            unsigned v2[2][2];
#pragma unroll
            for (int h = 0; h < 2; ++h)
#pragma unroll
                for (int i = 0; i < 2; ++i) v2[h][i] = last ? vn[h][i] : vc[h][i];
            PG8_LDB(B0, 0, 0); PG8_LDB(B1, 0, 1); PG8_SCHED; PG8_LDA(At, 0, 0); PG8_STAGE(PG8_SA(1, 1), a1, vc[1]);
            PG8_WAIT_V(8); PG8_WAIT_L(0); PG8_BAR; PG8_MMA(0, 0, At, B0); PG8_MMA(0, 1, At, B1); PG8_BAR; PG8_SCHED;
            if (!sh) { PG8_LDA(At, 0, 1); } PG8_STAGE(PG8_SB(0, 0), b2, voffB); PG8_STAGE(PG8_SB(0, 1), b2 + hstep, voffB); PG8_STAGE(PG8_SA(0, 0), a2, v2[0]);
            PG8_WAIT_V(8); PG8_WAIT_L(0); PG8_BAR; if (!sh) { PG8_MMA(1, 0, At, B0); PG8_MMA(1, 1, At, B1); } PG8_BAR; PG8_SCHED;
            PG8_LDB(B0, 1, 0); PG8_LDB(B1, 1, 1); PG8_SCHED; PG8_LDA(At, 1, 0); PG8_STAGE(PG8_SA(0, 1), a2, v2[1]);
            PG8_WAIT_V(8); PG8_WAIT_L(0); PG8_BAR; PG8_MMA(0, 0, At, B0); PG8_MMA(0, 1, At, B1); PG8_BAR; PG8_SCHED;
            if (!sh) { PG8_LDA(At, 1, 1); } PG8_STAGE(PG8_SB(1, 0), b3, voffB); PG8_STAGE(PG8_SB(1, 1), b3 + hstep, voffB); PG8_STAGE(PG8_SA(1, 0), a3, v2[0]);
            PG8_WAIT_V(8); PG8_WAIT_L(0); PG8_BAR; if (!sh) { PG8_MMA(1, 0, At, B0); PG8_MMA(1, 1, At, B1); } PG8_BAR; PG8_SCHED;
        }
        if constexpr (ALIGN_EPI) { if (wr == 0) PG8_BAR; }
        E(acc, cur, wr, wc, fr, fq);
        if (!has_next) break;
#pragma unroll
        for (int a = 0; a < 2; ++a)
#pragma unroll
            for (int b = 0; b < 2; ++b)
#pragma unroll
                for (int m = 0; m < 4; ++m)
#pragma unroll
                    for (int n = 0; n < 2; ++n) acc[a][b][m][n] = (f32x4){0.f, 0.f, 0.f, 0.f};
        cur = nxt; cB = nB; ++ui;
#pragma unroll
        for (int h = 0; h < 2; ++h)
#pragma unroll
            for (int i = 0; i < 2; ++i) vc[h][i] = vn[h][i];
        if constexpr (ALIGN_EPI) { if (wr == 1) PG8_BAR; }
    }
    PG8_WAIT_V(0);
    if constexpr (!ALIGN_EPI) { if (wr == 0) PG8_BAR; }
    PG8_BAR;
#undef PG8_SA
#undef PG8_SB
#undef PG8_STAGE
#undef PG8_LDA
#undef PG8_LDB
#undef PG8_MMA
#undef PG8_WAIT_V
#undef PG8_WAIT_L
#undef PG8_BAR
#undef PG8_SCHED
#undef PG8_VOFF
}

struct EpiEvenIn {
    static constexpr bool PERM = true;
    bf16 *U, *GV, *Q, *Kb, *VT;
    __device__ __forceinline__ void operator()(const Acc& acc, const Unit& u, int wr, int wc, int fr, int fq) const {
        const int sel = u.pn >> 1;
        const int row0 = u.pm * BM + wr * 64 + fr;
        const int colt = (u.pn & 1) * BM + wc * 32 + 8 * fq;
        if (sel < 4) {
            bf16* base = sel == 0 ? U : sel == 1 ? GV : sel == 2 ? Q : Kb;
#pragma unroll
            for (int ai = 0; ai < 2; ++ai)
#pragma unroll
                for (int m = 0; m < 4; ++m) { bf16* rowp = base + (size_t)(row0 + ai * HALF + m * 16) * GW + colt;
#pragma unroll
                    for (int bj = 0; bj < 2; ++bj) { f32x4 v0 = acc[ai][bj][m][0], v1 = acc[ai][bj][m][1];
                        if (sel < 2) { f32x2 a = gelu_pk((f32x2){v0[0], v0[1]}), b = gelu_pk((f32x2){v0[2], v0[3]}), c = gelu_pk((f32x2){v1[0], v1[1]}), d = gelu_pk((f32x2){v1[2], v1[3]});
                            v0 = (f32x4){a.x, a.y, b.x, b.y}; v1 = (f32x4){c.x, c.y, d.x, d.y}; }
                        v4u w; w.x = cvt_pk_bf16(v0[0], v0[1]); w.y = cvt_pk_bf16(v0[2], v0[3]); w.z = cvt_pk_bf16(v1[0], v1[1]); w.w = cvt_pk_bf16(v1[2], v1[3]);
                        *(v4u*)(rowp + bj * HALF) = w; } }
        } else {
#pragma unroll
            for (int ai = 0; ai < 2; ++ai)
#pragma unroll
                for (int m = 0; m < 4; ++m) { const int tok = row0 + ai * HALF + m * 16; const int b = tok / SEQ, t = tok % SEQ;
#pragma unroll
                    for (int bj = 0; bj < 2; ++bj) { const int c0 = colt + bj * HALF;
#pragma unroll
                        for (int n = 0; n < 2; ++n)
#pragma unroll
                            for (int j = 0; j < 4; ++j) { const int c = c0 + 4 * n + j;
                                VT[((size_t)(b * NH) * HD + c) * SEQ + t] = (bf16)f2bf(acc[ai][bj][m][n][j]); } } }
        }
    }
};
struct EpiResF32 {
    static constexpr bool PERM = false;
    const float* R; float* X;
    __device__ __forceinline__ void operator()(const Acc& acc, const Unit& u, int wr, int wc, int fr, int fq) const {
        const int row0 = u.pm * BM + wr * 64 + fr, col0 = u.pn * BM + wc * 32 + 4 * fq;
#pragma unroll
        for (int ai = 0; ai < 2; ++ai)
#pragma unroll
            for (int m = 0; m < 4; ++m) { const size_t off = (size_t)(row0 + ai * HALF + m * 16) * D + col0;
#pragma unroll
                for (int bj = 0; bj < 2; ++bj)
#pragma unroll
                    for (int n = 0; n < 2; ++n) { const f32x4 r = *(const f32x4*)(R + off + bj * HALF + n * 16); *(f32x4*)(X + off + bj * HALF + n * 16) = r + acc[ai][bj][m][n]; } }
    }
};
struct EpiMixBf16 {
    static constexpr bool PERM = true;
    bf16* MO;
    __device__ __forceinline__ void operator()(const Acc& acc, const Unit& u, int wr, int wc, int fr, int fq) const {
        const int row0 = u.pm * BM + wr * 64 + fr, col = u.pn * BM + wc * 32 + 8 * fq;
#pragma unroll
        for (int ai = 0; ai < 2; ++ai)
#pragma unroll
            for (int m = 0; m < 4; ++m)
#pragma unroll
                for (int bj = 0; bj < 2; ++bj) { const f32x4 v0 = acc[ai][bj][m][0], v1 = acc[ai][bj][m][1];
                    v4u w; w.x = cvt_pk_bf16(v0[0], v0[1]); w.y = cvt_pk_bf16(v0[2], v0[3]); w.z = cvt_pk_bf16(v1[0], v1[1]); w.w = cvt_pk_bf16(v1[2], v1[3]);
                    *(v4u*)(MO + (size_t)(row0 + ai * HALF + m * 16) * D + col + bj * HALF) = w; }
    }
};
struct EpiOddIn {
    static constexpr bool PERM = true;
    bf16 *Y, *GB;
    __device__ __forceinline__ void operator()(const Acc& acc, const Unit& u, int wr, int wc, int fr, int fq) const {
        const int row0 = u.pm * BM + wr * 64 + fr;
        if (u.pn < 8) {
            const int col = u.pn * HALF + wc * 32 + 8 * fq;
#pragma unroll
            for (int ai = 0; ai < 2; ++ai)
#pragma unroll
                for (int m = 0; m < 4; ++m) { const f32x4 v0 = acc[ai][0][m][0] * acc[ai][1][m][0], v1 = acc[ai][0][m][1] * acc[ai][1][m][1];
                    v4u w; w.x = cvt_pk_bf16(v0[0], v0[1]); w.y = cvt_pk_bf16(v0[2], v0[3]); w.z = cvt_pk_bf16(v1[0], v1[1]); w.w = cvt_pk_bf16(v1[2], v1[3]);
                    *(v4u*)(Y + (size_t)(row0 + ai * HALF + m * 16) * D + col) = w; }
        } else {
            const int col = (u.pn - 8) * BM + wc * 32 + 8 * fq;
#pragma unroll
            for (int ai = 0; ai < 2; ++ai)
#pragma unroll
                for (int m = 0; m < 4; ++m)
#pragma unroll
                    for (int bj = 0; bj < 2; ++bj) { const f32x4 v0 = acc[ai][bj][m][0], v1 = acc[ai][bj][m][1];
                        v4u w; w.x = cvt_pk_bf16(v0[0], v0[1]); w.y = cvt_pk_bf16(v0[2], v0[3]); w.z = cvt_pk_bf16(v1[0], v1[1]); w.w = cvt_pk_bf16(v1[2], v1[3]);
                        *(v4u*)(GB + (size_t)(row0 + ai * HALF + m * 16) * D + col + bj * HALF) = w; }
        }
    }
};
struct EpiMoeUp {
    static constexpr bool PERM = true;
    bf16* HM;
    __device__ __forceinline__ void operator()(const Acc& acc, const Unit& u, int wr, int wc, int fr, int fq) const {
        const int row0 = u.pm * BM + wr * 64 + fr, col = u.pn * HALF + wc * 32 + 8 * fq;
#pragma unroll
        for (int ai = 0; ai < 2; ++ai)
#pragma unroll
            for (int m = 0; m < 4; ++m) { float o[8];
#pragma unroll
                for (int n = 0; n < 2; ++n)
#pragma unroll
                    for (int j = 0; j < 4; ++j) { const float g = acc[ai][0][m][n][j], up = acc[ai][1][m][n][j];
                        o[4 * n + j] = g * __builtin_amdgcn_rcpf(1.0f + __builtin_amdgcn_exp2f(-1.44269504089f * g)) * up; }
                v4u w; w.x = cvt_pk_bf16(o[0], o[1]); w.y = cvt_pk_bf16(o[2], o[3]); w.z = cvt_pk_bf16(o[4], o[5]); w.w = cvt_pk_bf16(o[6], o[7]);
                *(v4u*)(HM + (size_t)(row0 + ai * HALF + m * 16) * FF + col) = w; }
    }
};
struct EpiMoeDown {
    static constexpr bool PERM = true;
    bf16* CONTRIB; const unsigned* list; const float* selw; const LAS int* cnt;
    __device__ __forceinline__ void operator()(const Acc& acc, const Unit& u, int wr, int wc, int fr, int fq) const {
        const int n_e = cnt[u.e]; const unsigned* le = list + (size_t)u.e * LIST_CAP + u.mt * BM; const float* lw = selw + (size_t)u.e * LIST_CAP + u.mt * BM;
        const int col = u.pn * BM + wc * 32 + 8 * fq;
        unsigned ent[2][4]; float wgt[2][4];
#pragma unroll
        for (int ai = 0; ai < 2; ++ai)
#pragma unroll
            for (int m = 0; m < 4; ++m) { const int r = ai * HALF + wr * 64 + m * 16 + fr; ent[ai][m] = le[(u.mt * BM + r < n_e) ? r : 0]; }
#pragma unroll
        for (int ai = 0; ai < 2; ++ai)
#pragma unroll
            for (int m = 0; m < 4; ++m) { const int r = ai * HALF + wr * 64 + m * 16 + fr; wgt[ai][m] = lw[(u.mt * BM + r < n_e) ? r : 0]; }
#pragma unroll
        for (int ai = 0; ai < 2; ++ai)
#pragma unroll
            for (int m = 0; m < 4; ++m) { const int r = ai * HALF + wr * 64 + m * 16 + fr;
                if (u.mt * BM + r < n_e) { const unsigned e = ent[ai][m]; const float w = wgt[ai][m];
                    bf16* rowp = CONTRIB + ((size_t)(e & 1u) * T + (e >> 1)) * D + col;
#pragma unroll
                    for (int bj = 0; bj < 2; ++bj) { const f32x4 v0 = acc[ai][bj][m][0] * w, v1 = acc[ai][bj][m][1] * w;
                        v4u o; o.x = cvt_pk_bf16(v0[0], v0[1]); o.y = cvt_pk_bf16(v0[2], v0[3]); o.z = cvt_pk_bf16(v1[0], v1[1]); o.w = cvt_pk_bf16(v1[2], v1[3]);
                        *(v4u*)(rowp + bj * HALF) = o; } } }
    }
};
}

struct Frame {
    LAS unsigned char* lds;
    volatile LAS unsigned* MISC;
    gu32* ctl;
    int tid, lane, wave, vcu, G;
};

struct TrDesc { const float* W; bf16* WT; int K, N, k0, n0, orow0; };
__device__ __forceinline__ void tr_load(const TrDesc& d, f32x4 (&v)[16], int lane) {
    const int kk = lane >> 4, nq = (lane & 15) * 4;
#pragma unroll
    for (int i = 0; i < 16; ++i) v[i] = __builtin_nontemporal_load((const GAS f32x4*)(d.W + (size_t)(d.k0 + 4 * i + kk) * d.N + d.n0 + nq));
}
__device__ __forceinline__ void tr_finish(const TrDesc& d, const f32x4 (&v)[16], LAS float* scr, int lane) {
    const int kk = lane >> 4, nq = (lane & 15) * 4;
    const int c0 = (nq + 0) ^ kk, c1 = (nq + 1) ^ kk, c2 = (nq + 2) ^ kk, c3 = (nq + 3) ^ kk;
#pragma unroll
    for (int i = 0; i < 16; ++i) { const int k = 4 * i + kk, sw = 8 * (i >> 1); LAS float* row = scr + k * 64;
        row[c0 ^ sw] = v[i].x; row[c1 ^ sw] = v[i].y; row[c2 ^ sw] = v[i].z; row[c3 ^ sw] = v[i].w; }
    LDS_WAIT(); asm volatile("" ::: "memory");
    const int c = lane & 7, nl = lane >> 3;
#pragma unroll
    for (int j = 0; j < 8; ++j) { const int n = nl + 8 * j; const LAS float* s = scr + (8 * c) * 64; const int q0 = n ^ (8 * c), q1 = q0 ^ 1, q2 = q0 ^ 2, q3 = q0 ^ 3;
        v4u o; o.x = pk2(s[0 * 64 + q0], s[1 * 64 + q1]); o.y = pk2(s[2 * 64 + q2], s[3 * 64 + q3]); o.z = pk2(s[4 * 64 + q0], s[5 * 64 + q1]); o.w = pk2(s[6 * 64 + q2], s[7 * 64 + q3]);
        __builtin_nontemporal_store(o, (GAS v4u*)(d.WT + (size_t)(d.orow0 + n) * d.K + d.k0 + 8 * c)); }
    LDS_WAIT(); asm volatile("" ::: "memory");
}
__device__ __forceinline__ void tr_item64(const float* W, int K, int N, bf16* WT, int k0, int n0, int orow0, LAS float* scr, int lane) {
    const TrDesc d{W, WT, K, N, k0, n0, orow0}; f32x4 v[16]; tr_load(d, v, lane); tr_finish(d, v, scr, lane);
}
struct Args;
constexpr int I_IN0 = 16 * (EVEN_IN / 64), I_OUT = 16 * (D / 64), I_IN1 = 16 * (ODD_IN / 64), I_DENSE = I_IN0 + 2 * I_OUT + I_IN1;
constexpr int I_MOE = NEXP * 384;
__device__ __forceinline__ void norm_row(int lane, const float* xrow, const bf16* mo, const bf16* c0, const bf16* c1, const float* gain, float* xs, bf16* ob, float* of32) {
    const GAS f32x4* xr = (const GAS f32x4*)xrow + lane;
    f32x4 v[4]; float s = 0.f;
#pragma unroll
    for (int j = 0; j < 4; ++j) v[j] = xr[64 * j];
    if (mo) {
#pragma unroll
        for (int j = 0; j < 4; ++j) { const v2u a = *((const GAS v2u*)mo + lane + 64 * j); v[j].x += bf_lo(a.x); v[j].y += bf_hi(a.x); v[j].z += bf_lo(a.y); v[j].w += bf_hi(a.y); }
    }
    if (c0) {
#pragma unroll
        for (int j = 0; j < 4; ++j) { const v2u a = *((const GAS v2u*)c0 + lane + 64 * j), b = *((const GAS v2u*)c1 + lane + 64 * j);
            v[j].x += bf_lo(a.x) + bf_lo(b.x); v[j].y += bf_hi(a.x) + bf_hi(b.x); v[j].z += bf_lo(a.y) + bf_lo(b.y); v[j].w += bf_hi(a.y) + bf_hi(b.y); }
    }
#pragma unroll
    for (int j = 0; j < 4; ++j) s += (v[j].x * v[j].x + v[j].y * v[j].y) + (v[j].z * v[j].z + v[j].w * v[j].w);
    if (xs) {
#pragma unroll
        for (int j = 0; j < 4; ++j) *((GAS f32x4*)xs + lane + 64 * j) = v[j]; }
    const float rstd = rsqrtf(wave_sum(s) * (1.f / D) + EPS);
#pragma unroll
    for (int j = 0; j < 4; ++j) { const f32x4 g = *((const GAS f32x4*)gain + lane + 64 * j); v[j] = v[j] * rstd * g; }
    if (ob) {
#pragma unroll
        for (int j = 0; j < 4; ++j) { v2u o; o.x = pk2(v[j].x, v[j].y); o.y = pk2(v[j].z, v[j].w); *((GAS v2u*)ob + lane + 64 * j) = o; } }
    if (of32) {
#pragma unroll
        for (int j = 0; j < 4; ++j) *((GAS f32x4*)of32 + lane + 64 * j) = v[j]; }
}

struct Args { const float* in[17]; float* out; unsigned char* ws; unsigned mask; int single; };

__device__ __forceinline__ void conv_dense_item(const Args& a, int r, LAS float* scr, int lane) {
    unsigned char* ws = a.ws;
    if (r < I_IN0) { const int nb = EVEN_IN / 64; tr_item64(a.in[1], D, EVEN_IN, (bf16*)(ws + WS_WIN0), 64 * (r / nb), 64 * (r % nb), 64 * (r % nb), scr, lane); return; } r -= I_IN0;
    if (r < I_OUT) { const int nb = D / 64; tr_item64(a.in[2], D, D, (bf16*)(ws + WS_WOUT0), 64 * (r / nb), 64 * (r % nb), 64 * (r % nb), scr, lane); return; } r -= I_OUT;
    if (r < I_IN1) { const int nb = ODD_IN / 64; const int n0 = 64 * (r % nb);
        const int sec = n0 / D, c = n0 % D; const int orow = sec == 0 ? 2048 + c : 256 * (c / 128) + (sec == 2 ? 128 : 0) + (c % 128);
        tr_item64(a.in[6], D, ODD_IN, (bf16*)(ws + WS_WIN1), 64 * (r / nb), n0, orow, scr, lane); return; } r -= I_IN1;
    { const int nb = D / 64; tr_item64(a.in[8], D, D, (bf16*)(ws + WS_WOUT1), 64 * (r / nb), 64 * (r % nb), 64 * (r % nb), scr, lane); }
}
__device__ __forceinline__ TrDesc moe_item_desc(const Args& a, int layer, int q) {
    unsigned char* ws = a.ws;
    const int le = layer * NEXP + q / 384; int r = q % 384;
    if (r < 256) { const int up = r >= 128; if (up) r -= 128; const int n0 = 64 * (r % 8);
        const float* W = (up ? a.in[14] : a.in[13]) + (size_t)le * D * FF;
        return TrDesc{W, (bf16*)(ws + WS_WGU) + (size_t)le * 1024 * D, D, FF, 64 * (r / 8), n0, 256 * (n0 / 128) + (up ? 128 : 0) + (n0 % 128)}; }
    r -= 256;
    return TrDesc{a.in[15] + (size_t)le * FF * D, (bf16*)(ws + WS_WD) + (size_t)le * D * FF, FF, D, 64 * (r / 16), 64 * (r % 16), 64 * (r % 16)};
}
__device__ __forceinline__ void conv_moe_range(const Args& a, LAS unsigned char* lds, int wave, int lane, int layer, int first, int last, int widx, int nw) {
    LAS float* scr = (LAS float*)(lds + wave * 16384);
    int q = first + widx;
    if (q >= last) return;
    TrDesc d0 = moe_item_desc(a, layer, q), d1 = d0; f32x4 v0[16], v1[16];
    tr_load(d0, v0, lane);
    for (;;) {
        const int q1 = q + nw; const bool h1 = q1 < last;
        if (h1) { d1 = moe_item_desc(a, layer, q1); tr_load(d1, v1, lane); }
        tr_finish(d0, v0, scr, lane);
        if (!h1) break;
        const int q2 = q1 + nw; const bool h2 = q2 < last;
        if (h2) { d0 = moe_item_desc(a, layer, q2); tr_load(d0, v0, lane); }
        tr_finish(d1, v1, scr, lane);
        if (!h2) break;
        q = q2;
    }
}
constexpr int L0_P0 = 0, L1_P0 = 0;

__device__ __forceinline__ void phase_prologue(Frame& F, const Args& a, int l0_last) {
    LAS float* scr = (LAS float*)(F.lds + F.wave * 16384);
    const int gw = F.vcu * NWAVES + F.wave, NGW = F.G * NWAVES;
    unsigned char* ws = a.ws;
#ifdef TS_A
#define PSTAMP(k) do { if (blockIdx.x == 0 && F.tid == 0) __hip_atomic_store(F.ctl + CW_TS + (k), (unsigned)__builtin_amdgcn_s_memrealtime(), RLX_AGENT); } while (0)
#else
#define PSTAMP(k) do { } while (0)
#endif
    for (int m = gw; m < T; m += NGW) norm_row(F.lane, a.in[0] + (size_t)m * D, nullptr, nullptr, nullptr, a.in[9], nullptr, (bf16*)(ws + WS_H) + (size_t)m * D, nullptr);
    PSTAMP(53);
    for (int it = gw; it < I_DENSE; it += NGW) conv_dense_item(a, it, scr, F.lane);
    PSTAMP(50);
    conv_moe_range(a, F.lds, F.wave, F.lane, 0, 0, l0_last, gw, NGW);
    PSTAMP(51);
    { const float* wsrc = a.in[3]; bf16* wt = (bf16*)(ws + WS_WTRIL);
      for (int i = (F.vcu * 512 + F.tid) * 4; i < NG * CHUNK * CHUNK; i += F.G * 512 * 4) { const int t = (i / CHUNK) % CHUNK, s = i % CHUNK; const f32x4 v = *(const f32x4*)(wsrc + i);
          v2u o; o.x = pk2(s <= t ? v.x : 0.f, s + 1 <= t ? v.y : 0.f); o.y = pk2(s + 2 <= t ? v.z : 0.f, s + 3 <= t ? v.w : 0.f); *(v2u*)(wt + i) = o; } }
    { bf16* wr = (bf16*)(ws + WS_WR);
      for (int i = F.vcu * 512 + F.tid; i < 2 * 48 * D; i += F.G * 512) { const int k = i % D, c = (i / D) % 48, l = i / (48 * D);
          float w = 0.f;
          if (c < NGRP) w = a.in[11][((size_t)l * D + k) * NGRP + c];
          else if (c < NGRP + NEXP) { const int g = (c - NGRP) / EPG, e = (c - NGRP) % EPG; w = a.in[12][(((size_t)l * NGRP + g) * D + k) * EPG + e]; }
          w *= a.in[10][l * D + k];
          const unsigned hi = f2bf(w); const float rem = w - __builtin_bit_cast(float, hi << 16);
          wr[((size_t)(l * 2 + 0) * 48 + c) * D + k] = (bf16)hi; wr[((size_t)(l * 2 + 1) * 48 + c) * D + k] = (bf16)f2bf(rem); } }
    PSTAMP(52);
}

__device__ __forceinline__ void gmlp_unit(Frame& F, const Args& a, int unit) {
    unsigned char* ws = a.ws;
    const bf16* U = (const bf16*)(ws + WS_ACT); const bf16* GV = U + (size_t)T * GW; const bf16* WT = (const bf16*)(ws + WS_WTRIL); bf16* MIX = (bf16*)(ws + WS_MIX);
    const int g = unit % NG, n = (unit / NG) % (SEQ / CHUNK), b = unit / (NG * (SEQ / CHUNK));
    const int tok0 = b * SEQ + n * CHUNK;
    constexpr int VSTR = 136;
    LAS bf16* vnT = (LAS bf16*)F.lds;
    { const int s = F.tid >> 2, cg = F.tid & 3;
      const v4u r0 = *(const v4u*)(GV + (size_t)(tok0 + s) * GW + g * GD + 16 * cg), r1 = *(const v4u*)(GV + (size_t)(tok0 + s) * GW + g * GD + 16 * cg + 8);
      float v[16]; const unsigned w[8] = {r0.x, r0.y, r0.z, r0.w, r1.x, r1.y, r1.z, r1.w};
#pragma unroll
      for (int i = 0; i < 8; ++i) { v[2 * i] = bf_lo(w[i]); v[2 * i + 1] = bf_hi(w[i]); }
      float ss = 0.f;
#pragma unroll
      for (int i = 0; i < 16; ++i) ss += v[i] * v[i];
      ss += __shfl_xor(ss, 1); ss += __shfl_xor(ss, 2);
      const float rstd = rsqrtf(ss * (1.0f / GD) + EPS);
      const float* gn = a.in[5] + g * GD + 16 * cg;
#pragma unroll
      for (int i = 0; i < 16; ++i) vnT[(16 * cg + i) * VSTR + s] = (bf16)f2bf(v[i] * rstd * gn[i]); }
    __syncthreads();
    { const int db = F.wave & 1, tb = F.wave >> 1, r = F.lane & 31, h = F.lane >> 5;
      f32x16 x;
_Pragma("unroll") for (int i = 0; i < 16; ++i) x[i] = 0.f;
      const bf16* wrow = WT + ((size_t)g * CHUNK + 32 * tb + r) * CHUNK + 8 * h;
      const LAS bf16* vrow = vnT + (32 * db + r) * VSTR + 8 * h;
      for (int kk = 0; kk < 2 * (tb + 1); ++kk) {
          const bf16x8 av = *(const LAS bf16x8*)(vrow + 16 * kk);
          const bf16x8 bw = *(const bf16x8*)(wrow + 16 * kk);
          x = __builtin_amdgcn_mfma_f32_32x32x16_bf16(av, bw, x, 0, 0, 0);
      }
      const int t = 32 * tb + r; const float bias = a.in[4][g * CHUNK + t];
      const bf16* urow = U + (size_t)(tok0 + t) * GW + g * GD + 32 * db + 4 * h; bf16* orow = MIX + (size_t)(tok0 + t) * D + g * GD + 32 * db + 4 * h;
#pragma unroll
      for (int q = 0; q < 4; ++q) { const v2u uu = *(const v2u*)(urow + 8 * q);
          v2u o; o.x = pk2(bf_lo(uu.x) * (x[4 * q] + bias), bf_hi(uu.x) * (x[4 * q + 1] + bias)); o.y = pk2(bf_lo(uu.y) * (x[4 * q + 2] + bias), bf_hi(uu.y) * (x[4 * q + 3] + bias));
          *(v2u*)(orow + 8 * q) = o; } }
    __syncthreads();
}

template <bool DIAG>
__device__ __forceinline__ void sb_tile(const f32x16& s, float& carry, bf16x8& p0, bf16x8& p1, int r, int hh) {
    float l[16], lk[16];
#pragma unroll
    for (int i = 0; i < 16; ++i) {
        const float n = fminf(s[i] * (-0.125f * 1.44269504089f), 126.0f);
        const float e = __builtin_amdgcn_exp2f(n);
        l[i] = __builtin_amdgcn_logf(1.0f + e);
        lk[i] = n - l[i];
        if (DIAG) { const int key = 16 * (i >> 3) + 8 * hh + (i & 7); if (key >= r) lk[i] = 0.f; }
    }
    float suf[16]; float run0 = 0.f, run1 = 0.f;
#pragma unroll
    for (int j = 7; j >= 0; --j) { suf[j] = run0; run0 += lk[j]; suf[8 + j] = run1; run1 += lk[8 + j]; }
    const float o0 = __shfl_xor(run0, 32), o1 = __shfl_xor(run1, 32);
    const float afterA = hh == 0 ? (o0 + run1 + o1) : (o1 + run1);
    const float afterB = hh == 0 ? o1 : 0.f;
    float pa[16];
#pragma unroll
    for (int i = 0; i < 16; ++i) {
        const float arg = carry + (i < 8 ? afterA : afterB) + suf[i] - l[i];
        pa[i] = __builtin_amdgcn_exp2f(arg);
        if (DIAG) { const int key = 16 * (i >> 3) + 8 * hh + (i & 7); if (key >= r) pa[i] = 0.f; }
    }
    carry += (run0 + run1) + (o0 + o1);
    v4u w0, w1;
    w0.x = cvt_pk_bf16(pa[0], pa[1]); w0.y = cvt_pk_bf16(pa[2], pa[3]); w0.z = cvt_pk_bf16(pa[4], pa[5]); w0.w = cvt_pk_bf16(pa[6], pa[7]);
    w1.x = cvt_pk_bf16(pa[8], pa[9]); w1.y = cvt_pk_bf16(pa[10], pa[11]); w1.z = cvt_pk_bf16(pa[12], pa[13]); w1.w = cvt_pk_bf16(pa[14], pa[15]);
    p0 = __builtin_bit_cast(bf16x8, w0); p1 = __builtin_bit_cast(bf16x8, w1);
}
__device__ __forceinline__ void sb_task(const Args& a, int lane, int bh, int qblk) {
    unsigned char* ws = a.ws;
    const bf16* Q = (const bf16*)(ws + WS_ACT) + (size_t)2 * T * GW; const bf16* Kb = Q + (size_t)T * SBW; const bf16* VT = Kb + (size_t)T * SBW; bf16* MIX = (bf16*)(ws + WS_MIX);
    const int b = bh / NH, h = bh % NH, r = lane & 31, hh = lane >> 5;
    const int q0 = qblk * 32;
    const int kap = (r & ~12) | ((r & 4) << 1) | ((r & 8) >> 1);
    bf16x8 qf[4];
    { const bf16* qp = Q + (size_t)(b * SEQ + q0 + r) * SBW + h * HD + 8 * hh;
#pragma unroll
      for (int kk = 0; kk < 4; ++kk) qf[kk] = *(const bf16x8*)(qp + 16 * kk); }
    const bf16* kbase = Kb + (size_t)(b * SEQ + kap) * SBW + h * HD + 8 * hh;
    const bf16* vbase = VT + ((size_t)bh * HD + r) * SEQ + 8 * hh;
    f32x16 o0, o1;
_Pragma("unroll") for (int i = 0; i < 16; ++i) { o0[i] = 0.f; o1[i] = 0.f; }
    float carry = 0.f;
    bf16x8 kf[4], vf[2][2];
    int k0 = q0;
#pragma unroll
    for (int kk = 0; kk < 4; ++kk) kf[kk] = *(const bf16x8*)(kbase + (size_t)k0 * SBW + 16 * kk);
#pragma unroll
    for (int db = 0; db < 2; ++db)
#pragma unroll
        for (int s = 0; s < 2; ++s) vf[db][s] = *(const bf16x8*)(vbase + (size_t)(32 * db) * SEQ + k0 + 16 * s);
    bool diag = true;
    for (;;) {
        f32x16 sc;
_Pragma("unroll") for (int i = 0; i < 16; ++i) sc[i] = 0.f;
#pragma unroll
        for (int kk = 0; kk < 4; ++kk) sc = __builtin_amdgcn_mfma_f32_32x32x16_bf16(kf[kk], qf[kk], sc, 0, 0, 0);
        bf16x8 vcur[2][2];
#pragma unroll
        for (int db = 0; db < 2; ++db)
#pragma unroll
            for (int s = 0; s < 2; ++s) vcur[db][s] = vf[db][s];
        const int kn = k0 - 32;
        if (kn >= 0) {
#pragma unroll
            for (int kk = 0; kk < 4; ++kk) kf[kk] = *(const bf16x8*)(kbase + (size_t)kn * SBW + 16 * kk);
#pragma unroll
            for (int db = 0; db < 2; ++db)
#pragma unroll
                for (int s = 0; s < 2; ++s) vf[db][s] = *(const bf16x8*)(vbase + (size_t)(32 * db) * SEQ + kn + 16 * s);
        }
        bf16x8 p0, p1;
        if (diag) sb_tile<true>(sc, carry, p0, p1, r, hh); else sb_tile<false>(sc, carry, p0, p1, r, hh);
        diag = false;
        o0 = __builtin_amdgcn_mfma_f32_32x32x16_bf16(vcur[0][0], p0, o0, 0, 0, 0);
        o0 = __builtin_amdgcn_mfma_f32_32x32x16_bf16(vcur[0][1], p1, o0, 0, 0, 0);
        o1 = __builtin_amdgcn_mfma_f32_32x32x16_bf16(vcur[1][0], p0, o1, 0, 0, 0);
        o1 = __builtin_amdgcn_mfma_f32_32x32x16_bf16(vcur[1][1], p1, o1, 0, 0, 0);
        if (kn < 0) break;
        if (__all(carry < -150.0f)) break;
        k0 = kn;
    }
    bf16* orow = MIX + (size_t)(b * SEQ + q0 + r) * D + GW + h * HD + 4 * hh;
#pragma unroll
    for (int q = 0; q < 4; ++q) {
        v2u w; w.x = cvt_pk_bf16(o0[4 * q], o0[4 * q + 1]); w.y = cvt_pk_bf16(o0[4 * q + 2], o0[4 * q + 3]); *(v2u*)(orow + 8 * q) = w;
        v2u w2; w2.x = cvt_pk_bf16(o1[4 * q], o1[4 * q + 1]); w2.y = cvt_pk_bf16(o1[4 * q + 2], o1[4 * q + 3]); *(v2u*)(orow + 32 + 8 * q) = w2;
    }
}

struct RouteW { bf16x8 w[3][4][2]; };
__device__ __forceinline__ void route_load_w(RouteW& R, const Args& a, int layer, int wave, int lane) {
    const int fr = lane & 15, fq = lane >> 4;
    const bf16* wh = (const bf16*)(a.ws + WS_WR) + ((size_t)(layer * 2) * 48 + fr) * D + 128 * wave + 8 * fq;
#pragma unroll
    for (int cb = 0; cb < 3; ++cb)
#pragma unroll
        for (int s = 0; s < 4; ++s)
#pragma unroll
            for (int p = 0; p < 2; ++p) R.w[cb][s][p] = *(const bf16x8*)(wh + ((size_t)p * 48 + 16 * cb) * D + 32 * s);
}
__device__ __forceinline__ void route_round(const RouteW& R, const Args& a, LAS unsigned char* lds, int tid, int wave, int lane, int layer, int tok0, const float* X, const bf16* MO, bf16* H, unsigned* cntw, unsigned* list, float* selw) {
    LAS float* plog = (LAS float*)lds;
    LAS float* psq = (LAS float*)(lds + 49152);
    LAS float* lgf = (LAS float*)(lds + 49152 + 1024);
    LAS float* rs = (LAS float*)(lds + 49152 + 1024 + 6144);
    volatile LAS unsigned* hist = (volatile LAS unsigned*)(lds + 49152 + 1024 + 6144 + 128);
    const int fr = lane & 15, fq = lane >> 4;
    if (tid < 64) hist[tid] = 0u;
    f32x4 xp[2][4], xq[2][4]; v4u mo[2][4];
#pragma unroll
    for (int mt = 0; mt < 2; ++mt)
#pragma unroll
        for (int s = 0; s < 4; ++s) { const size_t o = (size_t)(tok0 + 16 * mt + fr) * D + 128 * wave + 32 * s + 8 * fq; xp[mt][s] = *(const f32x4*)(X + o); xq[mt][s] = *(const f32x4*)(X + o + 4); mo[mt][s] = *(const v4u*)(MO + o); }
#pragma unroll
    for (int mt = 0; mt < 2; ++mt)
#pragma unroll
        for (int s = 0; s < 4; ++s) { const v4u m = mo[mt][s]; xp[mt][s] += (f32x4){bf_lo(m.x), bf_hi(m.x), bf_lo(m.y), bf_hi(m.y)}; xq[mt][s] += (f32x4){bf_lo(m.z), bf_hi(m.z), bf_lo(m.w), bf_hi(m.w)}; }
#pragma unroll
    for (int mt = 0; mt < 2; ++mt) {
        f32x4 acc[3]; float ss = 0.f;
#pragma unroll
        for (int cb = 0; cb < 3; ++cb) acc[cb] = (f32x4){0.f, 0.f, 0.f, 0.f};
#pragma unroll
        for (int s = 0; s < 4; ++s) { const f32x4 p = xp[mt][s], q = xq[mt][s];
            ss += (p.x * p.x + p.y * p.y) + (p.z * p.z + p.w * p.w) + (q.x * q.x + q.y * q.y) + (q.z * q.z + q.w * q.w);
            v4u hi; hi.x = cvt_pk_bf16(p.x, p.y); hi.y = cvt_pk_bf16(p.z, p.w); hi.z = cvt_pk_bf16(q.x, q.y); hi.w = cvt_pk_bf16(q.z, q.w);
            v4u lo; lo.x = cvt_pk_bf16(p.x - bf_lo(hi.x), p.y - bf_hi(hi.x)); lo.y = cvt_pk_bf16(p.z - bf_lo(hi.y), p.w - bf_hi(hi.y));
            lo.z = cvt_pk_bf16(q.x - bf_lo(hi.z), q.y - bf_hi(hi.z)); lo.w = cvt_pk_bf16(q.z - bf_lo(hi.w), q.w - bf_hi(hi.w));
            const bf16x8 xh = __builtin_bit_cast(bf16x8, hi), xl = __builtin_bit_cast(bf16x8, lo);
#pragma unroll
            for (int cb = 0; cb < 3; ++cb) {
                acc[cb] = __builtin_amdgcn_mfma_f32_16x16x32_bf16(R.w[cb][s][0], xh, acc[cb], 0, 0, 0);
                acc[cb] = __builtin_amdgcn_mfma_f32_16x16x32_bf16(R.w[cb][s][1], xh, acc[cb], 0, 0, 0);
                acc[cb] = __builtin_amdgcn_mfma_f32_16x16x32_bf16(R.w[cb][s][0], xl, acc[cb], 0, 0, 0);
            } }
        ss += __shfl_xor(ss, 16); ss += __shfl_xor(ss, 32);
#pragma unroll
        for (int cb = 0; cb < 3; ++cb) *(LAS f32x4*)(plog + (wave * 32 + 16 * mt + fr) * 48 + 16 * cb + 4 * fq) = acc[cb];
        if (fq == 0) psq[wave * 32 + 16 * mt + fr] = ss;
    }
    __syncthreads();
    { const int t = tid >> 4, c0 = 3 * (tid & 15);
      float q = 0.f, l0 = 0.f, l1 = 0.f, l2 = 0.f;
#pragma unroll
      for (int w = 0; w < 8; ++w) { q += psq[w * 32 + t]; const LAS float* pl = plog + (w * 32 + t) * 48 + c0; l0 += pl[0]; l1 += pl[1]; l2 += pl[2]; }
      const float rstd = rsqrtf(q * (1.f / D) + EPS);
      lgf[t * 48 + c0] = l0 * rstd; lgf[t * 48 + c0 + 1] = l1 * rstd; lgf[t * 48 + c0 + 2] = l2 * rstd;
      if ((tid & 15) == 0) rs[t] = rstd; }
    __syncthreads();
    int ea = 0, eb = 0; unsigned ra = 0, rb = 0; float wa_ = 0.f, wb_ = 0.f;
    if (tid < 32) {
        const LAS float* my = lgf + tid * 48;
        float gl[4];
#pragma unroll
        for (int g = 0; g < NGRP; ++g) gl[g] = my[g];
        int tg = 0; float mx = gl[0];
#pragma unroll
        for (int g = 1; g < NGRP; ++g) if (gl[g] > mx) { mx = gl[g]; tg = g; }
        float den = 0.f;
#pragma unroll
        for (int g = 0; g < NGRP; ++g) den += __expf(gl[g] - mx);
        const float top_gp = 1.0f / den;
        float el[8];
#pragma unroll
        for (int e = 0; e < EPG; ++e) el[e] = my[NGRP + 8 * tg + e];
        int e0 = 0; float l0 = el[0];
#pragma unroll
        for (int e = 1; e < EPG; ++e) if (el[e] > l0) { l0 = el[e]; e0 = e; }
        int e1 = 0; float l1 = -INFINITY;
#pragma unroll
        for (int e = 0; e < EPG; ++e) if (e != e0 && el[e] > l1) { l1 = el[e]; e1 = e; }
        const float p1 = __expf(l1 - l0), inv = 1.0f / (1.0f + p1);
        ea = tg * EPG + e0; eb = tg * EPG + e1; wa_ = top_gp * inv; wb_ = top_gp * p1 * inv;
        ra = __hip_atomic_fetch_add((LAS unsigned*)hist + ea, 1u, __ATOMIC_RELAXED, __HIP_MEMORY_SCOPE_WORKGROUP);
        rb = __hip_atomic_fetch_add((LAS unsigned*)hist + eb, 1u, __ATOMIC_RELAXED, __HIP_MEMORY_SCOPE_WORKGROUP);
    }
    { const float* gain = a.in[10] + layer * D + 128 * wave + 8 * fq;
#pragma unroll
      for (int s = 0; s < 4; ++s) { const f32x4 gp = *(const f32x4*)(gain + 32 * s), gq = *(const f32x4*)(gain + 32 * s + 4);
#pragma unroll
          for (int mt = 0; mt < 2; ++mt) { const float r = rs[16 * mt + fr]; const f32x4 hp = xp[mt][s] * r * gp, hq = xq[mt][s] * r * gq;
              v4u hi; hi.x = cvt_pk_bf16(hp.x, hp.y); hi.y = cvt_pk_bf16(hp.z, hp.w); hi.z = cvt_pk_bf16(hq.x, hq.y); hi.w = cvt_pk_bf16(hq.z, hq.w);
              *(v4u*)(H + (size_t)(tok0 + 16 * mt + fr) * D + 128 * wave + 32 * s + 8 * fq) = hi; } } }
    __syncthreads();
    if (tid < NEXP) { const unsigned c = hist[tid]; if (c) hist[32 + tid] = __hip_atomic_fetch_add(cntw + (layer * NEXP + tid) * 64, c, RLX_AGENT); }
    __syncthreads();
    if (tid < 32) {
        const int t = tok0 + tid;
        const size_t pa_ = (size_t)ea * LIST_CAP + hist[32 + ea] + ra, pb_ = (size_t)eb * LIST_CAP + hist[32 + eb] + rb;
        list[pa_] = (unsigned)(t * 2); list[pb_] = (unsigned)(t * 2 + 1); selw[pa_] = wa_; selw[pb_] = wb_;
    }
    __syncthreads();
}

__device__ __forceinline__ void moe_tables(Frame& F, int layer) {
    volatile LAS int* cnt = (volatile LAS int*)(F.lds + LDSCTL_OFF);
    volatile LAS int* tst = cnt + 32;
    if (F.tid < NEXP) cnt[F.tid] = (int)__hip_atomic_load(F.ctl + CW_CNT + (layer * NEXP + F.tid) * 64, RLX_AGENT);
    __syncthreads();
    if (F.tid == 0) { int acc = 0; for (int e = 0; e < NEXP; ++e) { tst[e] = acc; acc += (cnt[e] + 255) >> 8; } tst[NEXP] = acc; }
    __syncthreads();
}

__device__ __forceinline__ void conv_phase(Frame& F, const Args& a) {
    unsigned char* ws = a.ws;
    const bf16* Y = (const bf16*)(ws + WS_ACT); const bf16* GB = Y + (size_t)T * D; bf16* MIX = (bf16*)(ws + WS_MIX);
    const float* cw = a.in[7];
    for (int it = F.vcu * 512 + F.tid; it < (T / 16) * (D / 8); it += F.G * 512) {
        const int cg = it % (D / 8), tb = it / (D / 8), c0 = cg * 8, tok0 = tb * 16;
        float w0[8], w1[8], w2[8];
#pragma unroll
        for (int j = 0; j < 8; ++j) { w0[j] = cw[c0 + j]; w1[j] = cw[D + c0 + j]; w2[j] = cw[2 * D + c0 + j]; }
        float ym2[8], ym1[8];
        const bool first = (tok0 % SEQ) == 0;
        { v4u r1 = {0, 0, 0, 0}, r2 = {0, 0, 0, 0};
          if (!first) { r2 = *(const v4u*)(Y + (size_t)(tok0 - 2) * D + c0); r1 = *(const v4u*)(Y + (size_t)(tok0 - 1) * D + c0); }
          const unsigned a2[4] = {r2.x, r2.y, r2.z, r2.w}, a1[4] = {r1.x, r1.y, r1.z, r1.w};
#pragma unroll
          for (int j = 0; j < 4; ++j) { ym2[2 * j] = bf_lo(a2[j]); ym2[2 * j + 1] = bf_hi(a2[j]); ym1[2 * j] = bf_lo(a1[j]); ym1[2 * j + 1] = bf_hi(a1[j]); } }
#pragma unroll 4
        for (int t = 0; t < 16; ++t) {
            const v4u ry = *(const v4u*)(Y + (size_t)(tok0 + t) * D + c0), rg = *(const v4u*)(GB + (size_t)(tok0 + t) * D + c0);
            const unsigned ay[4] = {ry.x, ry.y, ry.z, ry.w}, ag[4] = {rg.x, rg.y, rg.z, rg.w};
            float y[8], o[8];
#pragma unroll
            for (int j = 0; j < 4; ++j) { y[2 * j] = bf_lo(ay[j]); y[2 * j + 1] = bf_hi(ay[j]); }
#pragma unroll
            for (int j = 0; j < 8; ++j) { const float gbv = (j & 1) ? bf_hi(ag[j >> 1]) : bf_lo(ag[j >> 1]); o[j] = gbv * (w0[j] * ym2[j] + w1[j] * ym1[j] + w2[j] * y[j]); ym2[j] = ym1[j]; ym1[j] = y[j]; }
            v4u w; w.x = pk2(o[0], o[1]); w.y = pk2(o[2], o[3]); w.z = pk2(o[4], o[5]); w.w = pk2(o[6], o[7]);
            *(v4u*)(MIX + (size_t)(tok0 + t) * D + c0) = w;
        }
    }
}

constexpr int NPHASE = 15;
__global__ void __launch_bounds__(NWAVES * 64, 2) mk_fwd(Args args) {
    extern __shared__ __attribute__((aligned(16))) unsigned char lds[];
    Frame F;
    F.lds = (LAS unsigned char*)lds;
    F.MISC = (volatile LAS unsigned*)(F.lds + MISC_OFF);
    F.tid = threadIdx.x; F.lane = F.tid & 63; F.wave = __builtin_amdgcn_readfirstlane(F.tid >> 6);
    F.G = gridDim.x; { const int bx = blockIdx.x; F.vcu = (F.G % 8 == 0) ? (bx % 8) * (F.G / 8) + bx / 8 : bx; }
    unsigned char* ws = args.ws;
    F.ctl = (gu32*)(ws + WS_CTL);
#ifdef TS_FIXED
    const unsigned long long t_start_ = __builtin_amdgcn_s_memrealtime();
#endif
#ifdef TS_A
    if (blockIdx.x == 0 && threadIdx.x == 0) __hip_atomic_store(F.ctl + CW_TS + 45, (unsigned)__builtin_amdgcn_s_memrealtime(), RLX_AGENT);
#endif
    for (int u = F.tid; u < (LDS_BYTES - LDSCTL_OFF) / 4; u += NWAVES * 64) ((LAS unsigned*)(F.lds + LDSCTL_OFF))[u] = 0u;
    __syncthreads();
    XcdBarrier bar; bar.bar = (unsigned*)(F.ctl + CW_BAR); bar.x = 0; bar.st = nullptr;
    if (args.single) bar = xcd_barrier_post((unsigned*)(F.ctl + CW_BAR), F.MISC + 8);
    const unsigned mask = args.mask;
#ifndef PHCT
#define PHCT 0x7fffu
#endif
#define RUN(k) (((PHCT >> (k)) & 1u) && ((mask >> (k)) & 1u))
#define SEAM(k) do { STAMP(3 * (k) + 1); if (args.single && (k) + 1 < NPHASE) xcd_barrier(bar); STAMP(3 * (k) + 2); } while (0)
#ifndef REPEAT
#define REPEAT (-1)
#endif
#ifdef TS_A
#ifndef TS_BLOCK
#define TS_BLOCK 0
#endif
#define STAMP(k) do { if (blockIdx.x == (TS_BLOCK) && F.tid == 0) __hip_atomic_store(F.ctl + CW_TS + (k), (unsigned)__builtin_amdgcn_s_memrealtime(), RLX_AGENT); } while (0)
#else
#define STAMP(k) do { } while (0)
#endif
#ifndef RMODE
#define RMODE 0
#endif
#define REPS(k) for (int rep_ = 0; rep_ < ((REPEAT) == (k) ? 2 : 1); ++rep_)
    const LAS int* cntL = (const LAS int*)(F.lds + LDSCTL_OFF); const LAS int* tstL = cntL + 32;
    bf16* const Hb = (bf16*)(ws + WS_H); bf16* const ACT = (bf16*)(ws + WS_ACT); bf16* const MIXb = (bf16*)(ws + WS_MIX); float* const Xf = (float*)(ws + WS_X);
    bf16* const MOb = (bf16*)(ws + WS_ACT + 40 * MiB);
    bf16* const CONTRIB = (bf16*)(ws + WS_CONTRIB); unsigned* const LIST = (unsigned*)(ws + WS_LIST); float* const SELW = (float*)(ws + WS_SELW);
    const int gw = F.vcu * NWAVES + F.wave, NGW = F.G * NWAVES;

    STAMP(46);
#ifdef TS_SKEW
    if (F.tid == 0) { const unsigned t = (unsigned)__builtin_amdgcn_s_memrealtime(); __hip_atomic_fetch_max(F.ctl + CW_TS + 60, ~t, RLX_AGENT); __hip_atomic_fetch_max(F.ctl + CW_TS + 61, t, RLX_AGENT); }
#endif
    const int GEMM_G = (F.G == 256) ? 128 : F.G;
    const bool conv_wg = (int)blockIdx.x >= GEMM_G; const int cwi = ((int)blockIdx.x - GEMM_G) * NWAVES + F.wave, ncw = (F.G - GEMM_G) * NWAVES;
    if (RUN(0)) REPS(0) { phase_prologue(F, args, GEMM_G == F.G ? 2 * I_MOE : 0); SEAM(0); }
    if (RUN(1)) REPS(1) {
        if (!conv_wg) {
#ifdef P1_CONV_ONLY_REP
        if (rep_ == 0)
#endif
        {
        pg8::DenseOrder S; S.init(T, EVEN_IN, D, (const bf16*)(ws + WS_WIN0), GEMM_G, (int)blockIdx.x);
        pg8::EpiEvenIn E{ACT, ACT + (size_t)T * GW, ACT + (size_t)2 * T * GW, ACT + (size_t)3 * T * GW, ACT + (size_t)4 * T * GW};
        pg8::gemm_phase<pg8::EpiEvenIn, pg8::DenseOrder, true>(F.lds, Hb, D, S, E);
        }
        } else { conv_moe_range(args, F.lds, F.wave, F.lane, 0, 0, 2 * I_MOE, cwi, ncw); }
        SEAM(1);
    }
#ifdef PROBE_CONV
    if (RUN(1)) { if (conv_wg) { conv_moe_range(args, F.lds, F.wave, F.lane, 0, L0_P0, I_MOE, cwi, ncw); } if (args.single) xcd_barrier(bar); }
#endif
    if (RUN(2)) REPS(2) {
        for (int u = F.vcu; u < BATCH * (SEQ / CHUNK) * NG; u += F.G) gmlp_unit(F, args, u);
        for (int t = gw; t < 2 * 2048; t += NGW) {
            const int rnd = t >> 11, tt = t & 2047; const int bh = (tt >> 6) + 32 * rnd, qb = tt & 63;
            sb_task(args, F.lane, bh, rnd ? 63 - qb : qb);
        }
        SEAM(2);
    }
    if (RUN(3)) REPS(3) {
        pg8::DenseOrder S; S.init(T, D, D, (const bf16*)(ws + WS_WOUT0), F.G, (int)blockIdx.x);
        pg8::EpiMixBf16 E{MOb};
        pg8::gemm_phase<pg8::EpiMixBf16, pg8::DenseOrder, false>(F.lds, MIXb, D, S, E);
        SEAM(3);
    }
#define MOE_PHASES(layer, pb) do { \
        if (RUN(pb)) REPS(pb) { \
            { RouteW RW; route_load_w(RW, args, layer, F.wave, F.lane); \
              for (int rd = F.vcu; rd < T / 32; rd += F.G) route_round(RW, args, F.lds, F.tid, F.wave, F.lane, layer, rd * 32, (layer) == 0 ? args.in[0] : Xf, MOb, Hb, (unsigned*)(F.ctl + CW_CNT) + (rep_ ? 2 * NEXP * 64 : 0), rep_ ? (unsigned*)(ws + WS_CONTRIB) : LIST, rep_ ? (float*)(ws + WS_CONTRIB + 4 * MiB) : SELW); } \
            SEAM(pb); \
        } \
        if (RUN((pb) + 1)) REPS((pb) + 1) { \
            moe_tables(F, layer); \
            { \
            pg8::MoeOrder S{cntL, tstL, (int)blockIdx.x, F.G, (const bf16*)(ws + WS_WGU) + (size_t)(layer) * NEXP * 1024 * D, (size_t)1024 * D, D, LIST, true}; \
            pg8::EpiMoeUp E{ACT}; \
            pg8::gemm_phase<pg8::EpiMoeUp, pg8::MoeOrder, true>(F.lds, Hb, D, S, E); } \
            SEAM((pb) + 1); \
        } \
        if (RUN((pb) + 2)) REPS((pb) + 2) { \
            moe_tables(F, layer); \
            { \
            pg8::MoeOrder S{cntL, tstL, (int)blockIdx.x, F.G, (const bf16*)(ws + WS_WD) + (size_t)(layer) * NEXP * D * FF, (size_t)D * FF, FF, LIST, false}; \
            pg8::EpiMoeDown E{CONTRIB, LIST, SELW, cntL}; \
            pg8::gemm_phase<pg8::EpiMoeDown, pg8::MoeOrder, true>(F.lds, ACT, FF, S, E); } \
            SEAM((pb) + 2); \
        } } while (0)
    MOE_PHASES(0, 4);
    if (RUN(7)) REPS(7) {
        for (int m = gw; m < T; m += NGW) norm_row(F.lane, args.in[0] + (size_t)m * D, MOb + (size_t)m * D, CONTRIB + (size_t)m * D, CONTRIB + (size_t)(T + m) * D, args.in[9] + D, (rep_ ? (float*)ACT : Xf) + (size_t)m * D, (rep_ ? MIXb : Hb) + (size_t)m * D, nullptr);
        SEAM(7);
    }
    if (RUN(8)) REPS(8) {
        pg8::DenseOrder S; S.init(T, ODD_IN, D, (const bf16*)(ws + WS_WIN1), F.G, (int)blockIdx.x);
        pg8::EpiOddIn E{ACT, ACT + (size_t)T * D};
        pg8::gemm_phase<pg8::EpiOddIn, pg8::DenseOrder, true>(F.lds, Hb, D, S, E);
        SEAM(8);
    }
    if (RUN(9)) REPS(9) { conv_phase(F, args); SEAM(9); }
    if (RUN(10)) {
        pg8::DenseOrder S; S.init(T, D, D, (const bf16*)(ws + WS_WOUT1), F.G, (int)blockIdx.x);
        pg8::EpiMixBf16 E{MOb};
        pg8::gemm_phase<pg8::EpiMixBf16, pg8::DenseOrder, false>(F.lds, MIXb, D, S, E);
        SEAM(10);
    }
    MOE_PHASES(1, 11);
#undef MOE_PHASES
    if (RUN(14)) REPS(14) {
        for (int m = gw; m < T; m += NGW) norm_row(F.lane, Xf + (size_t)m * D, MOb + (size_t)m * D, CONTRIB + (size_t)m * D, CONTRIB + (size_t)(T + m) * D, args.in[16], nullptr, nullptr, args.out + (size_t)m * D);
    }
#ifdef TS_FIXED
    { const unsigned long long tend = t_start_ + (unsigned long long)(TS_FIXED) * 100ull; while (__builtin_amdgcn_s_memrealtime() < tend) __builtin_amdgcn_s_sleep(8); }
#endif
#ifdef TS_A
    STAMP(47);
    if (blockIdx.x == (TS_BLOCK) && F.tid == 0) {
        const unsigned s0 = __hip_atomic_load(F.ctl + CW_TS + (TS_A), RLX_AGENT), s1 = __hip_atomic_load(F.ctl + CW_TS + (TS_A1), RLX_AGENT);
        const unsigned s2 = __hip_atomic_load(F.ctl + CW_TS + (TS_B), RLX_AGENT), s3 = __hip_atomic_load(F.ctl + CW_TS + (TS_B1), RLX_AGENT);
#ifdef TS_SKEW
        const unsigned e0 = ~__hip_atomic_load(F.ctl + CW_TS + 60, RLX_AGENT), e1 = __hip_atomic_load(F.ctl + CW_TS + 61, RLX_AGENT);
        const unsigned long long delay = 100ull * (unsigned long long)(e1 - e0);
#else
        const unsigned long long delay = (unsigned long long)(s1 - s0) + 400ull * (unsigned long long)(((s3 - s2) / 100u) * 100u);
#endif
        const unsigned long long t0 = __builtin_amdgcn_s_memrealtime();
        while (__builtin_amdgcn_s_memrealtime() - t0 < delay) __builtin_amdgcn_s_sleep(8);
    }
#endif
#undef RUN
#undef SEAM
}

#if HYBRID
__global__ void __launch_bounds__(256) k_rmsnorm(const float* __restrict__ x, const float* __restrict__ gain, float* __restrict__ out, int rows) {
    const int wave = (blockIdx.x * blockDim.x + threadIdx.x) >> 6, lane = threadIdx.x & 63;
    if (wave >= rows) return;
    const float* xr = x + (size_t)wave * D;
    float v[16]; float s = 0.f;
#pragma unroll
    for (int j = 0; j < 16; ++j) { v[j] = xr[lane + 64 * j]; s += v[j] * v[j]; }
    s = wave_sum(s);
    const float r = rsqrtf(s * (1.0f / D) + EPS);
#pragma unroll
    for (int j = 0; j < 16; ++j) out[(size_t)wave * D + lane + 64 * j] = v[j] * r * gain[lane + 64 * j];
}
__global__ void __launch_bounds__(256) k_sgemm(const float* __restrict__ A, const float* __restrict__ B, float* C, const float* R, int M, int N, int K) {
    __shared__ float As[16][65];
    __shared__ float Bs[16][65];
    const int tx = threadIdx.x & 15, ty = threadIdx.x >> 4;
    const int bm = blockIdx.y * 64, bn = blockIdx.x * 64;
    float acc[4][4] = {};
    for (int k0 = 0; k0 < K; k0 += 16) {
        for (int i = threadIdx.x; i < 64 * 16; i += 256) { const int r = i >> 4, c = i & 15; As[c][r] = A[(size_t)(bm + r) * K + k0 + c]; }
        for (int i = threadIdx.x; i < 16 * 64; i += 256) { const int r = i >> 6, c = i & 63; Bs[r][c] = B[(size_t)(k0 + r) * N + bn + c]; }
        __syncthreads();
#pragma unroll
        for (int k = 0; k < 16; ++k) {
            float a[4], b[4];
#pragma unroll
            for (int i = 0; i < 4; ++i) { a[i] = As[k][ty * 4 + i]; b[i] = Bs[k][tx * 4 + i]; }
#pragma unroll
            for (int i = 0; i < 4; ++i)
#pragma unroll
                for (int j = 0; j < 4; ++j) acc[i][j] += a[i] * b[j];
        }
        __syncthreads();
    }
#pragma unroll
    for (int i = 0; i < 4; ++i)
#pragma unroll
        for (int j = 0; j < 4; ++j) { const size_t o = (size_t)(bm + ty * 4 + i) * N + bn + tx * 4 + j; C[o] = (R ? R[o] : 0.f) + acc[i][j]; }
}
__device__ __forceinline__ float gelu_exact(float v) { return 0.5f * v * (1.0f + erff(v * 0.70710678118654752f)); }
__global__ void __launch_bounds__(256) k_even_post(float* P, const float* __restrict__ vgain) {
    const int w = (blockIdx.x * blockDim.x + threadIdx.x) >> 6, lane = threadIdx.x & 63;
    if (w >= T * NG) return;
    const int tok = w / NG, g = w % NG;
    float* pu = P + (size_t)tok * EVEN_IN + g * GD + lane;
    float* pv = P + (size_t)tok * EVEN_IN + GW + g * GD + lane;
    *pu = gelu_exact(*pu);
    const float v = gelu_exact(*pv);
    const float s = wave_sum(v * v);
    *pv = v * rsqrtf(s * (1.0f / GD) + EPS) * vgain[g * GD + lane];
}
__global__ void __launch_bounds__(256) k_gmlp(const float* __restrict__ P, const float* __restrict__ ws_, const float* __restrict__ bs_, float* __restrict__ mixcat) {
    __shared__ float vs[CHUNK][GD];
    const int g = blockIdx.x % NG, n = (blockIdx.x / NG) % (SEQ / CHUNK), b = blockIdx.x / (NG * (SEQ / CHUNK));
    const int tok0 = b * SEQ + n * CHUNK;
    for (int i = threadIdx.x; i < CHUNK * GD; i += 256) { const int s = i >> 6, d = i & 63; vs[s][d] = P[(size_t)(tok0 + s) * EVEN_IN + GW + g * GD + d]; }
    __syncthreads();
    const int d = threadIdx.x & 63;
    for (int t = threadIdx.x >> 6; t < CHUNK; t += 4) {
        float acc = 0.f;
        const float* wr = ws_ + ((size_t)g * CHUNK + t) * CHUNK;
        for (int s = 0; s <= t; ++s) acc += wr[s] * vs[s][d];
        acc += bs_[g * CHUNK + t];
        const float u = P[(size_t)(tok0 + t) * EVEN_IN + g * GD + d];
        mixcat[(size_t)(tok0 + t) * D + g * GD + d] = u * acc;
    }
}
__device__ __forceinline__ float log_sigmoid(float z) { return fminf(z, 0.f) - log1pf(expf(-fabsf(z))); }
__global__ void __launch_bounds__(256) k_sbattn(const float* __restrict__ P, float* __restrict__ mixcat) {
    const int w = (blockIdx.x * blockDim.x + threadIdx.x) >> 6, lane = threadIdx.x & 63;
    if (w >= T * NH) return;
    const int h = w % NH, tok = w / NH, b = tok / SEQ, t = tok % SEQ;
    const float q = P[(size_t)tok * EVEN_IN + 2 * GW + h * HD + lane];
    float acc = 0.f, suffix = 0.f;
    for (int s = t - 1; s >= 0; --s) {
        const size_t row = (size_t)(b * SEQ + s) * EVEN_IN;
        const float kk = P[row + 2 * GW + SBW + h * HD + lane];
        const float vv = P[row + 2 * GW + 2 * SBW + h * HD + lane];
        const float z = wave_sum(q * kk) * 0.125f;
        const float a = expf(log_sigmoid(z) + suffix);
        acc += a * vv;
        suffix += log_sigmoid(-z);
    }
    mixcat[(size_t)tok * D + GW + h * HD + lane] = acc;
}
__global__ void __launch_bounds__(256) k_conv(const float* __restrict__ P, const float* __restrict__ cw, float* __restrict__ mixin) {
    const size_t i = (size_t)blockIdx.x * blockDim.x + threadIdx.x;
    if (i >= (size_t)T * D) return;
    const int c = (int)(i % D), tok = (int)(i / D), t = tok % SEQ;
    float acc = 0.f;
#pragma unroll
    for (int k = 0; k < 3; ++k) { const int tt = t + k - 2;
        if (tt >= 0) { const size_t row = (size_t)(tok + k - 2) * ODD_IN; acc += cw[k * D + c] * (P[row + D + c] * P[row + 2 * D + c]); } }
    mixin[i] = P[(size_t)tok * ODD_IN + c] * acc;
}
__global__ void __launch_bounds__(256) k_route(const float* __restrict__ x, const float* __restrict__ gain, const float* __restrict__ wrg, const float* __restrict__ wre,
                                               float* __restrict__ h2, int* __restrict__ sel_e, float* __restrict__ sel_w) {
    const int w = (blockIdx.x * blockDim.x + threadIdx.x) >> 6, lane = threadIdx.x & 63;
    if (w >= T) return;
    const float* xr = x + (size_t)w * D;
    float v[16]; float s = 0.f;
#pragma unroll
    for (int j = 0; j < 16; ++j) { v[j] = xr[lane + 64 * j]; s += v[j] * v[j]; }
    s = wave_sum(s);
    const float r = rsqrtf(s * (1.0f / D) + EPS);
#pragma unroll
    for (int j = 0; j < 16; ++j) { v[j] = v[j] * r * gain[lane + 64 * j]; h2[(size_t)w * D + lane + 64 * j] = v[j]; }
    float gl[NGRP];
#pragma unroll
    for (int g = 0; g < NGRP; ++g) { float a = 0.f;
#pragma unroll
        for (int j = 0; j < 16; ++j) a += v[j] * wrg[(size_t)(lane + 64 * j) * NGRP + g];
        gl[g] = wave_sum(a); }
    int tg = 0; float mx = gl[0];
#pragma unroll
    for (int g = 1; g < NGRP; ++g) if (gl[g] > mx) { mx = gl[g]; tg = g; }
    float den = 0.f;
#pragma unroll
    for (int g = 0; g < NGRP; ++g) den += expf(gl[g] - mx);
    const float top_gp = 1.0f / den;
    float el[EPG];
#pragma unroll
    for (int e = 0; e < EPG; ++e) { float a = 0.f;
#pragma unroll
        for (int j = 0; j < 16; ++j) a += v[j] * wre[((size_t)tg * D + lane + 64 * j) * EPG + e];
        el[e] = wave_sum(a); }
    int e0 = 0; float l0 = el[0];
#pragma unroll
    for (int e = 1; e < EPG; ++e) if (el[e] > l0) { l0 = el[e]; e0 = e; }
    int e1 = -1; float l1 = -INFINITY;
#pragma unroll
    for (int e = 0; e < EPG; ++e) if (e != e0 && el[e] > l1) { l1 = el[e]; e1 = e; }
    const float p1 = expf(l1 - l0), inv = 1.0f / (1.0f + p1);
    if (lane == 0) { sel_e[w * 2 + 0] = tg * EPG + e0; sel_e[w * 2 + 1] = tg * EPG + e1; sel_w[w * 2 + 0] = top_gp * inv; sel_w[w * 2 + 1] = top_gp * p1 * inv; }
}
__global__ void __launch_bounds__(256) k_moe_up(const float* __restrict__ h2, const int* __restrict__ sel_e, const float* __restrict__ wg, const float* __restrict__ wu, float* __restrict__ hmid) {
    __shared__ float hs[D];
    const int row = blockIdx.x, tok = row >> 1;
    const int e = sel_e[row];
    for (int i = threadIdx.x; i < D; i += 256) hs[i] = h2[(size_t)tok * D + i];
    __syncthreads();
    const float* g = wg + (size_t)e * D * FF; const float* u = wu + (size_t)e * D * FF;
    float ag0 = 0.f, ag1 = 0.f, au0 = 0.f, au1 = 0.f;
    const int f = threadIdx.x;
    for (int k = 0; k < D; ++k) { const float hv = hs[k];
        ag0 += hv * g[(size_t)k * FF + f]; ag1 += hv * g[(size_t)k * FF + f + 256];
        au0 += hv * u[(size_t)k * FF + f]; au1 += hv * u[(size_t)k * FF + f + 256]; }
    hmid[(size_t)row * FF + f] = ag0 / (1.0f + expf(-ag0)) * au0;
    hmid[(size_t)row * FF + f + 256] = ag1 / (1.0f + expf(-ag1)) * au1;
}
__global__ void __launch_bounds__(256) k_moe_down(const float* __restrict__ hmid, const int* __restrict__ sel_e, const float* __restrict__ sel_w, const float* __restrict__ wd, float* x) {
    __shared__ float hs[2][FF];
    const int tok = blockIdx.x;
    for (int i = threadIdx.x; i < 2 * FF; i += 256) hs[i / FF][i % FF] = hmid[(size_t)tok * 2 * FF + i];
    __syncthreads();
    float acc[4] = {0.f, 0.f, 0.f, 0.f};
    for (int sl = 0; sl < 2; ++sl) {
        const int e = sel_e[tok * 2 + sl]; const float w = sel_w[tok * 2 + sl];
        const float* dmat = wd + (size_t)e * FF * D;
        float a[4] = {0.f, 0.f, 0.f, 0.f};
        for (int f = 0; f < FF; ++f) { const float hv = hs[sl][f];
#pragma unroll
            for (int j = 0; j < 4; ++j) a[j] += hv * dmat[(size_t)f * D + threadIdx.x + 256 * j]; }
#pragma unroll
        for (int j = 0; j < 4; ++j) acc[j] += w * a[j];
    }
#pragma unroll
    for (int j = 0; j < 4; ++j) x[(size_t)tok * D + threadIdx.x + 256 * j] += acc[j];
}
#endif

extern "C" void kernel_launch(void* const* d_in, const int* in_sizes, int n_in, void* d_out, int out_size, void* d_ws, size_t ws_size, hipStream_t stream) {
    static int grid = 0;
    if (grid == 0) {
        if (n_in != 17 || in_sizes[0] != T * D || out_size != T * D || ws_size < WS_END) { fprintf(stderr, "kernel_launch: unexpected shapes / workspace (%d inputs, ws %zu)\n", n_in, ws_size); grid = -1; return; }
        int dev = 0, cus = 0, per_cu = 0;
        if (hipGetDevice(&dev) != hipSuccess || hipDeviceGetAttribute(&cus, hipDeviceAttributeMultiprocessorCount, dev) != hipSuccess) { grid = -1; return; }
        if (hipFuncSetAttribute((const void*)mk_fwd, hipFuncAttributeMaxDynamicSharedMemorySize, LDS_BYTES) != hipSuccess) { fprintf(stderr, "kernel_launch: hipFuncSetAttribute failed\n"); grid = -1; return; }
        if (hipOccupancyMaxActiveBlocksPerMultiprocessor(&per_cu, (const void*)mk_fwd, NWAVES * 64, LDS_BYTES) != hipSuccess || per_cu < 1) { fprintf(stderr, "kernel_launch: occupancy query reports %d workgroups per CU\n", per_cu); }
        (void)hipGetLastError();
        grid = cus;
    }
    if (grid < 0) return;
    Args a{};
    for (int i = 0; i < 17; ++i) a.in[i] = (const float*)d_in[i];
    a.out = (float*)d_out; a.ws = (unsigned char*)d_ws;
#if !HYBRID
    hipMemsetAsync((char*)d_ws + WS_CTL, 0, CTL_ZERO_BYTES, stream);
    a.mask = (1u << NPHASE) - 1u; a.single = 1;
    hipLaunchKernelGGL(mk_fwd, dim3(grid), dim3(NWAVES * 64), LDS_BYTES, stream, a);
#else
    char* ws = (char*)d_ws;
    float* X = (float*)(ws + WS_X);
    float* sH = (float*)(ws + 0 * MiB); float* sP = (float*)(ws + 64 * MiB); float* sMC = (float*)(ws + 256 * MiB);
    int* sSE = (int*)(ws + 320 * MiB); float* sSW = (float*)(ws + 321 * MiB); float* sHM = (float*)(ws + 420 * MiB);
    const float** in = (const float**)a.in;
    auto fast = [&](unsigned mask) {
        for (int k = 0; k < NPHASE; ++k) if ((mask >> k) & 1u) { a.mask = 1u << k; a.single = 0; hipLaunchKernelGGL(mk_fwd, dim3(grid), dim3(NWAVES * 64), LDS_BYTES, stream, a); } };
    auto fast_prep = [&]() { hipMemsetAsync(ws + WS_CTL, 0, CTL_ZERO_BYTES, stream); fast(1u << 0); };
    auto slow_mixer = [&](int l) {
        const float* xin = (l == 0) ? in[0] : X;
        k_rmsnorm<<<T / 4, 256, 0, stream>>>(xin, in[9] + l * D, sH, T);
        if (l == 0) {
            k_sgemm<<<dim3(EVEN_IN / 64, T / 64), 256, 0, stream>>>(sH, in[1], sP, nullptr, T, EVEN_IN, D);
            k_even_post<<<T * NG / 4, 256, 0, stream>>>(sP, in[5]);
            k_gmlp<<<BATCH * (SEQ / CHUNK) * NG, 256, 0, stream>>>(sP, in[3], in[4], sMC);
            k_sbattn<<<T * NH / 4, 256, 0, stream>>>(sP, sMC);
            k_sgemm<<<dim3(D / 64, T / 64), 256, 0, stream>>>(sMC, in[2], X, xin, T, D, D);
        } else {
            k_sgemm<<<dim3(ODD_IN / 64, T / 64), 256, 0, stream>>>(sH, in[6], sP, nullptr, T, ODD_IN, D);
            k_conv<<<T * D / 256, 256, 0, stream>>>(sP, in[7], sMC);
            k_sgemm<<<dim3(D / 64, T / 64), 256, 0, stream>>>(sMC, in[8], X, xin, T, D, D);
        } };
    auto slow_moe = [&](int l) {
        k_route<<<T / 4, 256, 0, stream>>>(X, in[10] + l * D, in[11] + (size_t)l * D * NGRP, in[12] + (size_t)l * NGRP * D * EPG, sH, sSE, sSW);
        k_moe_up<<<T * 2, 256, 0, stream>>>(sH, sSE, in[13] + (size_t)l * NEXP * D * FF, in[14] + (size_t)l * NEXP * D * FF, sHM);
        k_moe_down<<<T, 256, 0, stream>>>(sHM, sSE, sSW, in[15] + (size_t)l * NEXP * FF * D, X);
        hipMemsetAsync(ws + WS_CONTRIB, 0, (size_t)2 * T * D * 2, stream); };
    const unsigned hy = HYBRID;
    if (hy & 1u) slow_mixer(0); else { fast_prep(); fast(0xEu); }
    if (hy & 2u) slow_moe(0); else { if (hy & 1u) fast_prep(); fast(0x70u); }
    if (hy & 4u) { if (!(hy & 2u)) fast(1u << 7); slow_mixer(1); }
    else { if (hy & 2u) fast_prep(); fast(0x780u); }
    if (hy & 8u) slow_moe(1); else { if (hy & 4u) fast_prep(); fast(0x3800u); }
    fast(1u << 14);
#endif
}
```

```cpp
#include <hip/hip_runtime.h>
#include <cstdio>
#include <cstdint>
#include <cmath>


#define GAS __attribute__((address_space(1)))
#define LAS __attribute__((address_space(3)))
typedef unsigned short bf16;
typedef unsigned v4u __attribute__((ext_vector_type(4)));
typedef unsigned v2u __attribute__((ext_vector_type(2)));
typedef float f32x4 __attribute__((ext_vector_type(4)));
typedef float f32x2 __attribute__((ext_vector_type(2)));
typedef float f32x16 __attribute__((ext_vector_type(16)));
typedef short bf16x8 __attribute__((ext_vector_type(8)));
typedef GAS unsigned gu32;

constexpr int D = 1024, BATCH = 8, SEQ = 2048, T = BATCH * SEQ;
constexpr int NG = 8, GD = 64, GW = 512, CHUNK = 128;
constexpr int NH = 8, HD = 64, SBW = 512;
constexpr int EVEN_IN = 2560, ODD_IN = 3072;
constexpr int NGRP = 4, EPG = 8, NEXP = 32, FF = 512;
constexpr float EPS = 1e-6f;
constexpr int NWAVES = 8;
constexpr int LIST_CAP = T;
constexpr int MAX_MT = 2 * T / 256 + NEXP;

constexpr size_t MiB = 1u << 20;
constexpr size_t WS_CTL = 0, CTL_ZERO_BYTES = 128 * 1024;
constexpr size_t WS_WTRIL = 128 * 1024;
constexpr size_t WS_WR = 384 * 1024;
constexpr size_t WS_LIST = 1 * MiB;
constexpr size_t WS_SELW = 3 * MiB;
constexpr size_t WS_WIN0 = 5 * MiB, WS_WOUT0 = 10 * MiB, WS_WIN1 = 12 * MiB, WS_WOUT1 = 18 * MiB;
constexpr size_t WS_WGU = 20 * MiB;
constexpr size_t WS_WD = 148 * MiB;
constexpr size_t WS_H = 212 * MiB;
constexpr size_t WS_ACT = 244 * MiB;
constexpr size_t WS_MIX = 324 * MiB;
constexpr size_t WS_X = 356 * MiB;
constexpr size_t WS_CONTRIB = 420 * MiB;
constexpr size_t WS_END = 484 * MiB;
constexpr int CW_CNT = 64;
constexpr int CW_TS = 12288;
constexpr int CW_BAR = 16384;

constexpr int RING_BYTES = 131072;
constexpr int LDSCTL_OFF = RING_BYTES, MISC_OFF = LDSCTL_OFF + 320;
constexpr int LDS_BYTES = 147456;

#define RLX_AGENT __ATOMIC_RELAXED, __HIP_MEMORY_SCOPE_AGENT
#define LDS_WAIT() asm volatile("s_waitcnt lgkmcnt(0)" ::: "memory")
#define VM_WAIT() asm volatile("s_waitcnt vmcnt(0)" ::: "memory")
__device__ __forceinline__ unsigned f2bf(float f) { unsigned u = __builtin_bit_cast(unsigned, f); return (u + 0x7fffu + ((u >> 16) & 1u)) >> 16; }
__device__ __forceinline__ unsigned pk2(float lo, float hi) { return f2bf(lo) | (f2bf(hi) << 16); }
__device__ __forceinline__ float bf_lo(unsigned w) { return __builtin_bit_cast(float, w << 16); }
__device__ __forceinline__ float bf_hi(unsigned w) { return __builtin_bit_cast(float, w & 0xffff0000u); }
__device__ __forceinline__ unsigned cvt_pk_bf16(float lo, float hi) { unsigned r; asm volatile("v_cvt_pk_bf16_f32 %0, %1, %2" : "=v"(r) : "v"(lo), "v"(hi)); return r; }
__device__ __forceinline__ float wave_sum(float v) {
#pragma unroll
    for (int o = 1; o < 64; o <<= 1) v += __shfl_xor(v, o);
    return v;
}

#define XB_TMO      128
#define XB_XCNT(j)  (256  + 64 * (j))
#define XB_XSUB(j)  (1280 + 64 * (j))
#define XB_XGEN(j)  (2304 + 64 * (j))
#define XB_TOP      3328
#define XB_TOPGEN   3392
#define XCD_BAR_WORDS 3456
#define XB_SPIN_CAP (1u << 18)
__device__ __forceinline__ unsigned xb_ld(unsigned* p)              { return __hip_atomic_load(p, __ATOMIC_RELAXED, __HIP_MEMORY_SCOPE_AGENT); }
__device__ __forceinline__ unsigned xb_add(unsigned* p, unsigned v) { return __hip_atomic_fetch_add(p, v, __ATOMIC_RELAXED, __HIP_MEMORY_SCOPE_AGENT); }
__device__ __forceinline__ unsigned xb_xcc_id() { return (unsigned)__builtin_amdgcn_s_getreg((3 << 11) | 20) & 0xFu; }
#define XB_SPIN(cond, bar) do { unsigned _sp = 0; while (cond) { __builtin_amdgcn_s_sleep(1); \
    if ((++_sp & 255u) == 0u) { if (xb_ld(&(bar)[XB_TMO])) break; if (_sp > XB_SPIN_CAP) { atomicAdd(&(bar)[XB_TMO], 1u); break; } } } } while (0)
struct XcdBarrier { unsigned* bar; unsigned x; volatile LAS unsigned* st; };
__device__ __forceinline__ XcdBarrier xcd_barrier_post(unsigned* bar, volatile LAS unsigned* st) {
    XcdBarrier b; b.bar = bar; b.x = xb_xcc_id(); b.st = st;
    if (threadIdx.x == 0) (void)xb_add(&bar[XB_XCNT(b.x)], 1u);
    return b;
}
__device__ __forceinline__ void xcd_barrier_complete(unsigned* bar, unsigned x, unsigned& nloc, unsigned& nx) {
    const unsigned G = gridDim.x * gridDim.y * gridDim.z;
    unsigned sum, cnt, mine, sp = 0u;
    for (;;) {
        sum = 0u; cnt = 0u; mine = 0u;
#pragma unroll
        for (unsigned j = 0; j < 16; ++j) { const unsigned c = xb_ld(&bar[XB_XCNT(j)]); sum += c; cnt += (c > 0u) ? 1u : 0u; mine = (j == x) ? c : mine; }
        if (sum == G) break;
        __builtin_amdgcn_s_sleep(1);
        if ((++sp & 255u) == 0u) { if (xb_ld(&bar[XB_TMO])) break; if (sp > XB_SPIN_CAP) { atomicAdd(&bar[XB_TMO], 1u); break; } }
    }
    nloc = mine > 0u ? mine : 1u; nx = cnt > 0u ? cnt : 1u;
}
__device__ __forceinline__ void xcd_barrier(const XcdBarrier& b) {
    asm volatile("s_waitcnt vmcnt(0)" ::: "memory");
    __syncthreads();
    if (threadIdx.x == 0) {
        unsigned* bar = b.bar;
        __builtin_amdgcn_s_waitcnt(0);
        unsigned nloc = b.st[0], nx = b.st[1];
        if (nloc == 0u) { xcd_barrier_complete(bar, b.x, nloc, nx); b.st[0] = nloc; b.st[1] = nx; }
        const unsigned old = xb_add(&bar[XB_XSUB(b.x)], 1u);
        const unsigned gen = old / nloc;
        if (old + 1u == (gen + 1u) * nloc) {
            __builtin_amdgcn_fence(__ATOMIC_RELEASE, "agent");
            asm volatile("s_waitcnt vmcnt(0)" ::: "memory");
            const unsigned og = xb_add(&bar[XB_TOP], 1u);
            const unsigned tg = og / nx;
            if (og + 1u == (tg + 1u) * nx) xb_add(&bar[XB_TOPGEN], 1u);
            else XB_SPIN(xb_ld(&bar[XB_TOPGEN]) == tg, bar);
            __builtin_amdgcn_fence(__ATOMIC_ACQUIRE, "agent");
            xb_add(&bar[XB_XGEN(b.x)], 1u);
            asm volatile("s_waitcnt vmcnt(0)" ::: "memory");
        } else {
            XB_SPIN(xb_ld(&bar[XB_XGEN(b.x)]) == gen, bar);
            __builtin_amdgcn_fence(__ATOMIC_ACQUIRE, "agent");
            asm volatile("s_waitcnt vmcnt(0)" ::: "memory");
        }
    }
    __syncthreads();
}

namespace pg8 {
constexpr int BM = 256, BK = 64, HALF = 128, HTB = HALF * BK * 2, STAGE_BYTES = 8 * HTB, NXCD = 8, WGM = 8;
__host__ __device__ __forceinline__ int lds_byte(int r, int c) { const int st = (r >> 4) * 2 + (c >> 5), rr = r & 15, cc = c & 31, ob = rr * 64 + cc * 2; return st * 1024 + (ob ^ (((ob >> 9) & 1) << 5)); }
__host__ __device__ __forceinline__ void stage_rc(int b, int& R, int& C) { const int st = b / 1024, sb = b % 1024, swz = sb ^ (((sb >> 9) & 1) << 5); R = (st >> 1) * 16 + swz / 64; C = (st & 1) * 32 + (swz % 64) / 2; }
__host__ __device__ __forceinline__ int perm32(int rho) { const int n = rho >> 4, i = rho & 15; return 8 * (i >> 2) + 4 * n + (i & 3); }

struct Unit { int pm, pn, e, mt, sh; };

struct DenseOrder {
    static constexpr bool HAS_SHORT = false;
    int nM, nN, nwg, G, c; const bf16* Bt; int K;
    __device__ void init(int M, int N, int K_, const bf16* Bt_, int G_, int c_) { nM = M / BM; nN = N / BM; nwg = nM * nN; G = G_; c = c_; Bt = Bt_; K = K_; }
    __device__ bool next(int i, Unit& u) const {
        const long L = (long)i * G + c; if (L >= nwg) return false;
        int wgid = (int)L; { const int q = nwg / NXCD, r = nwg % NXCD, xcd = wgid % NXCD, off = wgid / NXCD; wgid = (xcd < r ? xcd * (q + 1) : r * (q + 1) + (xcd - r) * q) + off; }
        const int nig = WGM * nN, gid = wgid / nig, fm = gid * WGM, gsz = (nM - fm) < WGM ? (nM - fm) : WGM;
        u.pm = fm + ((wgid % nig) % gsz); u.pn = (wgid % nig) / gsz; u.e = 0; u.mt = 0; u.sh = 0; return true;
    }
    __device__ __forceinline__ int a_row(const Unit& u, int r) const { return u.pm * BM + r; }
    __device__ __forceinline__ const char* b_base(const Unit& u) const { return (const char*)Bt + (size_t)u.pn * BM * K * 2; }
};

struct MoeOrder {
    const LAS int* cnt; const LAS int* tstart; int c, G; const bf16* W; size_t wstride; int K; const unsigned* list; bool gather;
    static constexpr bool HAS_SHORT = true;
    __device__ bool next(int i, Unit& u) const {
        const int x = c & 7, j = c >> 3, per = (G - x + 7) >> 3;
        int L = i * per + j;
        int tl = L >> 2; const int pn = L & 3;
#pragma unroll
        for (int k = 0; k < 4; ++k) {
            const int e = x + 8 * k; const int nt = tstart[e + 1] - tstart[e]; const int shrt = (nt > 0 && cnt[e] - (nt - 1) * BM <= HALF) ? 1 : 0; const int nf = nt - shrt;
            if (tl < nf) { u.e = e; u.mt = tl; u.pm = tstart[e] + tl; u.pn = pn; u.sh = 0; return true; }
            tl -= nf;
        }
#pragma unroll
        for (int k = 0; k < 4; ++k) {
            const int e = x + 8 * k; const int nt = tstart[e + 1] - tstart[e]; const int shrt = (nt > 0 && cnt[e] - (nt - 1) * BM <= HALF) ? 1 : 0;
            if (shrt) { if (tl == 0) { u.e = e; u.mt = nt - 1; u.pm = tstart[e] + nt - 1; u.pn = pn; u.sh = 1; return true; } --tl; }
        }
        return false;
    }
    __device__ __forceinline__ int a_row(const Unit& u, int r) const {
        if (!gather) return u.pm * BM + r;
        const int idx = u.mt * BM + r;
        return idx < cnt[u.e] ? (int)(list[(size_t)u.e * LIST_CAP + idx] >> 1) : 0;
    }
    __device__ __forceinline__ const char* b_base(const Unit& u) const { return (const char*)W + ((size_t)u.e * wstride + (size_t)u.pn * BM * K) * 2; }
};

__device__ __forceinline__ f32x2 gelu_pk(f32x2 v) {
    const f32x2 av = __builtin_elementwise_abs(v), d = av * 0.2316418882f + 1.0f;
    f32x2 t; t.x = __builtin_amdgcn_rcpf(d.x); t.y = __builtin_amdgcn_rcpf(d.y);
    f32x2 q = t * 0.5307027145f + (-0.7265760135f); q = q * t + 0.7107068705f; q = q * t + (-0.142248368f); q = q * t + 0.127414796f; q = q * t;
    const f32x2 s = (v * v) * (-0.72134752044f);
    f32x2 e; e.x = __builtin_amdgcn_exp2f(s.x); e.y = __builtin_amdgcn_exp2f(s.y);
    const f32x2 m = v * (q * e), r = v - m;
    f32x2 o; o.x = v.x < 0.f ? m.x : r.x; o.y = v.y < 0.f ? m.y : r.y; return o;
}

typedef f32x4 Acc[2][2][4][2];

template <class Epi, class Sched, bool ALIGN_EPI>
__device__ __forceinline__ void gemm_phase(LAS unsigned char* lds, const bf16* A, const int K, const Sched& S, const Epi& E) {
    const int tid = threadIdx.x, wid = __builtin_amdgcn_readfirstlane(tid >> 6), lane = tid & 63, wr = wid >> 2, wc = wid & 3, fr = lane & 15, fq = lane >> 4;
    const int nt = K / BK;
    int Rr[2], Cc[2]; unsigned voffB[2];
#pragma unroll
    for (int i = 0; i < 2; ++i) { int R, C; stage_rc(tid * 16 + i * 8192, R, C); const int Rb = Epi::PERM ? ((R & ~31) + perm32(R & 31)) : R;
        Rr[i] = R; Cc[i] = C; voffB[i] = (unsigned)(Rb * K + C) * 2u; }
    const size_t kstep = (size_t)(BK * 2);
    const size_t hstep = (size_t)HALF * K * 2;
    const unsigned ldsw = (unsigned)wid * 1024u;
    const int aoff = lds_byte(wr * 64 + fr, fq * 8), boff = lds_byte(wc * 32 + fr, fq * 8);
#define PG8_SA(b, h) (((b) * 2 + (h)) * HTB)
#define PG8_SB(b, h) ((4 + (b) * 2 + (h)) * HTB)
#define PG8_STAGE(bufoff, gbase, voff) do { _Pragma("unroll") for (int _i = 0; _i < 2; ++_i) \
        __builtin_amdgcn_global_load_lds((const unsigned*)((const char*)(gbase) + (voff)[_i]), (LAS unsigned*)(lds + (bufoff) + ldsw + _i * 8192), 16, 0, 0); } while (0)
#define PG8_LDA(dst, b, h) do { _Pragma("unroll") for (int m = 0; m < 4; ++m) _Pragma("unroll") for (int k = 0; k < 2; ++k) dst[m][k] = *(const LAS bf16x8*)(lds + PG8_SA(b, h) + aoff + m * 2048 + k * 1024); } while (0)
#define PG8_LDB(dst, b, h) do { _Pragma("unroll") for (int n = 0; n < 2; ++n) _Pragma("unroll") for (int k = 0; k < 2; ++k) dst[n][k] = *(const LAS bf16x8*)(lds + PG8_SB(b, h) + boff + n * 2048 + k * 1024); } while (0)
#define PG8_MMA(ai, bj, At, Bt) do { __builtin_amdgcn_s_setprio(1); _Pragma("unroll") for (int m = 0; m < 4; ++m) _Pragma("unroll") for (int n = 0; n < 2; ++n) _Pragma("unroll") for (int k = 0; k < 2; ++k) \
        acc[ai][bj][m][n] = __builtin_amdgcn_mfma_f32_16x16x32_bf16(Bt[n][k], At[m][k], acc[ai][bj][m][n], 0, 0, 0); __builtin_amdgcn_s_setprio(0); } while (0)
#define PG8_WAIT_V(n) asm volatile("s_waitcnt vmcnt(" #n ")" ::: "memory")
#define PG8_WAIT_L(n) asm volatile("s_waitcnt lgkmcnt(" #n ")" ::: "memory")
#define PG8_BAR __builtin_amdgcn_s_barrier()
#define PG8_SCHED __builtin_amdgcn_sched_barrier(0)
#define PG8_VOFF(dst, u) do { _Pragma("unroll") for (int _h = 0; _h < 2; ++_h) _Pragma("unroll") for (int _i = 0; _i < 2; ++_i) \
        dst[_h][_i] = (unsigned)(S.a_row(u, _h * HALF + Rr[_i]) * K + Cc[_i]) * 2u; \
        asm volatile("" : "+v"(dst[0][0]), "+v"(dst[0][1]), "+v"(dst[1][0]), "+v"(dst[1][1])); } while (0)
    Unit cur, nxt; int ui = 0;
    if (!S.next(0, cur)) return;
    Acc acc;
#pragma unroll
    for (int a = 0; a < 2; ++a)
#pragma unroll
        for (int b = 0; b < 2; ++b)
#pragma unroll
            for (int m = 0; m < 4; ++m)
#pragma unroll
                for (int n = 0; n < 2; ++n) acc[a][b][m][n] = (f32x4){0.f, 0.f, 0.f, 0.f};
    bf16x8 At[4][2], B0[2][2], B1[2][2];
    unsigned vc[2][2], vn[2][2];
    PG8_VOFF(vc, cur);
    const char* const cA = (const char*)A;
    const char* cB = S.b_base(cur);
    PG8_STAGE(PG8_SB(0, 0), cB, voffB); PG8_STAGE(PG8_SB(0, 1), cB + hstep, voffB); PG8_STAGE(PG8_SA(0, 0), cA, vc[0]); PG8_STAGE(PG8_SA(0, 1), cA, vc[1]);
    if (wr == 1) PG8_BAR;
    PG8_WAIT_V(2); PG8_BAR;
    PG8_STAGE(PG8_SB(1, 0), cB + kstep, voffB); PG8_STAGE(PG8_SA(1, 0), cA + kstep, vc[0]); PG8_STAGE(PG8_SB(1, 1), cB + hstep + kstep, voffB);
    PG8_WAIT_V(6); PG8_BAR;
    for (;;) {
        const bool has_next = S.next(ui + 1, nxt);
        if (has_next) { PG8_VOFF(vn, nxt); } else {
#pragma unroll
            for (int h = 0; h < 2; ++h)
#pragma unroll
                for (int i = 0; i < 2; ++i) vn[h][i] = vc[h][i]; }
        const char* nB = has_next ? S.b_base(nxt) : cB;
        const bool sh = Sched::HAS_SHORT && cur.sh != 0;
        for (int t = 0; t < nt; t += 2) {
            const bool last = (t == nt - 2);
            const char* a1 = cA + (size_t)(t + 1) * kstep;
            const char* a2 = last ? cA : cA + (size_t)(t + 2) * kstep; const char* b2 = last ? nB : cB + (size_t)(t + 2) * kstep;
            const char* a3 = a2 + kstep; const char* b3 = b2 + kstep;
            unsigned v2[2][2];
#pragma unroll
            for (int h = 0; h < 2; ++h)
#pragma unroll
                for (int i = 0; i < 2; ++i) v2[h][i] = last ? vn[h][i] : vc[h][i];
            PG8_LDB(B0, 0, 0); PG8_LDB(B1, 0, 1); PG8_SCHED; PG8_LDA(At, 0, 0); PG8_STAGE(PG8_SA(1, 1), a1, vc[1]);
            PG8_WAIT_V(8); PG8_WAIT_L(0); PG8_BAR; PG8_MMA(0, 0, At, B0); PG8_MMA(0, 1, At, B1); PG8_BAR; PG8_SCHED;
            if (!sh) { PG8_LDA(At, 0, 1); } PG8_STAGE(PG8_SB(0, 0), b2, voffB); PG8_STAGE(PG8_SB(0, 1), b2 + hstep, voffB); PG8_STAGE(PG8_SA(0, 0), a2, v2[0]);
            PG8_WAIT_V(8); PG8_WAIT_L(0); PG8_BAR; if (!sh) { PG8_MMA(1, 0, At, B0); PG8_MMA(1, 1, At, B1); } PG8_BAR; PG8_SCHED;
            PG8_LDB(B0, 1, 0); PG8_LDB(B1, 1, 1); PG8_SCHED; PG8_LDA(At, 1, 0); PG8_STAGE(PG8_SA(0, 1), a2, v2[1]);
            PG8_WAIT_V(8); PG8_WAIT_L(0); PG8_BAR; PG8_MMA(0, 0, At, B0); PG8_MMA(0, 1, At, B1); PG8_BAR; PG8_SCHED;
            if (!sh) { PG8_LDA(At, 1, 1); } PG8_STAGE(PG8_SB(1, 0), b3, voffB); PG8_STAGE(PG8_SB(1, 1), b3 + hstep, voffB); PG8_STAGE(PG8_SA(1, 0), a3, v2[0]);
            PG8_WAIT_V(8); PG8_WAIT_L(0); PG8_BAR; if (!sh) { PG8_MMA(1, 0, At, B0); PG8_MMA(1, 1, At, B1); } PG8_BAR; PG8_SCHED;
        }
        if constexpr (ALIGN_EPI) { if (wr == 0) PG8_BAR; }
        E(acc, cur, wr, wc, fr, fq);
        if (!has_next) break;
#pragma unroll
        for (int a = 0; a < 2; ++a)
#pragma unroll
            for (int b = 0; b < 2; ++b)
#pragma unroll
                for (int m = 0; m < 4; ++m)
#pragma unroll
                    for (int n = 0; n < 2; ++n) acc[a][b][m][n] = (f32x4){0.f, 0.f, 0.f, 0.f};
        cur = nxt; cB = nB; ++ui;
#pragma unroll
        for (int h = 0; h < 2; ++h)
#pragma unroll
            for (int i = 0; i < 2; ++i) vc[h][i] = vn[h][i];
        if constexpr (ALIGN_EPI) { if (wr == 1) PG8_BAR; }
    }
    PG8_WAIT_V(0);
    if constexpr (!ALIGN_EPI) { if (wr == 0) PG8_BAR; }
    PG8_BAR;
#undef PG8_SA
#undef PG8_SB
#undef PG8_STAGE
#undef PG8_LDA
#undef PG8_LDB
#undef PG8_MMA
#undef PG8_WAIT_V
#undef PG8_WAIT_L
#undef PG8_BAR
#undef PG8_SCHED
#undef PG8_VOFF
}

struct EpiEvenIn {
    static constexpr bool PERM = true;
    bf16 *U, *GV, *Q, *Kb, *VT;
    __device__ __forceinline__ void operator()(const Acc& acc, const Unit& u, int wr, int wc, int fr, int fq) const {
        const int sel = u.pn >> 1;
        const int row0 = u.pm * BM + wr * 64 + fr;
        const int colt = (u.pn & 1) * BM + wc * 32 + 8 * fq;
        if (sel < 4) {
            bf16* base = sel == 0 ? U : sel == 1 ? GV : sel == 2 ? Q : Kb;
#pragma unroll
            for (int ai = 0; ai < 2; ++ai)
#pragma unroll
                for (int m = 0; m < 4; ++m) { bf16* rowp = base + (size_t)(row0 + ai * HALF + m * 16) * GW + colt;
#pragma unroll
                    for (int bj = 0; bj < 2; ++bj) { f32x4 v0 = acc[ai][bj][m][0], v1 = acc[ai][bj][m][1];
                        if (sel < 2) { f32x2 a = gelu_pk((f32x2){v0[0], v0[1]}), b = gelu_pk((f32x2){v0[2], v0[3]}), c = gelu_pk((f32x2){v1[0], v1[1]}), d = gelu_pk((f32x2){v1[2], v1[3]});
                            v0 = (f32x4){a.x, a.y, b.x, b.y}; v1 = (f32x4){c.x, c.y, d.x, d.y}; }
                        v4u w; w.x = cvt_pk_bf16(v0[0], v0[1]); w.y = cvt_pk_bf16(v0[2], v0[3]); w.z = cvt_pk_bf16(v1[0], v1[1]); w.w = cvt_pk_bf16(v1[2], v1[3]);
                        *(v4u*)(rowp + bj * HALF) = w; } }
        } else {
#pragma unroll
            for (int ai = 0; ai < 2; ++ai)
#pragma unroll
                for (int m = 0; m < 4; ++m) { const int tok = row0 + ai * HALF + m * 16; const int b = tok / SEQ, t = tok % SEQ;
#pragma unroll
                    for (int bj = 0; bj < 2; ++bj) { const int c0 = colt + bj * HALF;
#pragma unroll
                        for (int n = 0; n < 2; ++n)
#pragma unroll
                            for (int j = 0; j < 4; ++j) { const int c = c0 + 4 * n + j;
                                VT[((size_t)(b * NH) * HD + c) * SEQ + t] = (bf16)f2bf(acc[ai][bj][m][n][j]); } } }
        }
    }
};
struct EpiResF32 {
    static constexpr bool PERM = false;
    const float* R; float* X;
    __device__ __forceinline__ void operator()(const Acc& acc, const Unit& u, int wr, int wc, int fr, int fq) const {
        const int row0 = u.pm * BM + wr * 64 + fr, col0 = u.pn * BM + wc * 32 + 4 * fq;
#pragma unroll
        for (int ai = 0; ai < 2; ++ai)
#pragma unroll
            for (int m = 0; m < 4; ++m) { const size_t off = (size_t)(row0 + ai * HALF + m * 16) * D + col0;
#pragma unroll
                for (int bj = 0; bj < 2; ++bj)
#pragma unroll
                    for (int n = 0; n < 2; ++n) { const f32x4 r = *(const f32x4*)(R + off + bj * HALF + n * 16); *(f32x4*)(X + off + bj * HALF + n * 16) = r + acc[ai][bj][m][n]; } }
    }
};
struct EpiMixBf16 {
    static constexpr bool PERM = true;
    bf16* MO;
    __device__ __forceinline__ void operator()(const Acc& acc, const Unit& u, int wr, int wc, int fr, int fq) const {
        const int row0 = u.pm * BM + wr * 64 + fr, col = u.pn * BM + wc * 32 + 8 * fq;
#pragma unroll
        for (int ai = 0; ai < 2; ++ai)
#pragma unroll
            for (int m = 0; m < 4; ++m)
#pragma unroll
                for (int bj = 0; bj < 2; ++bj) { const f32x4 v0 = acc[ai][bj][m][0], v1 = acc[ai][bj][m][1];
                    v4u w; w.x = cvt_pk_bf16(v0[0], v0[1]); w.y = cvt_pk_bf16(v0[2], v0[3]); w.z = cvt_pk_bf16(v1[0], v1[1]); w.w = cvt_pk_bf16(v1[2], v1[3]);
                    *(v4u*)(MO + (size_t)(row0 + ai * HALF + m * 16) * D + col + bj * HALF) = w; }
    }
};
struct EpiOddIn {
    static constexpr bool PERM = true;
    bf16 *Y, *GB;
    __device__ __forceinline__ void operator()(const Acc& acc, const Unit& u, int wr, int wc, int fr, int fq) const {
        const int row0 = u.pm * BM + wr * 64 + fr;
        if (u.pn < 8) {
            const int col = u.pn * HALF + wc * 32 + 8 * fq;
#pragma unroll
            for (int ai = 0; ai < 2; ++ai)
#pragma unroll
                for (int m = 0; m < 4; ++m) { const f32x4 v0 = acc[ai][0][m][0] * acc[ai][1][m][0], v1 = acc[ai][0][m][1] * acc[ai][1][m][1];
                    v4u w; w.x = cvt_pk_bf16(v0[0], v0[1]); w.y = cvt_pk_bf16(v0[2], v0[3]); w.z = cvt_pk_bf16(v1[0], v1[1]); w.w = cvt_pk_bf16(v1[2], v1[3]);
                    *(v4u*)(Y + (size_t)(row0 + ai * HALF + m * 16) * D + col) = w; }
        } else {
            const int col = (u.pn - 8) * BM + wc * 32 + 8 * fq;
#pragma unroll
            for (int ai = 0; ai < 2; ++ai)
#pragma unroll
                for (int m = 0; m < 4; ++m)
#pragma unroll
                    for (int bj = 0; bj < 2; ++bj) { const f32x4 v0 = acc[ai][bj][m][0], v1 = acc[ai][bj][m][1];
                        v4u w; w.x = cvt_pk_bf16(v0[0], v0[1]); w.y = cvt_pk_bf16(v0[2], v0[3]); w.z = cvt_pk_bf16(v1[0], v1[1]); w.w = cvt_pk_bf16(v1[2], v1[3]);
                        *(v4u*)(GB + (size_t)(row0 + ai * HALF + m * 16) * D + col + bj * HALF) = w; }
        }
    }
};
struct EpiMoeUp {
    static constexpr bool PERM = true;
    bf16* HM;
    __device__ __forceinline__ void operator()(const Acc& acc, const Unit& u, int wr, int wc, int fr, int fq) const {
        const int row0 = u.pm * BM + wr * 64 + fr, col = u.pn * HALF + wc * 32 + 8 * fq;
#pragma unroll
        for (int ai = 0; ai < 2; ++ai)
#pragma unroll
            for (int m = 0; m < 4; ++m) { float o[8];
#pragma unroll
                for (int n = 0; n < 2; ++n)
#pragma unroll
                    for (int j = 0; j < 4; ++j) { const float g = acc[ai][0][m][n][j], up = acc[ai][1][m][n][j];
                        o[4 * n + j] = g * __builtin_amdgcn_rcpf(1.0f + __builtin_amdgcn_exp2f(-1.44269504089f * g)) * up; }
                v4u w; w.x = cvt_pk_bf16(o[0], o[1]); w.y = cvt_pk_bf16(o[2], o[3]); w.z = cvt_pk_bf16(o[4], o[5]); w.w = cvt_pk_bf16(o[6], o[7]);
                *(v4u*)(HM + (size_t)(row0 + ai * HALF + m * 16) * FF + col) = w; }
    }
};
struct EpiMoeDown {
    static constexpr bool PERM = true;
    bf16* CONTRIB; const unsigned* list; const float* selw; const LAS int* cnt;
    __device__ __forceinline__ void operator()(const Acc& acc, const Unit& u, int wr, int wc, int fr, int fq) const {
        const int n_e = cnt[u.e]; const unsigned* le = list + (size_t)u.e * LIST_CAP + u.mt * BM; const float* lw = selw + (size_t)u.e * LIST_CAP + u.mt * BM;
        const int col = u.pn * BM + wc * 32 + 8 * fq;
        unsigned ent[2][4]; float wgt[2][4];
#pragma unroll
        for (int ai = 0; ai < 2; ++ai)
#pragma unroll
            for (int m = 0; m < 4; ++m) { const int r = ai * HALF + wr * 64 + m * 16 + fr; ent[ai][m] = le[(u.mt * BM + r < n_e) ? r : 0]; }
#pragma unroll
        for (int ai = 0; ai < 2; ++ai)
#pragma unroll
            for (int m = 0; m < 4; ++m) { const int r = ai * HALF + wr * 64 + m * 16 + fr; wgt[ai][m] = lw[(u.mt * BM + r < n_e) ? r : 0]; }
#pragma unroll
        for (int ai = 0; ai < 2; ++ai)
#pragma unroll
            for (int m = 0; m < 4; ++m) { const int r = ai * HALF + wr * 64 + m * 16 + fr;
                if (u.mt * BM + r < n_e) { const unsigned e = ent[ai][m]; const float w = wgt[ai][m];
                    bf16* rowp = CONTRIB + ((size_t)(e & 1u) * T + (e >> 1)) * D + col;
#pragma unroll
                    for (int bj = 0; bj < 2; ++bj) { const f32x4 v0 = acc[ai][bj][m][0] * w, v1 = acc[ai][bj][m][1] * w;
                        v4u o; o.x = cvt_pk_bf16(v0[0], v0[1]); o.y = cvt_pk_bf16(v0[2], v0[3]); o.z = cvt_pk_bf16(v1[0], v1[1]); o.w = cvt_pk_bf16(v1[2], v1[3]);
                        *(v4u*)(rowp + bj * HALF) = o; } } }
    }
};
}

struct Frame {
    LAS unsigned char* lds;
    volatile LAS unsigned* MISC;
    gu32* ctl;
    int tid, lane, wave, vcu, G;
};

struct TrDesc { const float* W; bf16* WT; int K, N, k0, n0, orow0; };
__device__ __forceinline__ void tr_load(const TrDesc& d, f32x4 (&v)[16], int lane) {
    const int kk = lane >> 4, nq = (lane & 15) * 4;
#pragma unroll
    for (int i = 0; i < 16; ++i) v[i] = __builtin_nontemporal_load((const GAS f32x4*)(d.W + (size_t)(d.k0 + 4 * i + kk) * d.N + d.n0 + nq));
}
__device__ __forceinline__ void tr_finish(const TrDesc& d, const f32x4 (&v)[16], LAS float* scr, int lane) {
    const int kk = lane >> 4, nq = (lane & 15) * 4;
    const int c0 = (nq + 0) ^ kk, c1 = (nq + 1) ^ kk, c2 = (nq + 2) ^ kk, c3 = (nq + 3) ^ kk;
#pragma unroll
    for (int i = 0; i < 16; ++i) { const int k = 4 * i + kk, sw = 8 * (i >> 1); LAS float* row = scr + k * 64;
        row[c0 ^ sw] = v[i].x; row[c1 ^ sw] = v[i].y; row[c2 ^ sw] = v[i].z; row[c3 ^ sw] = v[i].w; }
    LDS_WAIT(); asm volatile("" ::: "memory");
    const int c = lane & 7, nl = lane >> 3;
#pragma unroll
    for (int j = 0; j < 8; ++j) { const int n = nl + 8 * j; const LAS float* s = scr + (8 * c) * 64; const int q0 = n ^ (8 * c), q1 = q0 ^ 1, q2 = q0 ^ 2, q3 = q0 ^ 3;
        v4u o; o.x = pk2(s[0 * 64 + q0], s[1 * 64 + q1]); o.y = pk2(s[2 * 64 + q2], s[3 * 64 + q3]); o.z = pk2(s[4 * 64 + q0], s[5 * 64 + q1]); o.w = pk2(s[6 * 64 + q2], s[7 * 64 + q3]);
        __builtin_nontemporal_store(o, (GAS v4u*)(d.WT + (size_t)(d.orow0 + n) * d.K + d.k0 + 8 * c)); }
    LDS_WAIT(); asm volatile("" ::: "memory");
}
__device__ __forceinline__ void tr_item64(const float* W, int K, int N, bf16* WT, int k0, int n0, int orow0, LAS float* scr, int lane) {
    const TrDesc d{W, WT, K, N, k0, n0, orow0}; f32x4 v[16]; tr_load(d, v, lane); tr_finish(d, v, scr, lane);
}
struct Args;
constexpr int I_IN0 = 16 * (EVEN_IN / 64), I_OUT = 16 * (D / 64), I_IN1 = 16 * (ODD_IN / 64), I_DENSE = I_IN0 + 2 * I_OUT + I_IN1;
constexpr int I_MOE = NEXP * 384;
__device__ __forceinline__ void norm_row(int lane, const float* xrow, const bf16* mo, const bf16* c0, const bf16* c1, const float* gain, float* xs, bf16* ob, float* of32) {
    const GAS f32x4* xr = (const GAS f32x4*)xrow + lane;
    f32x4 v[4]; float s = 0.f;
#pragma unroll
    for (int j = 0; j < 4; ++j) v[j] = __builtin_nontemporal_load(xr + 64 * j);
    if (mo) {
#pragma unroll
        for (int j = 0; j < 4; ++j) { const v2u a = __builtin_nontemporal_load((const GAS v2u*)mo + lane + 64 * j); v[j].x += bf_lo(a.x); v[j].y += bf_hi(a.x); v[j].z += bf_lo(a.y); v[j].w += bf_hi(a.y); }
    }
    if (c0) {
#pragma unroll
        for (int j = 0; j < 4; ++j) { const v2u a = __builtin_nontemporal_load((const GAS v2u*)c0 + lane + 64 * j), b = __builtin_nontemporal_load((const GAS v2u*)c1 + lane + 64 * j);
            v[j].x += bf_lo(a.x) + bf_lo(b.x); v[j].y += bf_hi(a.x) + bf_hi(b.x); v[j].z += bf_lo(a.y) + bf_lo(b.y); v[j].w += bf_hi(a.y) + bf_hi(b.y); }
    }
#pragma unroll
    for (int j = 0; j < 4; ++j) s += (v[j].x * v[j].x + v[j].y * v[j].y) + (v[j].z * v[j].z + v[j].w * v[j].w);
    if (xs) {
#pragma unroll
        for (int j = 0; j < 4; ++j) *((GAS f32x4*)xs + lane + 64 * j) = v[j]; }
    const float rstd = rsqrtf(wave_sum(s) * (1.f / D) + EPS);
#pragma unroll
    for (int j = 0; j < 4; ++j) { const f32x4 g = *((const GAS f32x4*)gain + lane + 64 * j); v[j] = v[j] * rstd * g; }
    if (ob) {
#pragma unroll
        for (int j = 0; j < 4; ++j) { v2u o; o.x = pk2(v[j].x, v[j].y); o.y = pk2(v[j].z, v[j].w); *((GAS v2u*)ob + lane + 64 * j) = o; } }
    if (of32) {
#pragma unroll
        for (int j = 0; j < 4; ++j) *((GAS f32x4*)of32 + lane + 64 * j) = v[j]; }
}

struct Args { const float* in[17]; float* out; unsigned char* ws; unsigned mask; int single; };

__device__ __forceinline__ void conv_dense_item(const Args& a, int r, LAS float* scr, int lane) {
    unsigned char* ws = a.ws;
    if (r < I_IN0) { const int nb = EVEN_IN / 64; tr_item64(a.in[1], D, EVEN_IN, (bf16*)(ws + WS_WIN0), 64 * (r / nb), 64 * (r % nb), 64 * (r % nb), scr, lane); return; } r -= I_IN0;
    if (r < I_OUT) { const int nb = D / 64; tr_item64(a.in[2], D, D, (bf16*)(ws + WS_WOUT0), 64 * (r / nb), 64 * (r % nb), 64 * (r % nb), scr, lane); return; } r -= I_OUT;
    if (r < I_IN1) { const int nb = ODD_IN / 64; const int n0 = 64 * (r % nb);
        const int sec = n0 / D, c = n0 % D; const int orow = sec == 0 ? 2048 + c : 256 * (c / 128) + (sec == 2 ? 128 : 0) + (c % 128);
        tr_item64(a.in[6], D, ODD_IN, (bf16*)(ws + WS_WIN1), 64 * (r / nb), n0, orow, scr, lane); return; } r -= I_IN1;
    { const int nb = D / 64; tr_item64(a.in[8], D, D, (bf16*)(ws + WS_WOUT1), 64 * (r / nb), 64 * (r % nb), 64 * (r % nb), scr, lane); }
}
__device__ __forceinline__ TrDesc moe_item_desc(const Args& a, int layer, int q) {
    unsigned char* ws = a.ws;
    const int le = layer * NEXP + q / 384; int r = q % 384;
    if (r < 256) { const int up = r >= 128; if (up) r -= 128; const int n0 = 64 * (r % 8);
        const float* W = (up ? a.in[14] : a.in[13]) + (size_t)le * D * FF;
        return TrDesc{W, (bf16*)(ws + WS_WGU) + (size_t)le * 1024 * D, D, FF, 64 * (r / 8), n0, 256 * (n0 / 128) + (up ? 128 : 0) + (n0 % 128)}; }
    r -= 256;
    return TrDesc{a.in[15] + (size_t)le * FF * D, (bf16*)(ws + WS_WD) + (size_t)le * D * FF, FF, D, 64 * (r / 16), 64 * (r % 16), 64 * (r % 16)};
}
__device__ __forceinline__ void conv_moe_range(const Args& a, LAS unsigned char* lds, int wave, int lane, int layer, int first, int last, int widx, int nw) {
    LAS float* scr = (LAS float*)(lds + wave * 16384);
    int q = first + widx;
    if (q >= last) return;
    TrDesc d0 = moe_item_desc(a, layer, q), d1 = d0; f32x4 v0[16], v1[16];
    tr_load(d0, v0, lane);
    for (;;) {
        const int q1 = q + nw; const bool h1 = q1 < last;
        if (h1) { d1 = moe_item_desc(a, layer, q1); tr_load(d1, v1, lane); }
        tr_finish(d0, v0, scr, lane);
        if (!h1) break;
        const int q2 = q1 + nw; const bool h2 = q2 < last;
        if (h2) { d0 = moe_item_desc(a, layer, q2); tr_load(d0, v0, lane); }
        tr_finish(d1, v1, scr, lane);
        if (!h2) break;
        q = q2;
    }
}
constexpr int L0_P0 = 0, L1_P0 = 0;

__device__ __forceinline__ void phase_prologue(Frame& F, const Args& a, int l0_last) {
    LAS float* scr = (LAS float*)(F.lds + F.wave * 16384);
    const int gw = F.vcu * NWAVES + F.wave, NGW = F.G * NWAVES;
    unsigned char* ws = a.ws;
#ifdef TS_A
#define PSTAMP(k) do { if (blockIdx.x == 0 && F.tid == 0) __hip_atomic_store(F.ctl + CW_TS + (k), (unsigned)__builtin_amdgcn_s_memrealtime(), RLX_AGENT); } while (0)
#else
#define PSTAMP(k) do { } while (0)
#endif
    for (int m = gw; m < T; m += NGW) norm_row(F.lane, a.in[0] + (size_t)m * D, nullptr, nullptr, nullptr, a.in[9], nullptr, (bf16*)(ws + WS_H) + (size_t)m * D, nullptr);
    PSTAMP(53);
    for (int it = gw; it < I_DENSE; it += NGW) conv_dense_item(a, it, scr, F.lane);
    PSTAMP(50);
    conv_moe_range(a, F.lds, F.wave, F.lane, 0, 0, l0_last, gw, NGW);
    PSTAMP(51);
    { const float* wsrc = a.in[3]; bf16* wt = (bf16*)(ws + WS_WTRIL);
      for (int i = (F.vcu * 512 + F.tid) * 4; i < NG * CHUNK * CHUNK; i += F.G * 512 * 4) { const int t = (i / CHUNK) % CHUNK, s = i % CHUNK; const f32x4 v = *(const f32x4*)(wsrc + i);
          v2u o; o.x = pk2(s <= t ? v.x : 0.f, s + 1 <= t ? v.y : 0.f); o.y = pk2(s + 2 <= t ? v.z : 0.f, s + 3 <= t ? v.w : 0.f); *(v2u*)(wt + i) = o; } }
    { bf16* wr = (bf16*)(ws + WS_WR);
      for (int i = F.vcu * 512 + F.tid; i < 2 * 48 * D; i += F.G * 512) { const int k = i % D, c = (i / D) % 48, l = i / (48 * D);
          float w = 0.f;
          if (c < NGRP) w = a.in[11][((size_t)l * D + k) * NGRP + c];
          else if (c < NGRP + NEXP) { const int g = (c - NGRP) / EPG, e = (c - NGRP) % EPG; w = a.in[12][(((size_t)l * NGRP + g) * D + k) * EPG + e]; }
          w *= a.in[10][l * D + k];
          const unsigned hi = f2bf(w); const float rem = w - __builtin_bit_cast(float, hi << 16);
          wr[((size_t)(l * 2 + 0) * 48 + c) * D + k] = (bf16)hi; wr[((size_t)(l * 2 + 1) * 48 + c) * D + k] = (bf16)f2bf(rem); } }
    PSTAMP(52);
}

__device__ __forceinline__ void gmlp_unit(Frame& F, const Args& a, int unit) {
    unsigned char* ws = a.ws;
    const bf16* U = (const bf16*)(ws + WS_ACT); const bf16* GV = U + (size_t)T * GW; const bf16* WT = (const bf16*)(ws + WS_WTRIL); bf16* MIX = (bf16*)(ws + WS_MIX);
    const int g = unit % NG, n = (unit / NG) % (SEQ / CHUNK), b = unit / (NG * (SEQ / CHUNK));
    const int tok0 = b * SEQ + n * CHUNK;
    constexpr int VSTR = 136;
    LAS bf16* vnT = (LAS bf16*)F.lds;
    { const int s = F.tid >> 2, cg = F.tid & 3;
      const v4u r0 = *(const v4u*)(GV + (size_t)(tok0 + s) * GW + g * GD + 16 * cg), r1 = *(const v4u*)(GV + (size_t)(tok0 + s) * GW + g * GD + 16 * cg + 8);
      float v[16]; const unsigned w[8] = {r0.x, r0.y, r0.z, r0.w, r1.x, r1.y, r1.z, r1.w};
#pragma unroll
      for (int i = 0; i < 8; ++i) { v[2 * i] = bf_lo(w[i]); v[2 * i + 1] = bf_hi(w[i]); }
      float ss = 0.f;
#pragma unroll
      for (int i = 0; i < 16; ++i) ss += v[i] * v[i];
      ss += __shfl_xor(ss, 1); ss += __shfl_xor(ss, 2);
      const float rstd = rsqrtf(ss * (1.0f / GD) + EPS);
      const float* gn = a.in[5] + g * GD + 16 * cg;
#pragma unroll
      for (int i = 0; i < 16; ++i) vnT[(16 * cg + i) * VSTR + s] = (bf16)f2bf(v[i] * rstd * gn[i]); }
    __syncthreads();
    { const int db = F.wave & 1, tb = F.wave >> 1, r = F.lane & 31, h = F.lane >> 5;
      f32x16 x;
_Pragma("unroll") for (int i = 0; i < 16; ++i) x[i] = 0.f;
      const bf16* wrow = WT + ((size_t)g * CHUNK + 32 * tb + r) * CHUNK + 8 * h;
      const LAS bf16* vrow = vnT + (32 * db + r) * VSTR + 8 * h;
      for (int kk = 0; kk < 2 * (tb + 1); ++kk) {
          const bf16x8 av = *(const LAS bf16x8*)(vrow + 16 * kk);
          const bf16x8 bw = *(const bf16x8*)(wrow + 16 * kk);
          x = __builtin_amdgcn_mfma_f32_32x32x16_bf16(av, bw, x, 0, 0, 0);
      }
      const int t = 32 * tb + r; const float bias = a.in[4][g * CHUNK + t];
      const bf16* urow = U + (size_t)(tok0 + t) * GW + g * GD + 32 * db + 4 * h; bf16* orow = MIX + (size_t)(tok0 + t) * D + g * GD + 32 * db + 4 * h;
#pragma unroll
      for (int q = 0; q < 4; ++q) { const v2u uu = *(const v2u*)(urow + 8 * q);
          v2u o; o.x = pk2(bf_lo(uu.x) * (x[4 * q] + bias), bf_hi(uu.x) * (x[4 * q + 1] + bias)); o.y = pk2(bf_lo(uu.y) * (x[4 * q + 2] + bias), bf_hi(uu.y) * (x[4 * q + 3] + bias));
          *(v2u*)(orow + 8 * q) = o; } }
    __syncthreads();
}

template <bool DIAG>
__device__ __forceinline__ void sb_tile(const f32x16& s, float& carry, bf16x8& p0, bf16x8& p1, int r, int hh) {
    float l[16], lk[16];
#pragma unroll
    for (int i = 0; i < 16; ++i) {
        const float n = fminf(s[i] * (-0.125f * 1.44269504089f), 126.0f);
        const float e = __builtin_amdgcn_exp2f(n);
        l[i] = __builtin_amdgcn_logf(1.0f + e);
        lk[i] = n - l[i];
        if (DIAG) { const int key = 16 * (i >> 3) + 8 * hh + (i & 7); if (key >= r) lk[i] = 0.f; }
    }
    float suf[16]; float run0 = 0.f, run1 = 0.f;
#pragma unroll
    for (int j = 7; j >= 0; --j) { suf[j] = run0; run0 += lk[j]; suf[8 + j] = run1; run1 += lk[8 + j]; }
    const float o0 = __shfl_xor(run0, 32), o1 = __shfl_xor(run1, 32);
    const float afterA = hh == 0 ? (o0 + run1 + o1) : (o1 + run1);
    const float afterB = hh == 0 ? o1 : 0.f;
    float pa[16];
#pragma unroll
    for (int i = 0; i < 16; ++i) {
        const float arg = carry + (i < 8 ? afterA : afterB) + suf[i] - l[i];
        pa[i] = __builtin_amdgcn_exp2f(arg);
        if (DIAG) { const int key = 16 * (i >> 3) + 8 * hh + (i & 7); if (key >= r) pa[i] = 0.f; }
    }
    carry += (run0 + run1) + (o0 + o1);
    v4u w0, w1;
    w0.x = cvt_pk_bf16(pa[0], pa[1]); w0.y = cvt_pk_bf16(pa[2], pa[3]); w0.z = cvt_pk_bf16(pa[4], pa[5]); w0.w = cvt_pk_bf16(pa[6], pa[7]);
    w1.x = cvt_pk_bf16(pa[8], pa[9]); w1.y = cvt_pk_bf16(pa[10], pa[11]); w1.z = cvt_pk_bf16(pa[12], pa[13]); w1.w = cvt_pk_bf16(pa[14], pa[15]);
    p0 = __builtin_bit_cast(bf16x8, w0); p1 = __builtin_bit_cast(bf16x8, w1);
}
__device__ __forceinline__ void sb_task(const Args& a, int lane, int bh, int qblk) {
    unsigned char* ws = a.ws;
    const bf16* Q = (const bf16*)(ws + WS_ACT) + (size_t)2 * T * GW; const bf16* Kb = Q + (size_t)T * SBW; const bf16* VT = Kb + (size_t)T * SBW; bf16* MIX = (bf16*)(ws + WS_MIX);
    const int b = bh / NH, h = bh % NH, r = lane & 31, hh = lane >> 5;
    const int q0 = qblk * 32;
    const int kap = (r & ~12) | ((r & 4) << 1) | ((r & 8) >> 1);
    bf16x8 qf[4];
    { const bf16* qp = Q + (size_t)(b * SEQ + q0 + r) * SBW + h * HD + 8 * hh;
#pragma unroll
      for (int kk = 0; kk < 4; ++kk) qf[kk] = *(const bf16x8*)(qp + 16 * kk); }
    const bf16* kbase = Kb + (size_t)(b * SEQ + kap) * SBW + h * HD + 8 * hh;
    const bf16* vbase = VT + ((size_t)bh * HD + r) * SEQ + 8 * hh;
    f32x16 o0, o1;
_Pragma("unroll") for (int i = 0; i < 16; ++i) { o0[i] = 0.f; o1[i] = 0.f; }
    float carry = 0.f;
    bf16x8 kf[4], vf[2][2];
    int k0 = q0;
#pragma unroll
    for (int kk = 0; kk < 4; ++kk) kf[kk] = *(const bf16x8*)(kbase + (size_t)k0 * SBW + 16 * kk);
#pragma unroll
    for (int db = 0; db < 2; ++db)
#pragma unroll
        for (int s = 0; s < 2; ++s) vf[db][s] = *(const bf16x8*)(vbase + (size_t)(32 * db) * SEQ + k0 + 16 * s);
    bool diag = true;
    for (;;) {
        f32x16 sc;
_Pragma("unroll") for (int i = 0; i < 16; ++i) sc[i] = 0.f;
#pragma unroll
        for (int kk = 0; kk < 4; ++kk) sc = __builtin_amdgcn_mfma_f32_32x32x16_bf16(kf[kk], qf[kk], sc, 0, 0, 0);
        bf16x8 vcur[2][2];
#pragma unroll
        for (int db = 0; db < 2; ++db)
#pragma unroll
            for (int s = 0; s < 2; ++s) vcur[db][s] = vf[db][s];
        const int kn = k0 - 32;
        if (kn >= 0) {
#pragma unroll
            for (int kk = 0; kk < 4; ++kk) kf[kk] = *(const bf16x8*)(kbase + (size_t)kn * SBW + 16 * kk);
#pragma unroll
            for (int db = 0; db < 2; ++db)
#pragma unroll
                for (int s = 0; s < 2; ++s) vf[db][s] = *(const bf16x8*)(vbase + (size_t)(32 * db) * SEQ + kn + 16 * s);
        }
        bf16x8 p0, p1;
        if (diag) sb_tile<true>(sc, carry, p0, p1, r, hh); else sb_tile<false>(sc, carry, p0, p1, r, hh);
        diag = false;
        o0 = __builtin_amdgcn_mfma_f32_32x32x16_bf16(vcur[0][0], p0, o0, 0, 0, 0);
        o0 = __builtin_amdgcn_mfma_f32_32x32x16_bf16(vcur[0][1], p1, o0, 0, 0, 0);
        o1 = __builtin_amdgcn_mfma_f32_32x32x16_bf16(vcur[1][0], p0, o1, 0, 0, 0);
        o1 = __builtin_amdgcn_mfma_f32_32x32x16_bf16(vcur[1][1], p1, o1, 0, 0, 0);
        if (kn < 0) break;
        if (__all(carry < -150.0f)) break;
        k0 = kn;
    }
    bf16* orow = MIX + (size_t)(b * SEQ + q0 + r) * D + GW + h * HD + 4 * hh;
#pragma unroll
    for (int q = 0; q < 4; ++q) {
        v2u w; w.x = cvt_pk_bf16(o0[4 * q], o0[4 * q + 1]); w.y = cvt_pk_bf16(o0[4 * q + 2], o0[4 * q + 3]); *(v2u*)(orow + 8 * q) = w;
        v2u w2; w2.x = cvt_pk_bf16(o1[4 * q], o1[4 * q + 1]); w2.y = cvt_pk_bf16(o1[4 * q + 2], o1[4 * q + 3]); *(v2u*)(orow + 32 + 8 * q) = w2;
    }
}

struct RouteW { bf16x8 w[3][4][2]; };
__device__ __forceinline__ void route_load_w(RouteW& R, const Args& a, int layer, int wave, int lane) {
    const int fr = lane & 15, fq = lane >> 4;
    const bf16* wh = (const bf16*)(a.ws + WS_WR) + ((size_t)(layer * 2) * 48 + fr) * D + 128 * wave + 8 * fq;
#pragma unroll
    for (int cb = 0; cb < 3; ++cb)
#pragma unroll
        for (int s = 0; s < 4; ++s)
#pragma unroll
            for (int p = 0; p < 2; ++p) R.w[cb][s][p] = *(const bf16x8*)(wh + ((size_t)p * 48 + 16 * cb) * D + 32 * s);
}
__device__ __forceinline__ void route_round(const RouteW& R, const Args& a, LAS unsigned char* lds, int tid, int wave, int lane, int layer, int tok0, const float* X, const bf16* MO, bf16* H, unsigned* cntw, unsigned* list, float* selw) {
    LAS float* plog = (LAS float*)lds;
    LAS float* psq = (LAS float*)(lds + 49152);
    LAS float* lgf = (LAS float*)(lds + 49152 + 1024);
    LAS float* rs = (LAS float*)(lds + 49152 + 1024 + 6144);
    volatile LAS unsigned* hist = (volatile LAS unsigned*)(lds + 49152 + 1024 + 6144 + 128);
    const int fr = lane & 15, fq = lane >> 4;
    if (tid < 64) hist[tid] = 0u;
    f32x4 xp[2][4], xq[2][4]; v4u mo[2][4];
#pragma unroll
    for (int mt = 0; mt < 2; ++mt)
#pragma unroll
        for (int s = 0; s < 4; ++s) { const size_t o = (size_t)(tok0 + 16 * mt + fr) * D + 128 * wave + 32 * s + 8 * fq; xp[mt][s] = *(const f32x4*)(X + o); xq[mt][s] = *(const f32x4*)(X + o + 4); mo[mt][s] = *(const v4u*)(MO + o); }
#pragma unroll
    for (int mt = 0; mt < 2; ++mt)
#pragma unroll
        for (int s = 0; s < 4; ++s) { const v4u m = mo[mt][s]; xp[mt][s] += (f32x4){bf_lo(m.x), bf_hi(m.x), bf_lo(m.y), bf_hi(m.y)}; xq[mt][s] += (f32x4){bf_lo(m.z), bf_hi(m.z), bf_lo(m.w), bf_hi(m.w)}; }
#pragma unroll
    for (int mt = 0; mt < 2; ++mt) {
        f32x4 acc[3]; float ss = 0.f;
#pragma unroll
        for (int cb = 0; cb < 3; ++cb) acc[cb] = (f32x4){0.f, 0.f, 0.f, 0.f};
#pragma unroll
        for (int s = 0; s < 4; ++s) { const f32x4 p = xp[mt][s], q = xq[mt][s];
            ss += (p.x * p.x + p.y * p.y) + (p.z * p.z + p.w * p.w) + (q.x * q.x + q.y * q.y) + (q.z * q.z + q.w * q.w);
            v4u hi; hi.x = cvt_pk_bf16(p.x, p.y); hi.y = cvt_pk_bf16(p.z, p.w); hi.z = cvt_pk_bf16(q.x, q.y); hi.w = cvt_pk_bf16(q.z, q.w);
            v4u lo; lo.x = cvt_pk_bf16(p.x - bf_lo(hi.x), p.y - bf_hi(hi.x)); lo.y = cvt_pk_bf16(p.z - bf_lo(hi.y), p.w - bf_hi(hi.y));
            lo.z = cvt_pk_bf16(q.x - bf_lo(hi.z), q.y - bf_hi(hi.z)); lo.w = cvt_pk_bf16(q.z - bf_lo(hi.w), q.w - bf_hi(hi.w));
            const bf16x8 xh = __builtin_bit_cast(bf16x8, hi), xl = __builtin_bit_cast(bf16x8, lo);
#pragma unroll
            for (int cb = 0; cb < 3; ++cb) {
                acc[cb] = __builtin_amdgcn_mfma_f32_16x16x32_bf16(R.w[cb][s][0], xh, acc[cb], 0, 0, 0);
                acc[cb] = __builtin_amdgcn_mfma_f32_16x16x32_bf16(R.w[cb][s][1], xh, acc[cb], 0, 0, 0);
                acc[cb] = __builtin_amdgcn_mfma_f32_16x16x32_bf16(R.w[cb][s][0], xl, acc[cb], 0, 0, 0);
            } }
        ss += __shfl_xor(ss, 16); ss += __shfl_xor(ss, 32);
#pragma unroll
        for (int cb = 0; cb < 3; ++cb) *(LAS f32x4*)(plog + (wave * 32 + 16 * mt + fr) * 48 + 16 * cb + 4 * fq) = acc[cb];
        if (fq == 0) psq[wave * 32 + 16 * mt + fr] = ss;
    }
    __syncthreads();
    { const int t = tid >> 4, c0 = 3 * (tid & 15);
      float q = 0.f, l0 = 0.f, l1 = 0.f, l2 = 0.f;
#pragma unroll
      for (int w = 0; w < 8; ++w) { q += psq[w * 32 + t]; const LAS float* pl = plog + (w * 32 + t) * 48 + c0; l0 += pl[0]; l1 += pl[1]; l2 += pl[2]; }
      const float rstd = rsqrtf(q * (1.f / D) + EPS);
      lgf[t * 48 + c0] = l0 * rstd; lgf[t * 48 + c0 + 1] = l1 * rstd; lgf[t * 48 + c0 + 2] = l2 * rstd;
      if ((tid & 15) == 0) rs[t] = rstd; }
    __syncthreads();
    int ea = 0, eb = 0; unsigned ra = 0, rb = 0; float wa_ = 0.f, wb_ = 0.f;
    if (tid < 32) {
        const LAS float* my = lgf + tid * 48;
        float gl[4];
#pragma unroll
        for (int g = 0; g < NGRP; ++g) gl[g] = my[g];
        int tg = 0; float mx = gl[0];
#pragma unroll
        for (int g = 1; g < NGRP; ++g) if (gl[g] > mx) { mx = gl[g]; tg = g; }
        float den = 0.f;
#pragma unroll
        for (int g = 0; g < NGRP; ++g) den += __expf(gl[g] - mx);
        const float top_gp = 1.0f / den;
        float el[8];
#pragma unroll
        for (int e = 0; e < EPG; ++e) el[e] = my[NGRP + 8 * tg + e];
        int e0 = 0; float l0 = el[0];
#pragma unroll
        for (int e = 1; e < EPG; ++e) if (el[e] > l0) { l0 = el[e]; e0 = e; }
        int e1 = 0; float l1 = -INFINITY;
#pragma unroll
        for (int e = 0; e < EPG; ++e) if (e != e0 && el[e] > l1) { l1 = el[e]; e1 = e; }
        const float p1 = __expf(l1 - l0), inv = 1.0f / (1.0f + p1);
        ea = tg * EPG + e0; eb = tg * EPG + e1; wa_ = top_gp * inv; wb_ = top_gp * p1 * inv;
        ra = __hip_atomic_fetch_add((LAS unsigned*)hist + ea, 1u, __ATOMIC_RELAXED, __HIP_MEMORY_SCOPE_WORKGROUP);
        rb = __hip_atomic_fetch_add((LAS unsigned*)hist + eb, 1u, __ATOMIC_RELAXED, __HIP_MEMORY_SCOPE_WORKGROUP);
    }
    { const float* gain = a.in[10] + layer * D + 128 * wave + 8 * fq;
#pragma unroll
      for (int s = 0; s < 4; ++s) { const f32x4 gp = *(const f32x4*)(gain + 32 * s), gq = *(const f32x4*)(gain + 32 * s + 4);
#pragma unroll
          for (int mt = 0; mt < 2; ++mt) { const float r = rs[16 * mt + fr]; const f32x4 hp = xp[mt][s] * r * gp, hq = xq[mt][s] * r * gq;
              v4u hi; hi.x = cvt_pk_bf16(hp.x, hp.y); hi.y = cvt_pk_bf16(hp.z, hp.w); hi.z = cvt_pk_bf16(hq.x, hq.y); hi.w = cvt_pk_bf16(hq.z, hq.w);
              *(v4u*)(H + (size_t)(tok0 + 16 * mt + fr) * D + 128 * wave + 32 * s + 8 * fq) = hi; } } }
    __syncthreads();
    if (tid < NEXP) { const unsigned c = hist[tid]; if (c) hist[32 + tid] = __hip_atomic_fetch_add(cntw + (layer * NEXP + tid) * 64, c, RLX_AGENT); }
    __syncthreads();
    if (tid < 32) {
        const int t = tok0 + tid;
        const size_t pa_ = (size_t)ea * LIST_CAP + hist[32 + ea] + ra, pb_ = (size_t)eb * LIST_CAP + hist[32 + eb] + rb;
        list[pa_] = (unsigned)(t * 2); list[pb_] = (unsigned)(t * 2 + 1); selw[pa_] = wa_; selw[pb_] = wb_;
    }
    __syncthreads();
}

__device__ __forceinline__ void moe_tables(Frame& F, int layer) {
    volatile LAS int* cnt = (volatile LAS int*)(F.lds + LDSCTL_OFF);
    volatile LAS int* tst = cnt + 32;
    if (F.tid < NEXP) cnt[F.tid] = (int)__hip_atomic_load(F.ctl + CW_CNT + (layer * NEXP + F.tid) * 64, RLX_AGENT);
    __syncthreads();
    if (F.tid == 0) { int acc = 0; for (int e = 0; e < NEXP; ++e) { tst[e] = acc; acc += (cnt[e] + 255) >> 8; } tst[NEXP] = acc; }
    __syncthreads();
}

__device__ __forceinline__ void conv_phase(Frame& F, const Args& a) {
    unsigned char* ws = a.ws;
    const bf16* Y = (const bf16*)(ws + WS_ACT); const bf16* GB = Y + (size_t)T * D; bf16* MIX = (bf16*)(ws + WS_MIX);
    const float* cw = a.in[7];
    for (int it = F.vcu * 512 + F.tid; it < (T / 16) * (D / 8); it += F.G * 512) {
        const int cg = it % (D / 8), tb = it / (D / 8), c0 = cg * 8, tok0 = tb * 16;
        float w0[8], w1[8], w2[8];
#pragma unroll
        for (int j = 0; j < 8; ++j) { w0[j] = cw[c0 + j]; w1[j] = cw[D + c0 + j]; w2[j] = cw[2 * D + c0 + j]; }
        float ym2[8], ym1[8];
        const bool first = (tok0 % SEQ) == 0;
        { v4u r1 = {0, 0, 0, 0}, r2 = {0, 0, 0, 0};
          if (!first) { r2 = *(const v4u*)(Y + (size_t)(tok0 - 2) * D + c0); r1 = *(const v4u*)(Y + (size_t)(tok0 - 1) * D + c0); }
          const unsigned a2[4] = {r2.x, r2.y, r2.z, r2.w}, a1[4] = {r1.x, r1.y, r1.z, r1.w};
#pragma unroll
          for (int j = 0; j < 4; ++j) { ym2[2 * j] = bf_lo(a2[j]); ym2[2 * j + 1] = bf_hi(a2[j]); ym1[2 * j] = bf_lo(a1[j]); ym1[2 * j + 1] = bf_hi(a1[j]); } }
#pragma unroll 4
        for (int t = 0; t < 16; ++t) {
            const v4u ry = *(const v4u*)(Y + (size_t)(tok0 + t) * D + c0), rg = *(const v4u*)(GB + (size_t)(tok0 + t) * D + c0);
            const unsigned ay[4] = {ry.x, ry.y, ry.z, ry.w}, ag[4] = {rg.x, rg.y, rg.z, rg.w};
            float y[8], o[8];
#pragma unroll
            for (int j = 0; j < 4; ++j) { y[2 * j] = bf_lo(ay[j]); y[2 * j + 1] = bf_hi(ay[j]); }
#pragma unroll
            for (int j = 0; j < 8; ++j) { const float gbv = (j & 1) ? bf_hi(ag[j >> 1]) : bf_lo(ag[j >> 1]); o[j] = gbv * (w0[j] * ym2[j] + w1[j] * ym1[j] + w2[j] * y[j]); ym2[j] = ym1[j]; ym1[j] = y[j]; }
            v4u w; w.x = pk2(o[0], o[1]); w.y = pk2(o[2], o[3]); w.z = pk2(o[4], o[5]); w.w = pk2(o[6], o[7]);
            *(v4u*)(MIX + (size_t)(tok0 + t) * D + c0) = w;
        }
    }
}

constexpr int NPHASE = 15;
__global__ void __launch_bounds__(NWAVES * 64, 2) mk_fwd(Args args) {
    extern __shared__ __attribute__((aligned(16))) unsigned char lds[];
    Frame F;
    F.lds = (LAS unsigned char*)lds;
    F.MISC = (volatile LAS unsigned*)(F.lds + MISC_OFF);
    F.tid = threadIdx.x; F.lane = F.tid & 63; F.wave = __builtin_amdgcn_readfirstlane(F.tid >> 6);
    F.G = gridDim.x; { const int bx = blockIdx.x; F.vcu = (F.G % 8 == 0) ? (bx % 8) * (F.G / 8) + bx / 8 : bx; }
    unsigned char* ws = args.ws;
    F.ctl = (gu32*)(ws + WS_CTL);
#ifdef TS_FIXED
    const unsigned long long t_start_ = __builtin_amdgcn_s_memrealtime();
#endif
#ifdef TS_A
    if (blockIdx.x == 0 && threadIdx.x == 0) __hip_atomic_store(F.ctl + CW_TS + 45, (unsigned)__builtin_amdgcn_s_memrealtime(), RLX_AGENT);
#endif
    for (int u = F.tid; u < (LDS_BYTES - LDSCTL_OFF) / 4; u += NWAVES * 64) ((LAS unsigned*)(F.lds + LDSCTL_OFF))[u] = 0u;
    __syncthreads();
    XcdBarrier bar; bar.bar = (unsigned*)(F.ctl + CW_BAR); bar.x = 0; bar.st = nullptr;
    if (args.single) bar = xcd_barrier_post((unsigned*)(F.ctl + CW_BAR), F.MISC + 8);
    const unsigned mask = args.mask;
#ifndef PHCT
#define PHCT 0x7fffu
#endif
#define RUN(k) (((PHCT >> (k)) & 1u) && ((mask >> (k)) & 1u))
#define SEAM(k) do { STAMP(3 * (k) + 1); if (args.single && (k) + 1 < NPHASE) xcd_barrier(bar); STAMP(3 * (k) + 2); } while (0)
#ifndef REPEAT
#define REPEAT (-1)
#endif
#ifdef TS_A
#ifndef TS_BLOCK
#define TS_BLOCK 0
#endif
#define STAMP(k) do { if (blockIdx.x == (TS_BLOCK) && F.tid == 0) __hip_atomic_store(F.ctl + CW_TS + (k), (unsigned)__builtin_amdgcn_s_memrealtime(), RLX_AGENT); } while (0)
#else
#define STAMP(k) do { } while (0)
#endif
#ifndef RMODE
#define RMODE 0
#endif
#define REPS(k) for (int rep_ = 0; rep_ < ((REPEAT) == (k) ? 2 : 1); ++rep_)
    const LAS int* cntL = (const LAS int*)(F.lds + LDSCTL_OFF); const LAS int* tstL = cntL + 32;
    bf16* const Hb = (bf16*)(ws + WS_H); bf16* const ACT = (bf16*)(ws + WS_ACT); bf16* const MIXb = (bf16*)(ws + WS_MIX); float* const Xf = (float*)(ws + WS_X);
    bf16* const MOb = (bf16*)(ws + WS_ACT + 40 * MiB);
    bf16* const CONTRIB = (bf16*)(ws + WS_CONTRIB); unsigned* const LIST = (unsigned*)(ws + WS_LIST); float* const SELW = (float*)(ws + WS_SELW);
    const int gw = F.vcu * NWAVES + F.wave, NGW = F.G * NWAVES;

    STAMP(46);
#ifdef TS_SKEW
    if (F.tid == 0) { const unsigned t = (unsigned)__builtin_amdgcn_s_memrealtime(); __hip_atomic_fetch_max(F.ctl + CW_TS + 60, ~t, RLX_AGENT); __hip_atomic_fetch_max(F.ctl + CW_TS + 61, t, RLX_AGENT); }
#endif
    const int GEMM_G = (F.G == 256) ? 128 : F.G;
    const bool conv_wg = (int)blockIdx.x >= GEMM_G; const int cwi = ((int)blockIdx.x - GEMM_G) * NWAVES + F.wave, ncw = (F.G - GEMM_G) * NWAVES;
    if (RUN(0)) REPS(0) { phase_prologue(F, args, GEMM_G == F.G ? 2 * I_MOE : 0); SEAM(0); }
    if (RUN(1)) REPS(1) {
        if (!conv_wg) {
#ifdef P1_CONV_ONLY_REP
        if (rep_ == 0)
#endif
        {
        pg8::DenseOrder S; S.init(T, EVEN_IN, D, (const bf16*)(ws + WS_WIN0), GEMM_G, (int)blockIdx.x);
        pg8::EpiEvenIn E{ACT, ACT + (size_t)T * GW, ACT + (size_t)2 * T * GW, ACT + (size_t)3 * T * GW, ACT + (size_t)4 * T * GW};
        pg8::gemm_phase<pg8::EpiEvenIn, pg8::DenseOrder, true>(F.lds, Hb, D, S, E);
        }
        } else { conv_moe_range(args, F.lds, F.wave, F.lane, 0, 0, 2 * I_MOE, cwi, ncw); }
        SEAM(1);
    }
#ifdef PROBE_CONV
    if (RUN(1)) { if (conv_wg) { conv_moe_range(args, F.lds, F.wave, F.lane, 0, L0_P0, I_MOE, cwi, ncw); } if (args.single) xcd_barrier(bar); }
#endif
    if (RUN(2)) REPS(2) {
        for (int u = F.vcu; u < BATCH * (SEQ / CHUNK) * NG; u += F.G) gmlp_unit(F, args, u);
        for (int t = gw; t < 2 * 2048; t += NGW) {
            const int rnd = t >> 11, tt = t & 2047; const int bh = (tt >> 6) + 32 * rnd, qb = tt & 63;
            sb_task(args, F.lane, bh, rnd ? 63 - qb : qb);
        }
        SEAM(2);
    }
    if (RUN(3)) REPS(3) {
        pg8::DenseOrder S; S.init(T, D, D, (const bf16*)(ws + WS_WOUT0), F.G, (int)blockIdx.x);
        pg8::EpiMixBf16 E{MOb};
        pg8::gemm_phase<pg8::EpiMixBf16, pg8::DenseOrder, false>(F.lds, MIXb, D, S, E);
        SEAM(3);
    }
#define MOE_PHASES(layer, pb) do { \
        if (RUN(pb)) REPS(pb) { \
            { RouteW RW; route_load_w(RW, args, layer, F.wave, F.lane); \
              for (int rd = F.vcu; rd < T / 32; rd += F.G) route_round(RW, args, F.lds, F.tid, F.wave, F.lane, layer, rd * 32, (layer) == 0 ? args.in[0] : Xf, MOb, Hb, (unsigned*)(F.ctl + CW_CNT) + (rep_ ? 2 * NEXP * 64 : 0), rep_ ? (unsigned*)(ws + WS_CONTRIB) : LIST, rep_ ? (float*)(ws + WS_CONTRIB + 4 * MiB) : SELW); } \
            SEAM(pb); \
        } \
        if (RUN((pb) + 1)) REPS((pb) + 1) { \
            moe_tables(F, layer); \
            { \
            pg8::MoeOrder S{cntL, tstL, (int)blockIdx.x, F.G, (const bf16*)(ws + WS_WGU) + (size_t)(layer) * NEXP * 1024 * D, (size_t)1024 * D, D, LIST, true}; \
            pg8::EpiMoeUp E{ACT}; \
            pg8::gemm_phase<pg8::EpiMoeUp, pg8::MoeOrder, true>(F.lds, Hb, D, S, E); } \
            SEAM((pb) + 1); \
        } \
        if (RUN((pb) + 2)) REPS((pb) + 2) { \
            moe_tables(F, layer); \
            { \
            pg8::MoeOrder S{cntL, tstL, (int)blockIdx.x, F.G, (const bf16*)(ws + WS_WD) + (size_t)(layer) * NEXP * D * FF, (size_t)D * FF, FF, LIST, false}; \
            pg8::EpiMoeDown E{CONTRIB, LIST, SELW, cntL}; \
            pg8::gemm_phase<pg8::EpiMoeDown, pg8::MoeOrder, true>(F.lds, ACT, FF, S, E); } \
            SEAM((pb) + 2); \
        } } while (0)
    MOE_PHASES(0, 4);
    if (RUN(7)) REPS(7) {
        for (int m = gw; m < T; m += NGW) norm_row(F.lane, args.in[0] + (size_t)m * D, MOb + (size_t)m * D, CONTRIB + (size_t)m * D, CONTRIB + (size_t)(T + m) * D, args.in[9] + D, (rep_ ? (float*)ACT : Xf) + (size_t)m * D, (rep_ ? MIXb : Hb) + (size_t)m * D, nullptr);
        SEAM(7);
    }
    if (RUN(8)) REPS(8) {
        pg8::DenseOrder S; S.init(T, ODD_IN, D, (const bf16*)(ws + WS_WIN1), F.G, (int)blockIdx.x);
        pg8::EpiOddIn E{ACT, ACT + (size_t)T * D};
        pg8::gemm_phase<pg8::EpiOddIn, pg8::DenseOrder, true>(F.lds, Hb, D, S, E);
        SEAM(8);
    }
    if (RUN(9)) REPS(9) { conv_phase(F, args); SEAM(9); }
    if (RUN(10)) {
        pg8::DenseOrder S; S.init(T, D, D, (const bf16*)(ws + WS_WOUT1), F.G, (int)blockIdx.x);
        pg8::EpiMixBf16 E{MOb};
        pg8::gemm_phase<pg8::EpiMixBf16, pg8::DenseOrder, false>(F.lds, MIXb, D, S, E);
        SEAM(10);
    }
    MOE_PHASES(1, 11);
#undef MOE_PHASES
    if (RUN(14)) REPS(14) {
        for (int m = gw; m < T; m += NGW) norm_row(F.lane, Xf + (size_t)m * D, MOb + (size_t)m * D, CONTRIB + (size_t)m * D, CONTRIB + (size_t)(T + m) * D, args.in[16], nullptr, nullptr, args.out + (size_t)m * D);
    }
#ifdef TS_FIXED
    { const unsigned long long tend = t_start_ + (unsigned long long)(TS_FIXED) * 100ull; while (__builtin_amdgcn_s_memrealtime() < tend) __builtin_amdgcn_s_sleep(8); }
#endif
#ifdef TS_A
    STAMP(47);
    if (blockIdx.x == (TS_BLOCK) && F.tid == 0) {
        const unsigned s0 = __hip_atomic_load(F.ctl + CW_TS + (TS_A), RLX_AGENT), s1 = __hip_atomic_load(F.ctl + CW_TS + (TS_A1), RLX_AGENT);
        const unsigned s2 = __hip_atomic_load(F.ctl + CW_TS + (TS_B), RLX_AGENT), s3 = __hip_atomic_load(F.ctl + CW_TS + (TS_B1), RLX_AGENT);
#ifdef TS_SKEW
        const unsigned e0 = ~__hip_atomic_load(F.ctl + CW_TS + 60, RLX_AGENT), e1 = __hip_atomic_load(F.ctl + CW_TS + 61, RLX_AGENT);
        const unsigned long long delay = 100ull * (unsigned long long)(e1 - e0);
#else
        const unsigned long long delay = (unsigned long long)(s1 - s0) + 400ull * (unsigned long long)(((s3 - s2) / 100u) * 100u);
#endif
        const unsigned long long t0 = __builtin_amdgcn_s_memrealtime();
        while (__builtin_amdgcn_s_memrealtime() - t0 < delay) __builtin_amdgcn_s_sleep(8);
    }
#endif
#undef RUN
#undef SEAM
}

extern "C" void kernel_launch(void* const* d_in, const int* in_sizes, int n_in, void* d_out, int out_size, void* d_ws, size_t ws_size, hipStream_t stream) {
    static int grid = 0;
    if (grid == 0) {
        if (n_in != 17 || in_sizes[0] != T * D || out_size != T * D || ws_size < WS_END) { fprintf(stderr, "kernel_launch: unexpected shapes / workspace (%d inputs, ws %zu)\n", n_in, ws_size); grid = -1; return; }
        int dev = 0, cus = 0, per_cu = 0;
        if (hipGetDevice(&dev) != hipSuccess || hipDeviceGetAttribute(&cus, hipDeviceAttributeMultiprocessorCount, dev) != hipSuccess) { grid = -1; return; }
        if (hipFuncSetAttribute((const void*)mk_fwd, hipFuncAttributeMaxDynamicSharedMemorySize, LDS_BYTES) != hipSuccess) { fprintf(stderr, "kernel_launch: hipFuncSetAttribute failed\n"); grid = -1; return; }
        if (hipOccupancyMaxActiveBlocksPerMultiprocessor(&per_cu, (const void*)mk_fwd, NWAVES * 64, LDS_BYTES) != hipSuccess || per_cu < 1) { fprintf(stderr, "kernel_launch: occupancy query reports %d workgroups per CU\n", per_cu); }
        (void)hipGetLastError();
        grid = cus;
    }
    if (grid < 0) return;
    Args a{};
    for (int i = 0; i < 17; ++i) a.in[i] = (const float*)d_in[i];
    a.out = (float*)d_out; a.ws = (unsigned char*)d_ws;
    (void)hipMemsetAsync((char*)d_ws + WS_CTL, 0, CTL_ZERO_BYTES, stream);
    a.mask = (1u << NPHASE) - 1u; a.single = 1;
    hipLaunchKernelGGL(mk_fwd, dim3(grid), dim3(NWAVES * 64), LDS_BYTES, stream, a);
}
```
